# Optimizing an MI355X kernel written in HIP

```python
import jax, jax.numpy as jnp
from jax import lax
import numpy as np

D_MODEL = 1024
BATCH = 2
SEQ = 8192
DEPTH = 1

HEAD_DIM = 64
A_Q_HEADS = 6
A_KV_HEADS = 2
A_GROUPS = A_Q_HEADS // A_KV_HEADS
B_Q_HEADS = 6
B_KV_HEADS = 2
B_GROUPS = B_Q_HEADS // B_KV_HEADS
M_HEADS = 4
N_MEM = 256
GRID_W = 64
Q_BLOCK = 128
WINDOW = 128
ROPE_THETA = 10000.0
N_BRANCHES = 3
N_EXPERTS = 32
TOP_K = 4
D_EXPERT = D_MODEL
SWIGLU_ALPHA = 1.702
SWIGLU_LIMIT = 7.0
MOE_BLOCK = 128
EPS = 1e-6

A_Q = A_Q_HEADS * HEAD_DIM
A_KV = A_KV_HEADS * HEAD_DIM
B_Q = B_Q_HEADS * HEAD_DIM
B_KV = B_KV_HEADS * HEAD_DIM
M_Q = M_HEADS * HEAD_DIM
GATE_W = N_BRANCHES * D_MODEL
IN_WIDTH = A_Q + 2 * A_KV + B_Q + 2 * B_KV + M_Q + GATE_W

kernel_name = "hybrid_gated_gqa_window_memory_moe_encoder"


def rmsnorm(x, g):
    xf = x.astype(jnp.float32)
    y = xf * lax.rsqrt(jnp.mean(xf * xf, axis=-1, keepdims=True) + EPS)
    return (y * g.astype(jnp.float32)).astype(x.dtype)


def rope(x, pos):
    d = x.shape[-1]
    inv = ROPE_THETA ** (-jnp.arange(0, d, 2, dtype=jnp.float32) / d)
    ang = pos.astype(jnp.float32)[:, None] * inv[None, :]
    cos, sin = jnp.cos(ang), jnp.sin(ang)
    xf = x.astype(jnp.float32)
    x1, x2 = xf[..., : d // 2], xf[..., d // 2:]
    return jnp.concatenate([x1 * cos - x2 * sin, x2 * cos + x1 * sin], axis=-1).astype(x.dtype)


def axial_rope(x, rows, cols):
    half = x.shape[-1] // 2
    return jnp.concatenate([rope(x[..., :half], rows), rope(x[..., half:], cols)], axis=-1)


def heads_q(t, kv, g):
    b, s, _ = t.shape
    return t.reshape(b, s, kv, g, HEAD_DIM).transpose(0, 2, 3, 1, 4)


def heads_kv(t, kv):
    b, s, _ = t.shape
    return t.reshape(b, s, kv, HEAD_DIM).transpose(0, 2, 1, 3)


def merge_heads(o):
    b, kv, g, s, d = o.shape
    return o.transpose(0, 3, 1, 2, 4).reshape(b, s, kv * g * d)


def global_gqa(q, k, v):
    b, kv, g, s, d = q.shape
    nb = s // Q_BLOCK
    scale = d ** -0.5
    qb = jnp.moveaxis(q.reshape(b, kv, g, nb, Q_BLOCK, d), 3, 0)

    def block(qi):
        sc = jnp.einsum('bkgqd,bksd->bkgqs', qi, k).astype(jnp.float32) * scale
        p = jax.nn.softmax(sc, axis=-1).astype(v.dtype)
        return jnp.einsum('bkgqs,bksd->bkgqd', p, v)

    o = lax.map(block, qb)
    return jnp.moveaxis(o, 0, 3).reshape(b, kv, g, s, d)


def window_gqa_sink(q, k, v, sink):
    b, kv, g, s, d = q.shape
    nb = s // Q_BLOCK
    scale = d ** -0.5
    pad = ((0, 0), (0, 0), (Q_BLOCK, Q_BLOCK), (0, 0))
    kp = jnp.pad(k, pad).reshape(b, kv, nb + 2, Q_BLOCK, d)
    vp = jnp.pad(v, pad).reshape(b, kv, nb + 2, Q_BLOCK, d)
    band = lambda t: jnp.concatenate([t[:, :, :-2], t[:, :, 1:-1], t[:, :, 2:]], axis=3)
    kw, vw = band(kp), band(vp)
    qb = q.reshape(b, kv, g, nb, Q_BLOCK, d)
    sc = jnp.einsum('bkgnqd,bknsd->bkgnqs', qb, kw).astype(jnp.float32) * scale
    blk = jnp.arange(nb)[:, None, None] * Q_BLOCK
    qpos = blk + jnp.arange(Q_BLOCK)[None, :, None]
    kpos = blk - Q_BLOCK + jnp.arange(3 * Q_BLOCK)[None, None, :]
    valid = (jnp.abs(kpos - qpos) <= WINDOW) & (kpos >= 0) & (kpos < s)
    sc = jnp.where(valid, sc, jnp.finfo(jnp.float32).min)
    sink_col = jnp.broadcast_to(sink.astype(jnp.float32).reshape(1, kv, g, 1, 1, 1), sc.shape[:-1] + (1,))
    p = jax.nn.softmax(jnp.concatenate([sc, sink_col], axis=-1), axis=-1)[..., :-1]
    o = jnp.einsum('bkgnqs,bknsd->bkgnqd', p.astype(v.dtype), vw)
    return o.reshape(b, kv, g, s, d)


def memory_attention(q, km, vm):
    scale = q.shape[-1] ** -0.5
    sc = jnp.einsum('bhsd,bhnd->bhsn', q, km).astype(jnp.float32) * scale
    p = jax.nn.softmax(sc, axis=-1).astype(vm.dtype)
    return jnp.einsum('bhsn,bhnd->bhsd', p, vm)


def moe(h, w_router, b_router, w_gu, b_gu, w_down, b_down):
    bn, s, d = h.shape
    t = bn * s
    ht = h.reshape(t, d)
    logits = (ht @ w_router + b_router).astype(jnp.float32)
    top_v, top_i = lax.top_k(logits, TOP_K)
    gate = jax.nn.softmax(top_v, axis=-1)
    a = t * TOP_K
    flat_e = top_i.reshape(a)
    flat_tok = jnp.repeat(jnp.arange(t, dtype=jnp.int32), TOP_K)
    flat_w = gate.reshape(a)
    order = jnp.argsort(flat_e)
    se = flat_e[order]
    counts = jnp.bincount(flat_e, length=N_EXPERTS)
    padded = (counts + MOE_BLOCK - 1) // MOE_BLOCK * MOE_BLOCK
    start = jnp.cumsum(counts) - counts
    pend = jnp.cumsum(padded)
    pstart = pend - padded
    dest = pstart[se] + jnp.arange(a) - start[se]
    p_rows = a + N_EXPERTS * MOE_BLOCK
    nb = p_rows // MOE_BLOCK
    row_tok = jnp.zeros((p_rows,), jnp.int32).at[dest].set(flat_tok[order])
    row_w = jnp.zeros((p_rows,), jnp.float32).at[dest].set(flat_w[order])
    blk_e = jnp.minimum(jnp.searchsorted(pend, jnp.arange(nb) * MOE_BLOCK, side='right'), N_EXPERTS - 1)
    xs = ht[row_tok].reshape(nb, MOE_BLOCK, d)

    def expert_block(args):
        xb, e = args
        gu = xb @ w_gu[e] + b_gu[e]
        g = jnp.minimum(gu[:, :D_EXPERT], SWIGLU_LIMIT)
        lin = jnp.clip(gu[:, D_EXPERT:], -SWIGLU_LIMIT, SWIGLU_LIMIT)
        act = g * jax.nn.sigmoid(SWIGLU_ALPHA * g) * (lin + 1.0)
        return act @ w_down[e] + b_down[e]

    ys = lax.map(expert_block, (xs, blk_e)).reshape(p_rows, d)
    y = jax.ops.segment_sum(ys * row_w[:, None].astype(ys.dtype), row_tok, num_segments=t)
    return y.reshape(bn, s, d)


def setup_inputs(seed: int = 0) -> dict:
    key = jax.random.key(seed)
    ks = jax.random.split(key, 24)
    f32 = jnp.float32
    w = lambda k, shape, fan_in: jax.random.normal(k, shape, f32) * fan_in ** -0.5
    gain = lambda k, shape: 1.0 + 0.02 * jax.random.normal(k, shape, f32)
    small = lambda k, shape, sc: sc * jax.random.normal(k, shape, f32)
    L = DEPTH
    return {
        "x": jax.random.normal(ks[0], (BATCH, SEQ, D_MODEL), f32),
        "mem": jax.random.normal(ks[1], (BATCH, N_MEM, D_MODEL), f32),
        "norm_mix": gain(ks[2], (L, D_MODEL)),
        "w_in": w(ks[3], (L, D_MODEL, IN_WIDTH), D_MODEL),
        "q_norm_a": gain(ks[4], (L, HEAD_DIM)),
        "k_norm_a": gain(ks[5], (L, HEAD_DIM)),
        "sink_b": small(ks[6], (L, B_Q_HEADS), 0.5),
        "norm_mem": gain(ks[7], (L, D_MODEL)),
        "w_mem_kv": w(ks[8], (L, D_MODEL, 2 * M_Q), D_MODEL),
        "w_branch_a": w(ks[9], (L, A_Q, D_MODEL), A_Q),
        "w_branch_b": w(ks[10], (L, B_Q, D_MODEL), B_Q),
        "w_branch_m": w(ks[11], (L, M_Q, D_MODEL), M_Q),
        "w_out": w(ks[12], (L, D_MODEL, D_MODEL), D_MODEL),
        "norm_ffn": gain(ks[13], (L, D_MODEL)),
        "w_router": w(ks[14], (L, D_MODEL, N_EXPERTS), D_MODEL),
        "b_router": small(ks[15], (L, N_EXPERTS), 0.01),
        "w_gate_up": w(ks[16], (L, N_EXPERTS, D_MODEL, 2 * D_EXPERT), D_MODEL),
        "b_gate_up": small(ks[17], (L, N_EXPERTS, 2 * D_EXPERT), 0.02),
        "w_down": w(ks[18], (L, N_EXPERTS, D_EXPERT, D_MODEL), D_EXPERT),
        "b_down": small(ks[19], (L, N_EXPERTS, D_MODEL), 0.02),
        "norm_final": gain(ks[20], (D_MODEL,)),
    }


def reference(x, mem, norm_mix, w_in, q_norm_a, k_norm_a, sink_b, norm_mem, w_mem_kv,
              w_branch_a, w_branch_b, w_branch_m, w_out, norm_ffn, w_router, b_router,
              w_gate_up, b_gate_up, w_down, b_down, norm_final):
    bn, s, d = x.shape
    n_rows = s // GRID_W
    pos = jnp.arange(s, dtype=jnp.int32)
    rows = jnp.repeat(jnp.arange(n_rows, dtype=jnp.int32), GRID_W, total_repeat_length=s)
    cols = pos % GRID_W
    widths = [A_Q, A_KV, A_KV, B_Q, B_KV, B_KV, M_Q]
    cuts, acc = [], 0
    for wd in widths:
        acc += wd
        cuts.append(acc)
    for l in range(DEPTH):
        h = rmsnorm(x, norm_mix[l])
        proj = h @ w_in[l]
        q_a, k_a, v_a, q_b, k_b, v_b, q_m, gates = jnp.split(proj, cuts, axis=-1)
        q_a = axial_rope(rmsnorm(heads_q(q_a, A_KV_HEADS, A_GROUPS), q_norm_a[l]), rows, cols)
        k_a = axial_rope(rmsnorm(heads_kv(k_a, A_KV_HEADS), k_norm_a[l]), rows, cols)
        y_a = merge_heads(global_gqa(q_a, k_a, heads_kv(v_a, A_KV_HEADS)))
        q_b = rope(heads_q(q_b, B_KV_HEADS, B_GROUPS), pos)
        k_b = rope(heads_kv(k_b, B_KV_HEADS), pos)
        y_b = merge_heads(window_gqa_sink(q_b, k_b, heads_kv(v_b, B_KV_HEADS), sink_b[l]))
        kv_m = rmsnorm(mem, norm_mem[l]) @ w_mem_kv[l]
        k_m, v_m = jnp.split(kv_m, 2, axis=-1)
        o_m = memory_attention(heads_kv(q_m, M_HEADS), heads_kv(k_m, M_HEADS), heads_kv(v_m, M_HEADS))
        y_m = o_m.transpose(0, 2, 1, 3).reshape(bn, s, M_Q)
        g_a, g_b, g_m = jnp.split(jax.nn.sigmoid(gates), N_BRANCHES, axis=-1)
        merged = g_a * (y_a @ w_branch_a[l]) + g_b * (y_b @ w_branch_b[l]) + g_m * (y_m @ w_branch_m[l])
        x = x + merged @ w_out[l]
        x = x + moe(rmsnorm(x, norm_ffn[l]), w_router[l], b_router[l], w_gate_up[l], b_gate_up[l],
                    w_down[l], b_down[l])
    return rmsnorm(x, norm_final)
```

```cpp
#include <hip/hip_runtime.h>
#include <cstdio>
#include <cstdint>

namespace cfg {
constexpr int D = 1024, BATCH = 2, SEQ = 8192, T = BATCH * SEQ;
constexpr int HD = 64, NMEM = 256, NE = 32, TOPK = 4, FF = 1024;
constexpr int INW = 4608;
constexpr int C_QA = 0, C_KA = 384, C_VA = 512, C_QB = 640, C_KB = 1024, C_VB = 1152, C_QM = 1280, C_G = 1536;
constexpr float EPS = 1e-6f;
}
using namespace cfg;

__global__ void rmsnorm_rows(const float* __restrict__ x, const float* __restrict__ g, float* __restrict__ out, int rows) {
    const int wave = (blockIdx.x * blockDim.x + threadIdx.x) >> 6, lane = threadIdx.x & 63;
    if (wave >= rows) return;
    const float4* xr = (const float4*)(x + (size_t)wave * D);
    float4 v[4]; float s = 0.f;
#pragma unroll
    for (int j = 0; j < 4; ++j) { v[j] = xr[lane + 64 * j]; s += v[j].x * v[j].x + v[j].y * v[j].y + v[j].z * v[j].z + v[j].w * v[j].w; }
#pragma unroll
    for (int o = 1; o < 64; o <<= 1) s += __shfl_xor(s, o);
    const float r = rsqrtf(s * (1.f / D) + EPS);
    float4* orow = (float4*)(out + (size_t)wave * D);
#pragma unroll
    for (int j = 0; j < 4; ++j) { const float4 gg = ((const float4*)g)[lane + 64 * j]; float4 o; o.x = v[j].x * r * gg.x; o.y = v[j].y * r * gg.y; o.z = v[j].z * r * gg.z; o.w = v[j].w * r * gg.w; orow[lane + 64 * j] = o; }
}

struct GemmP {
    const float* A; int lda; const float* B; int ldb; float* C; int ldc; int M, N, K;
    const float* bias; const float* res; int ldres;
    const int* cnt; const int* list; int list_stride; int a_shift;
    size_t b_gstride; int bias_gstride;
};
__global__ void __launch_bounds__(256) gemm_f32(GemmP p) {
    __shared__ float As[16][68];
    __shared__ float Bs[16][68];
    const int e = blockIdx.z;
    const int Mrows = p.cnt ? p.cnt[e] : p.M;
    const int m0 = blockIdx.y * 64, n0 = blockIdx.x * 64;
    if (m0 >= Mrows) return;
    const float* B = p.B + (size_t)e * p.b_gstride;
    const int tid = threadIdx.x, tx = tid & 15, ty = tid >> 4;
    const int ar = tid >> 2, ak = (tid & 3) * 4;
    int arow_id = -1;
    { const int r = m0 + ar; if (r < Mrows) arow_id = p.list ? (p.list[(size_t)e * p.list_stride + r] >> p.a_shift) : r; }
    const int bk = tid >> 4, bn = (tid & 15) * 4;
    float acc[4][4];
#pragma unroll
    for (int i = 0; i < 4; ++i)
#pragma unroll
        for (int j = 0; j < 4; ++j) acc[i][j] = 0.f;
    for (int k0 = 0; k0 < p.K; k0 += 16) {
        float4 av = make_float4(0.f, 0.f, 0.f, 0.f);
        if (arow_id >= 0) av = *(const float4*)(p.A + (size_t)arow_id * p.lda + k0 + ak);
        const float4 bv = *(const float4*)(B + (size_t)(k0 + bk) * p.ldb + n0 + bn);
        __syncthreads();
        As[ak + 0][ar] = av.x; As[ak + 1][ar] = av.y; As[ak + 2][ar] = av.z; As[ak + 3][ar] = av.w;
        *(float4*)&Bs[bk][bn] = bv;
        __syncthreads();
#pragma unroll
        for (int k = 0; k < 16; ++k) {
            const float4 a = *(const float4*)&As[k][ty * 4];
            const float4 b = *(const float4*)&Bs[k][tx * 4];
            const float aa[4] = {a.x, a.y, a.z, a.w}, bb[4] = {b.x, b.y, b.z, b.w};
#pragma unroll
            for (int i = 0; i < 4; ++i)
#pragma unroll
                for (int j = 0; j < 4; ++j) acc[i][j] = fmaf(aa[i], bb[j], acc[i][j]);
        }
    }
#pragma unroll
    for (int i = 0; i < 4; ++i) {
        const int r = m0 + ty * 4 + i;
        if (r >= Mrows) continue;
        const int crow = p.list ? p.list[(size_t)e * p.list_stride + r] : r;
        const int c = n0 + tx * 4;
        float4 o = make_float4(acc[i][0], acc[i][1], acc[i][2], acc[i][3]);
        if (p.bias) { const float4 b = *(const float4*)(p.bias + (size_t)e * p.bias_gstride + c); o.x += b.x; o.y += b.y; o.z += b.z; o.w += b.w; }
        if (p.res) { const float4 b = *(const float4*)(p.res + (size_t)r * p.ldres + c); o.x += b.x; o.y += b.y; o.z += b.z; o.w += b.w; }
        *(float4*)(p.C + (size_t)crow * p.ldc + c) = o;
    }
}

__device__ __forceinline__ void sincos_red(float ang, float& sn, float& c) {
    const float n = rintf(ang * 0.15915494309189535f);
    float r = fmaf(-n, 6.28318548202514648f, ang); r = fmaf(-n, -1.74845553e-7f, r);
    const float rev = r * 0.15915494309189535f;
    sn = __builtin_amdgcn_sinf(rev); c = __builtin_amdgcn_cosf(rev);
}
__global__ void __launch_bounds__(64) norm_rope(float* __restrict__ proj, const float* __restrict__ qn, const float* __restrict__ kn) {
    const int idx = blockIdx.x * blockDim.x + threadIdx.x;
    if (idx >= T * 16) return;
    const int t = idx >> 4, slot = idx & 15, s = t % SEQ;
    int col; const float* g = nullptr; bool axial;
    if (slot < 6) { col = C_QA + slot * 64; g = qn; axial = true; }
    else if (slot < 8) { col = C_KA + (slot - 6) * 64; g = kn; axial = true; }
    else if (slot < 14) { col = C_QB + (slot - 8) * 64; axial = false; }
    else { col = C_KB + (slot - 14) * 64; axial = false; }
    float* p = proj + (size_t)t * INW + col;
    float v[64];
#pragma unroll
    for (int i = 0; i < 64; ++i) v[i] = p[i];
    if (axial) {
        float ss = 0.f;
#pragma unroll
        for (int i = 0; i < 64; ++i) ss += v[i] * v[i];
        const float r = rsqrtf(ss * (1.f / 64.f) + EPS);
#pragma unroll
        for (int i = 0; i < 64; ++i) v[i] = v[i] * r * g[i];
        const float prow = (float)(s / 64), pcol = (float)(s % 64);
#pragma unroll
        for (int half = 0; half < 2; ++half) {
            const float pos = half ? pcol : prow;
#pragma unroll
            for (int i = 0; i < 16; ++i) {
                const float inv = exp2f(-(float)(2 * i) / 32.f * 13.287712379549449f);
                const float ang = pos * inv; float c, sn; sincos_red(ang, sn, c);
                const float x1 = v[half * 32 + i], x2 = v[half * 32 + 16 + i];
                v[half * 32 + i] = x1 * c - x2 * sn; v[half * 32 + 16 + i] = x2 * c + x1 * sn;
            }
        }
    } else {
        const float pos = (float)s;
#pragma unroll
        for (int i = 0; i < 32; ++i) {
            const float inv = exp2f(-(float)(2 * i) / 64.f * 13.287712379549449f);
            const float ang = pos * inv; float c, sn; sincos_red(ang, sn, c);
            const float x1 = v[i], x2 = v[32 + i];
            v[i] = x1 * c - x2 * sn; v[32 + i] = x2 * c + x1 * sn;
        }
    }
#pragma unroll
    for (int i = 0; i < 64; ++i) p[i] = v[i];
}

template <int MODE>
__global__ void __launch_bounds__(128) attn_naive(const float* __restrict__ Q, int ldq, const float* __restrict__ Kp, const float* __restrict__ Vp, int ldk, int skv, int kvdiv,
                                                  const float* __restrict__ sink, float* __restrict__ O, int ldo) {
    __shared__ float Ks[32][64];
    __shared__ float Vs[32][64];
    const int qb = blockIdx.x, head = blockIdx.y, b = blockIdx.z, tid = threadIdx.x;
    const int i = qb * 128 + tid;
    const int kvh = head / kvdiv;
    const float* qp = Q + (size_t)(b * SEQ + i) * ldq + head * 64;
    float q[64], o[64];
#pragma unroll
    for (int d = 0; d < 64; ++d) { q[d] = qp[d] * 0.125f; o[d] = 0.f; }
    float m = -3.0e38f, l = 0.f;
    int k_lo = 0, k_hi = skv;
    if (MODE == 1) { k_lo = qb * 128 - 128; if (k_lo < 0) k_lo = 0; k_hi = qb * 128 + 256; if (k_hi > skv) k_hi = skv; }
    for (int kt = k_lo; kt < k_hi; kt += 32) {
        __syncthreads();
        for (int u = tid; u < 32 * 16; u += 128) {
            const int r = u >> 4, c4 = (u & 15) * 4;
            const size_t off = (size_t)(b * skv + kt + r) * ldk + kvh * 64 + c4;
            *(float4*)&Ks[r][c4] = *(const float4*)(Kp + off);
            *(float4*)&Vs[r][c4] = *(const float4*)(Vp + off);
        }
        __syncthreads();
        float s[32]; float tm = -3.0e38f;
#pragma unroll
        for (int j = 0; j < 32; ++j) {
            float a = 0.f;
#pragma unroll
            for (int d = 0; d < 64; d += 4) { const float4 kk = *(const float4*)&Ks[j][d]; a = fmaf(q[d], kk.x, a); a = fmaf(q[d + 1], kk.y, a); a = fmaf(q[d + 2], kk.z, a); a = fmaf(q[d + 3], kk.w, a); }
            if (MODE == 1) { const int dj = (kt + j) - i; if (dj > 128 || dj < -128) a = -3.0e38f; }
            s[j] = a; tm = fmaxf(tm, a);
        }
        const float mn = fmaxf(m, tm);
        if (mn > -1.0e38f) {
            const float f = __expf(m - mn);
            l *= f;
#pragma unroll
            for (int d = 0; d < 64; ++d) o[d] *= f;
            m = mn;
#pragma unroll
            for (int j = 0; j < 32; ++j) {
                const float pj = (s[j] < -1.0e38f) ? 0.f : __expf(s[j] - m);
                l += pj;
#pragma unroll
                for (int d = 0; d < 64; d += 4) { const float4 vv = *(const float4*)&Vs[j][d]; o[d] = fmaf(pj, vv.x, o[d]); o[d + 1] = fmaf(pj, vv.y, o[d + 1]); o[d + 2] = fmaf(pj, vv.z, o[d + 2]); o[d + 3] = fmaf(pj, vv.w, o[d + 3]); }
            }
        }
    }
    if (MODE == 1) {
        const float sk = sink[head];
        const float mn = fmaxf(m, sk);
        const float f = __expf(m - mn);
        l = l * f + __expf(sk - mn);
#pragma unroll
        for (int d = 0; d < 64; ++d) o[d] *= f;
    }
    const float rl = 1.f / l;
    float* op = O + (size_t)(b * SEQ + i) * ldo + head * 64;
#pragma unroll
    for (int d = 0; d < 64; ++d) op[d] = o[d] * rl;
}

__global__ void merge_gates(const float* __restrict__ proj, float* __restrict__ ta, const float* __restrict__ tb, const float* __restrict__ tm) {
    const size_t idx = (size_t)blockIdx.x * blockDim.x + threadIdx.x;
    if (idx >= (size_t)T * D) return;
    const size_t t = idx / D; const int c = (int)(idx % D);
    const float* g = proj + t * INW + C_G;
    auto sg = [](float v) { return 1.f / (1.f + expf(-v)); };
    ta[idx] = sg(g[c]) * ta[idx] + sg(g[D + c]) * tb[idx] + sg(g[2 * D + c]) * tm[idx];
}

__global__ void router_topk(const float* __restrict__ h2, const float* __restrict__ wr, const float* __restrict__ br, int* __restrict__ cnt, int* __restrict__ list, float* __restrict__ topw) {
    const int wave = (blockIdx.x * blockDim.x + threadIdx.x) >> 6, lane = threadIdx.x & 63;
    if (wave >= T) return;
    const int e = lane & 31, half = lane >> 5;
    const float* hr = h2 + (size_t)wave * D;
    float a = 0.f;
    for (int k = half * 512; k < half * 512 + 512; ++k) a = fmaf(hr[k], wr[k * NE + e], a);
    a += __shfl_xor(a, 32);
    a += br[e];
    float vals[4]; int idxs[4];
    float cur = a;
#pragma unroll
    for (int k = 0; k < 4; ++k) {
        float bv = cur; int bi = e;
#pragma unroll
        for (int o = 1; o < 32; o <<= 1) { const float ov = __shfl_xor(bv, o); const int oi = __shfl_xor(bi, o); if (ov > bv || (ov == bv && oi < bi)) { bv = ov; bi = oi; } }
        vals[k] = bv; idxs[k] = bi;
        if (e == bi) cur = -3.0e38f;
    }
    const float mx = vals[0];
    float ex[4], sum = 0.f;
#pragma unroll
    for (int k = 0; k < 4; ++k) { ex[k] = expf(vals[k] - mx); sum += ex[k]; }
    if (lane < 4) {
        const int k = lane;
        const int ee = k == 0 ? idxs[0] : k == 1 ? idxs[1] : k == 2 ? idxs[2] : idxs[3];
        const float ev = k == 0 ? ex[0] : k == 1 ? ex[1] : k == 2 ? ex[2] : ex[3];
        const int pos = atomicAdd(&cnt[ee], 1);
        list[ee * T + pos] = wave * 4 + k;
        topw[wave * 4 + k] = ev / sum;
    }
}

__global__ void swiglu_act(float* __restrict__ gu) {
    const size_t idx = (size_t)blockIdx.x * blockDim.x + threadIdx.x;
    if (idx >= (size_t)T * TOPK * FF) return;
    const size_t r = idx / FF; const int c = (int)(idx % FF);
    float g = gu[r * 2 * FF + c], lin = gu[r * 2 * FF + FF + c];
    g = fminf(g, 7.f); lin = fminf(fmaxf(lin, -7.f), 7.f);
    gu[r * 2 * FF + c] = g * (1.f / (1.f + expf(-1.702f * g))) * (lin + 1.f);
}

__global__ void combine_final(const float* __restrict__ x1, const float* __restrict__ ys, const float* __restrict__ topw, const float* __restrict__ g, float* __restrict__ out) {
    const int wave = (blockIdx.x * blockDim.x + threadIdx.x) >> 6, lane = threadIdx.x & 63;
    if (wave >= T) return;
    float4 v[4]; float s = 0.f;
#pragma unroll
    for (int j = 0; j < 4; ++j) {
        float4 a = ((const float4*)(x1 + (size_t)wave * D))[lane + 64 * j];
#pragma unroll
        for (int k = 0; k < 4; ++k) { const float w = topw[wave * 4 + k]; const float4 y = ((const float4*)(ys + (size_t)(wave * 4 + k) * D))[lane + 64 * j]; a.x += w * y.x; a.y += w * y.y; a.z += w * y.z; a.w += w * y.w; }
        v[j] = a; s += a.x * a.x + a.y * a.y + a.z * a.z + a.w * a.w;
    }
#pragma unroll
    for (int o = 1; o < 64; o <<= 1) s += __shfl_xor(s, o);
    const float r = rsqrtf(s * (1.f / D) + EPS);
#pragma unroll
    for (int j = 0; j < 4; ++j) { const float4 gg = ((const float4*)g)[lane + 64 * j]; float4 o; o.x = v[j].x * r * gg.x; o.y = v[j].y * r * gg.y; o.z = v[j].z * r * gg.z; o.w = v[j].w * r * gg.w; ((float4*)(out + (size_t)wave * D))[lane + 64 * j] = o; }
}

static void run_gemm(hipStream_t st, const float* A, int lda, const float* B, int ldb, float* C, int ldc, int M, int N, int K, const float* bias = nullptr, const float* res = nullptr, int ldres = 0) {
    GemmP p{}; p.A = A; p.lda = lda; p.B = B; p.ldb = ldb; p.C = C; p.ldc = ldc; p.M = M; p.N = N; p.K = K; p.bias = bias; p.res = res; p.ldres = ldres;
    gemm_f32<<<dim3(N / 64, (M + 63) / 64, 1), 256, 0, st>>>(p);
}

extern "C" void kernel_launch(void* const* d_in, const int* in_sizes, int n_in, void* d_out, int out_size, void* d_ws, size_t ws_size, hipStream_t stream) {
    const float* x = (const float*)d_in[0]; const float* mem = (const float*)d_in[1]; const float* norm_mix = (const float*)d_in[2]; const float* w_in = (const float*)d_in[3];
    const float* q_norm_a = (const float*)d_in[4]; const float* k_norm_a = (const float*)d_in[5]; const float* sink_b = (const float*)d_in[6]; const float* norm_mem = (const float*)d_in[7];
    const float* w_mem_kv = (const float*)d_in[8]; const float* w_br_a = (const float*)d_in[9]; const float* w_br_b = (const float*)d_in[10]; const float* w_br_m = (const float*)d_in[11];
    const float* w_out = (const float*)d_in[12]; const float* norm_ffn = (const float*)d_in[13]; const float* w_router = (const float*)d_in[14]; const float* b_router = (const float*)d_in[15];
    const float* w_gu = (const float*)d_in[16]; const float* b_gu = (const float*)d_in[17]; const float* w_down = (const float*)d_in[18]; const float* b_down = (const float*)d_in[19];
    const float* norm_final = (const float*)d_in[20];
    float* out = (float*)d_out;
    float* ws = (float*)d_ws;
    size_t off = 0;
    auto take = [&](size_t n) { float* p = ws + off; off += (n + 63) & ~(size_t)63; return p; };
    float* proj = take((size_t)T * INW);
    float* ycat = take((size_t)T * D);
    float* ta = take((size_t)T * D);
    float* tb = take((size_t)T * D);
    float* tm = take((size_t)T * D);
    float* gu = proj;
    float* h = take((size_t)T * D);
    float* x1 = take((size_t)T * D);
    float* ys = take((size_t)T * TOPK * D);
    float* memn = take((size_t)BATCH * NMEM * D);
    float* kvm = take((size_t)BATCH * NMEM * 512);
    float* topw = take((size_t)T * TOPK);
    int* cnt = (int*)take(64);
    int* list = (int*)take((size_t)NE * T);
    if (off * 4 > ws_size) { fprintf(stderr, "kernel_launch: workspace too small: need %zu have %zu\n", off * 4, ws_size); return; }

    (void)hipMemsetAsync(cnt, 0, 64 * 4, stream);
    rmsnorm_rows<<<T / 4, 256, 0, stream>>>(x, norm_mix, h, T);
    run_gemm(stream, h, D, w_in, INW, proj, INW, T, INW, D);
    norm_rope<<<T * 16 / 64, 64, 0, stream>>>(proj, q_norm_a, k_norm_a);
    rmsnorm_rows<<<BATCH * NMEM / 4, 256, 0, stream>>>(mem, norm_mem, memn, BATCH * NMEM);
    run_gemm(stream, memn, D, w_mem_kv, 512, kvm, 512, BATCH * NMEM, 512, D);
    attn_naive<0><<<dim3(SEQ / 128, 6, BATCH), 128, 0, stream>>>(proj + C_QA, INW, proj + C_KA, proj + C_VA, INW, SEQ, 3, nullptr, ycat + 0, D);
    attn_naive<1><<<dim3(SEQ / 128, 6, BATCH), 128, 0, stream>>>(proj + C_QB, INW, proj + C_KB, proj + C_VB, INW, SEQ, 3, sink_b, ycat + 384, D);
    attn_naive<2><<<dim3(SEQ / 128, 4, BATCH), 128, 0, stream>>>(proj + C_QM, INW, kvm, kvm + 256, 512, NMEM, 1, nullptr, ycat + 768, D);
    run_gemm(stream, ycat + 0, D, w_br_a, D, ta, D, T, D, 384);
    run_gemm(stream, ycat + 384, D, w_br_b, D, tb, D, T, D, 384);
    run_gemm(stream, ycat + 768, D, w_br_m, D, tm, D, T, D, 256);
    merge_gates<<<(unsigned)(((size_t)T * D + 255) / 256), 256, 0, stream>>>(proj, ta, tb, tm);
    run_gemm(stream, ta, D, w_out, D, x1, D, T, D, D, nullptr, x, D);
    rmsnorm_rows<<<T / 4, 256, 0, stream>>>(x1, norm_ffn, h, T);
    router_topk<<<T / 4, 256, 0, stream>>>(h, w_router, b_router, cnt, list, topw);
    { GemmP p{}; p.A = h; p.lda = D; p.B = w_gu; p.ldb = 2 * FF; p.C = gu; p.ldc = 2 * FF; p.M = T; p.N = 2 * FF; p.K = D; p.bias = b_gu; p.cnt = cnt; p.list = list; p.list_stride = T; p.a_shift = 2;
      p.b_gstride = (size_t)D * 2 * FF; p.bias_gstride = 2 * FF;
      gemm_f32<<<dim3(2 * FF / 64, T / 64, NE), 256, 0, stream>>>(p); }
    swiglu_act<<<(unsigned)(((size_t)T * TOPK * FF + 255) / 256), 256, 0, stream>>>(gu);
    { GemmP p{}; p.A = gu; p.lda = 2 * FF; p.B = w_down; p.ldb = D; p.C = ys; p.ldc = D; p.M = T; p.N = D; p.K = FF; p.bias = b_down; p.cnt = cnt; p.list = list; p.list_stride = T; p.a_shift = 0;
      p.b_gstride = (size_t)FF * D; p.bias_gstride = D;
      gemm_f32<<<dim3(D / 64, T / 64, NE), 256, 0, stream>>>(p); }
    combine_final<<<T / 4, 256, 0, stream>>>(x1, ys, topw, norm_final, out);
}
```

```cpp
#define MK_DEBUG 0
#include <hip/hip_runtime.h>
#include <hip/hip_cooperative_groups.h>
#include <hip/hip_bf16.h>
#include <cstdio>
#include <cstdint>
namespace cg = cooperative_groups;

namespace cfg {
constexpr int D = 1024, BATCH = 2, SEQ = 8192, T = BATCH * SEQ;
constexpr int HD = 64, NMEM = 256, NE = 32, TOPK = 4, FF = 1024;
constexpr int INW = 4608, NQKV = 1536, NG = 3072;
constexpr int C_QA = 0, C_KA = 384, C_VA = 512, C_QB = 640, C_KB = 1024, C_VB = 1152, C_QM = 1280;
constexpr float EPS = 1e-6f;
constexpr float C2 = 0.125f * 1.4426950408889634f;
constexpr float LOG2E = 1.4426950408889634f;
constexpr int ACT_ROWS = T * TOPK + NE * 256;
}
using namespace cfg;

typedef unsigned short bf16_t;
typedef short bf16x8 __attribute__((ext_vector_type(8)));
typedef float f32x4 __attribute__((ext_vector_type(4)));
typedef float f32x2 __attribute__((ext_vector_type(2)));
typedef unsigned u32x4 __attribute__((ext_vector_type(4)));
typedef unsigned u32x2 __attribute__((ext_vector_type(2)));
#define LAS __attribute__((address_space(3)))

typedef __bf16 bf16x2_nat __attribute__((ext_vector_type(2)));
__device__ __forceinline__ unsigned cvt_pk_bf16(float lo, float hi) { f32x2 v = {lo, hi}; bf16x2_nat b = __builtin_convertvector(v, bf16x2_nat); return __builtin_bit_cast(unsigned, b); }
__device__ __forceinline__ float bf2f(unsigned short v) { return __uint_as_float((unsigned)v << 16); }
__device__ __forceinline__ float bflo(unsigned v) { return __uint_as_float(v << 16); }
__device__ __forceinline__ float bfhi(unsigned v) { return __uint_as_float(v & 0xffff0000u); }
__device__ __forceinline__ void sincos_red(float ang, float& sn, float& c) {
    const float n = rintf(ang * 0.15915494309189535f);
    float r = fmaf(-n, 6.28318548202514648f, ang); r = fmaf(-n, -1.74845553e-7f, r);
    const float rev = r * 0.15915494309189535f;
    sn = __builtin_amdgcn_sinf(rev); c = __builtin_amdgcn_cosf(rev);
}
__device__ __forceinline__ float sigmoidf_fast(float v) { return __builtin_amdgcn_rcpf(1.f + __builtin_amdgcn_exp2f(-v * LOG2E)); }
__host__ __device__ __forceinline__ int p8perm(int i) { return 8 * ((i >> 2) & 3) + 4 * (i >> 4) + (i & 3); }

namespace pg8 {
constexpr int BM = 256, BK = 64, HALF = 128, HTB = HALF * BK * 2, STAGE_BYTES = 8 * HTB;
__host__ __device__ __forceinline__ int lds_byte(int r, int c) { const int st = (r >> 4) * 2 + (c >> 5), rr = r & 15, cc = c & 31, ob = rr * 64 + cc * 2; return st * 1024 + (ob ^ (((ob >> 9) & 1) << 5)); }
__host__ __device__ __forceinline__ void stage_rc(int b, int& R, int& C) { const int st = b / 1024, sb = b % 1024, swz = sb ^ (((sb >> 9) & 1) << 5); R = (st >> 1) * 16 + swz / 64; C = (st & 1) * 32 + (swz % 64) / 2; }

struct Unit { int pm, pn, aux, nt; const char* a; const char* b; unsigned va0, va1, va2, va3; };

template <class Epi, class Sched, bool ALIGN_EPI>
__device__ __forceinline__ void gemm_phase(LAS unsigned char* lds, const Sched& S, const Epi& E, const unsigned ldb_bytes) {
    const int tid = threadIdx.x, wid = __builtin_amdgcn_readfirstlane(tid >> 6), lane = tid & 63, wr = wid >> 2, wc = wid & 3, fr = lane & 15, fq = lane >> 4;
    unsigned voffB[2];
#pragma unroll
    for (int i = 0; i < 2; ++i) { int R, C; stage_rc(tid * 16 + i * 8192, R, C); voffB[i] = (unsigned)R * ldb_bytes + (unsigned)C * 2u; }
    const size_t kstep = (size_t)(BK * 2);
    const size_t hstepB = (size_t)HALF * ldb_bytes;
    const unsigned ldsw = (unsigned)wid * 1024u;
    const int aoff = lds_byte(wr * 64 + fr, fq * 8), boff = lds_byte(wc * 32 + fr, fq * 8);
#define PG8_SA(b, h) (((b) * 2 + (h)) * HTB)
#define PG8_SB(b, h) ((4 + (b) * 2 + (h)) * HTB)
#define PG8_GLDS(src, dstoff) __builtin_amdgcn_global_load_lds((const unsigned*)(src), (LAS unsigned*)(lds + (dstoff)), 16, 0, 0)
#define PG8_STAGE_B(bufoff, gbase) do { PG8_GLDS((const char*)(gbase) + voffB[0], (bufoff) + ldsw); PG8_GLDS((const char*)(gbase) + voffB[1], (bufoff) + ldsw + 8192); } while (0)
#define PG8_STAGE_A(bufoff, gbase, v0, v1) do { PG8_GLDS((const char*)(gbase) + (v0), (bufoff) + ldsw); PG8_GLDS((const char*)(gbase) + (v1), (bufoff) + ldsw + 8192); } while (0)
#define PG8_LDA(dst, b, h) do { _Pragma("unroll") for (int m = 0; m < 4; ++m) _Pragma("unroll") for (int k = 0; k < 2; ++k) dst[m][k] = *(const LAS bf16x8*)(lds + PG8_SA(b, h) + aoff + m * 2048 + k * 1024); } while (0)
#define PG8_LDB(dst, b, h) do { _Pragma("unroll") for (int n = 0; n < 2; ++n) _Pragma("unroll") for (int k = 0; k < 2; ++k) dst[n][k] = *(const LAS bf16x8*)(lds + PG8_SB(b, h) + boff + n * 2048 + k * 1024); } while (0)
#define PG8_MMA(ai, bj, At, Bt) do { __builtin_amdgcn_s_setprio(1); _Pragma("unroll") for (int m = 0; m < 4; ++m) _Pragma("unroll") for (int n = 0; n < 2; ++n) _Pragma("unroll") for (int k = 0; k < 2; ++k) \
        acc[ai][bj][m][n] = __builtin_amdgcn_mfma_f32_16x16x32_bf16(Bt[n][k], At[m][k], acc[ai][bj][m][n], 0, 0, 0); __builtin_amdgcn_s_setprio(0); } while (0)
#define PG8_WAIT_V(n) asm volatile("s_waitcnt vmcnt(" #n ")" ::: "memory")
#define PG8_WAIT_L(n) asm volatile("s_waitcnt lgkmcnt(" #n ")" ::: "memory")
#define PG8_BAR __builtin_amdgcn_s_barrier()
#define PG8_SCHED __builtin_amdgcn_sched_barrier(0)
    Unit cur, nxt; int ui = 0;
    if (!S.next(0, cur)) return;
    f32x4 acc[2][2][4][2];
#pragma unroll
    for (int a = 0; a < 2; ++a)
#pragma unroll
        for (int b = 0; b < 2; ++b)
#pragma unroll
            for (int m = 0; m < 4; ++m)
#pragma unroll
                for (int n = 0; n < 2; ++n) acc[a][b][m][n] = (f32x4){0.f, 0.f, 0.f, 0.f};
    bf16x8 At[4][2], B0[2][2], B1[2][2];
    const char* cA = cur.a; const char* cB = cur.b;
    PG8_STAGE_B(PG8_SB(0, 0), cB); PG8_STAGE_B(PG8_SB(0, 1), cB + hstepB); PG8_STAGE_A(PG8_SA(0, 0), cA, cur.va0, cur.va1); PG8_STAGE_A(PG8_SA(0, 1), cA, cur.va2, cur.va3);
    if (wr == 1) PG8_BAR;
    PG8_WAIT_V(2); PG8_BAR;
    PG8_STAGE_B(PG8_SB(1, 0), cB + kstep); PG8_STAGE_A(PG8_SA(1, 0), cA + kstep, cur.va0, cur.va1); PG8_STAGE_B(PG8_SB(1, 1), cB + hstepB + kstep);
    PG8_WAIT_V(6); PG8_BAR;
    for (;;) {
        const bool has_next = S.next(ui + 1, nxt);
        const char* nA = cA; const char* nB = cB; unsigned n0 = cur.va0, n1 = cur.va1, n2 = cur.va2, n3 = cur.va3;
        if (has_next) { nA = nxt.a; nB = nxt.b; n0 = nxt.va0; n1 = nxt.va1; n2 = nxt.va2; n3 = nxt.va3; }
        const int nt = cur.nt;
        for (int t = 0; t < nt; t += 2) {
            const bool last = (t == nt - 2);
            const char* a1 = cA + (size_t)(t + 1) * kstep;
            const char* a2 = last ? nA : cA + (size_t)(t + 2) * kstep; const char* b2 = last ? nB : cB + (size_t)(t + 2) * kstep;
            const char* a3 = a2 + kstep; const char* b3 = b2 + kstep;
            const unsigned w0 = last ? n0 : cur.va0, w1 = last ? n1 : cur.va1, w2 = last ? n2 : cur.va2, w3 = last ? n3 : cur.va3;
            PG8_LDB(B0, 0, 0); PG8_LDB(B1, 0, 1); PG8_SCHED; PG8_LDA(At, 0, 0); PG8_STAGE_A(PG8_SA(1, 1), a1, cur.va2, cur.va3);
            PG8_WAIT_V(8); PG8_WAIT_L(0); PG8_BAR; PG8_MMA(0, 0, At, B0); PG8_MMA(0, 1, At, B1); PG8_BAR; PG8_SCHED;
            PG8_LDA(At, 0, 1); PG8_STAGE_B(PG8_SB(0, 0), b2); PG8_STAGE_B(PG8_SB(0, 1), b2 + hstepB); PG8_STAGE_A(PG8_SA(0, 0), a2, w0, w1);
            PG8_WAIT_V(8); PG8_WAIT_L(0); PG8_BAR; PG8_MMA(1, 0, At, B0); PG8_MMA(1, 1, At, B1); PG8_BAR; PG8_SCHED;
            PG8_LDB(B0, 1, 0); PG8_LDB(B1, 1, 1); PG8_SCHED; PG8_LDA(At, 1, 0); PG8_STAGE_A(PG8_SA(0, 1), a2, w2, w3);
            PG8_WAIT_V(8); PG8_WAIT_L(0); PG8_BAR; PG8_MMA(0, 0, At, B0); PG8_MMA(0, 1, At, B1); PG8_BAR; PG8_SCHED;
            PG8_LDA(At, 1, 1); PG8_STAGE_B(PG8_SB(1, 0), b3); PG8_STAGE_B(PG8_SB(1, 1), b3 + hstepB); PG8_STAGE_A(PG8_SA(1, 0), a3, w0, w1);
            PG8_WAIT_V(8); PG8_WAIT_L(0); PG8_BAR; PG8_MMA(1, 0, At, B0); PG8_MMA(1, 1, At, B1); PG8_BAR; PG8_SCHED;
        }
        if constexpr (ALIGN_EPI) { if (wr == 0) PG8_BAR; }
        E(acc, cur, wr, wc, fr, fq);
        if (!has_next) break;
#pragma unroll
        for (int a = 0; a < 2; ++a)
#pragma unroll
            for (int b = 0; b < 2; ++b)
#pragma unroll
                for (int m = 0; m < 4; ++m)
#pragma unroll
                    for (int n = 0; n < 2; ++n) acc[a][b][m][n] = (f32x4){0.f, 0.f, 0.f, 0.f};
        cur = nxt; cA = nA; cB = nB; ++ui;
        if constexpr (ALIGN_EPI) { if (wr == 1) PG8_BAR; }
    }
    PG8_WAIT_V(0);
    if constexpr (!ALIGN_EPI) { if (wr == 0) PG8_BAR; }
    PG8_BAR;
#undef PG8_SA
#undef PG8_SB
#undef PG8_GLDS
#undef PG8_STAGE_A
#undef PG8_STAGE_B
#undef PG8_LDA
#undef PG8_LDB
#undef PG8_MMA
#undef PG8_WAIT_V
#undef PG8_WAIT_L
#undef PG8_BAR
#undef PG8_SCHED
}
__device__ __forceinline__ void lane_piece(int i, int& R, int& C) { stage_rc((int)threadIdx.x * 16 + i * 8192, R, C); }
}
namespace attn_body {
using bf16=__hip_bfloat16;
using bf16x8=__attribute__((ext_vector_type(8)))short;
using s16x4=__attribute__((ext_vector_type(4)))short;
using f32x16=__attribute__((ext_vector_type(16)))float;
using u32x4=__attribute__((ext_vector_type(4)))unsigned;
constexpr int D=64;
constexpr int NW=8,QBLK=32,QB=QBLK*NW,KVBLK=64;
struct AttnDesc { const bf16* Q; const bf16* K; const bf16* V; bf16* O; int dmq, dmk, dmo; long qrow0, krow0; int NT; int dpos0; float sinkl2; };
__device__ __forceinline__ void wmask_c(f32x16&c0,f32x16&c1,const f32x16&negm,int d,int hi){
  const float NEG=-INFINITY; int kb=d+4*hi+128; asm volatile("":"+v"(kb));
  #pragma unroll
  for(int r=0;r<16;++r){const unsigned kv=(unsigned)(kb+(r&3)+8*(r>>2)); c0[r]=(kv>256u)?NEG:negm[r]; c1[r]=(kv+32u>256u)?NEG:negm[r];}
}
__device__ __forceinline__ int crow(int r,int hi){return (r&3)+8*(r>>2)+4*hi;}
#define SBAR() __builtin_amdgcn_sched_barrier(0)
constexpr int NSLOT=3, SLOTB=8192;
constexpr int LDS_K=0, LDS_V=NSLOT*SLOTB, LDS_WS=2*NSLOT*SLOTB, LDS_OST=LDS_WS+NW*64*4, LDS_BYTES=LDS_OST+NW*4096;
__device__ __forceinline__ void glds16(const void*gsrc,unsigned lds_dst){unsigned keep;
  asm volatile("s_mov_b32 %0, m0\n\ts_mov_b32 m0, %2\n\ts_nop 0\n\tglobal_load_lds_dwordx4 %1, off\n\ts_mov_b32 m0, %0":"=&s"(keep):"v"(gsrc),"s"(lds_dst):"memory");}
__device__ __forceinline__ float max3f(float a,float b,float c){float r;asm("v_max3_f32 %0, %1, %2, %3":"=v"(r):"v"(a),"v"(b),"v"(c));return r;}
__device__ __forceinline__ float max2f(float a,float b){float r;asm("v_max_f32_e32 %0, %1, %2":"=v"(r):"v"(a),"v"(b));return r;}
__device__ __forceinline__ float fadd_s(float a,float b){float r;asm("v_add_f32_e32 %0, %1, %2":"=v"(r):"v"(a),"v"(b));return r;}
__device__ __forceinline__ float fsub_s(float a,float b){float r;asm("v_sub_f32_e32 %0, %1, %2":"=v"(r):"v"(a),"v"(b));return r;}
typedef float f32x2_t __attribute__((ext_vector_type(2))); typedef __bf16 bf16x2_t __attribute__((ext_vector_type(2)));
__device__ __forceinline__ unsigned cvtpk_s(float lo,float hi){f32x2_t v={lo,hi};bf16x2_t b=__builtin_convertvector(v,bf16x2_t);return __builtin_bit_cast(unsigned,b);}
#define WAIT_BAR(N) asm volatile("s_waitcnt vmcnt(" #N ") lgkmcnt(0)\n\ts_barrier":::"memory")

__device__ __forceinline__ void qkt(f32x16&p0,f32x16&p1,const char*Kslot,const bf16x8*qr,const f32x16&c0,const f32x16&c1,int r32,int hi){
  const char*kb=Kslot+hi*1024+r32*16;
  #pragma unroll
  for(int d0=0;d0<4;++d0){
    const bf16x8 b0=*reinterpret_cast<const bf16x8*>(kb+d0*2048);
    const bf16x8 b1=*reinterpret_cast<const bf16x8*>(kb+d0*2048+512);
    if(d0==0){p0=__builtin_amdgcn_mfma_f32_32x32x16_bf16(b0,qr[0],c0,0,0,0);p1=__builtin_amdgcn_mfma_f32_32x32x16_bf16(b1,qr[0],c1,0,0,0);}
    else{p0=__builtin_amdgcn_mfma_f32_32x32x16_bf16(b0,qr[d0],p0,0,0,0);p1=__builtin_amdgcn_mfma_f32_32x32x16_bf16(b1,qr[d0],p1,0,0,0);}}
}
typedef __attribute__((address_space(3))) const char* lds_cptr;
typedef short v4i16_t __attribute__((ext_vector_type(4)));
__device__ __forceinline__ void kload8(bf16x8*kf,lds_cptr kp){
  kf[0]=*(const __attribute__((address_space(3))) bf16x8*)(kp);      kf[1]=*(const __attribute__((address_space(3))) bf16x8*)(kp+512);
  kf[2]=*(const __attribute__((address_space(3))) bf16x8*)(kp+2048); kf[3]=*(const __attribute__((address_space(3))) bf16x8*)(kp+2560);
  kf[4]=*(const __attribute__((address_space(3))) bf16x8*)(kp+4096); kf[5]=*(const __attribute__((address_space(3))) bf16x8*)(kp+4608);
  kf[6]=*(const __attribute__((address_space(3))) bf16x8*)(kp+6144); kf[7]=*(const __attribute__((address_space(3))) bf16x8*)(kp+6656);
}
__device__ __forceinline__ void kload2(bf16x8*kf,lds_cptr kp,int j){ kf[2*j]=*(const __attribute__((address_space(3))) bf16x8*)(kp+j*2048); kf[2*j+1]=*(const __attribute__((address_space(3))) bf16x8*)(kp+j*2048+512); }
__device__ __forceinline__ s16x4 vtr(lds_cptr p){ return __builtin_bit_cast(s16x4,__builtin_amdgcn_ds_read_tr16_b64_v4i16((__attribute__((address_space(3))) v4i16_t*)p)); }
__device__ __forceinline__ float rowmax(const f32x16&p0,const f32x16&p1){
  float a=max3f(p0[0],p0[1],p1[0]),b=max3f(p0[2],p0[3],p1[1]);a=max3f(a,p1[2],p1[3]);
  #pragma unroll
  for(int r=4;r<16;r+=4){a=max3f(a,p0[r],p0[r+1]);b=max3f(b,p0[r+2],p0[r+3]);a=max3f(a,p1[r],p1[r+1]);b=max3f(b,p1[r+2],p1[r+3]);}
  const float m=max2f(a,b);
  auto rr=__builtin_amdgcn_permlane32_swap(__float_as_uint(m),__float_as_uint(m),false,false);
  return max2f(__uint_as_float(rr[0]),__uint_as_float(rr[1]));
}
__device__ __forceinline__ void pv(f32x16*o,int vb,bf16x8 pa0,bf16x8 pa1,bf16x8 pa2,bf16x8 pa3){
  #pragma unroll
  for(int d0=0;d0<2;++d0){s16x4 lo[4],hi[4];
    #pragma unroll
    for(int ks=0;ks<4;++ks){
      asm volatile("ds_read_b64_tr_b16 %0,%1 offset:%c2":"=&v"(lo[ks]):"v"(vb),"i"(d0*4096+ks*1024):"memory");
      asm volatile("ds_read_b64_tr_b16 %0,%1 offset:%c2":"=&v"(hi[ks]):"v"(vb),"i"(d0*4096+ks*1024+512):"memory");}
    asm volatile("s_waitcnt lgkmcnt(0)":::"memory");SBAR();
    #define PK(k) (bf16x8){lo[k][0],lo[k][1],lo[k][2],lo[k][3],hi[k][0],hi[k][1],hi[k][2],hi[k][3]}
    o[d0]=__builtin_amdgcn_mfma_f32_32x32x16_bf16(pa0,PK(0),o[d0],0,0,0);
    o[d0]=__builtin_amdgcn_mfma_f32_32x32x16_bf16(pa1,PK(1),o[d0],0,0,0);
    o[d0]=__builtin_amdgcn_mfma_f32_32x32x16_bf16(pa2,PK(2),o[d0],0,0,0);
    o[d0]=__builtin_amdgcn_mfma_f32_32x32x16_bf16(pa3,PK(3),o[d0],0,0,0);
    #undef PK
  }
}

#ifndef ATTN_STORE16
#define ATTN_STORE16(p,v) (*(u32x4*)(p)=(v))
#endif
template<int THRL,int MODE> __device__ __forceinline__ void attn_unit(const AttnDesc&A,char*shm){
  const int tid=threadIdx.x,lane=tid&63,r32=lane&31,hi=lane>>5; const int wid=__builtin_amdgcn_readfirstlane(tid>>6);
  const int dmq=A.dmq,dmk=A.dmk,dmo=A.dmo;
  const bf16*Qw=A.Q+(A.qrow0+wid*QBLK)*dmq;
  const bf16*Kh=A.K+A.krow0*dmk,*Vh=A.V+A.krow0*dmk;
  const unsigned lds0=(unsigned)(uintptr_t)shm;
  float*wsf=(float*)(shm+LDS_WS)+wid*64;
  const bf16*ksrc=Kh+(long)lane*dmk+wid*8;
  const bf16*vsrc=Vh+(long)(16*(wid&3)+(lane>>2))*dmk+(wid>>2)*32+(lane&3)*8;
  const unsigned kdst=lds0+LDS_K+wid*1024, vdst=lds0+LDS_V+wid*1024;
  #define DMA_K(t,slot) glds16(ksrc+(long)(t)*KVBLK*dmk,(unsigned)__builtin_amdgcn_readfirstlane(kdst+(slot)))
  #define DMA_V(t,slot) glds16(vsrc+(long)(t)*KVBLK*dmk,(unsigned)__builtin_amdgcn_readfirstlane(vdst+(slot)))
  const int vb0=(int)(lds0+LDS_V)+((lane>>4)&1)*32+(lane&3)*8+(4*hi+((lane&15)>>2))*64;
  const char*Kbase=shm+LDS_K; bf16x8 kf[8];
  const lds_cptr shm3=(lds_cptr)shm; const lds_cptr kp0=shm3+LDS_K+hi*1024+r32*16; const lds_cptr vp0=shm3+LDS_V+((lane>>4)&1)*32+(lane&3)*8+(4*hi+((lane&15)>>2))*64;
  const int NT=A.NT;
  DMA_K(0,0);DMA_V(0,0);DMA_K(1,SLOTB);
  bf16x8 qr[4];
  #pragma unroll
  for(int d0=0;d0<4;++d0)qr[d0]=*reinterpret_cast<const bf16x8*>(&Qw[(long)r32*dmq+d0*16+hi*8]);
  float mhat=0.f,l_reg=0.f;f32x16 o[2];o[0]=f32x16{};o[1]=f32x16{};f32x16 negm=f32x16{};asm volatile("":"+v"(negm));
  const int qrel=wid*QBLK+r32; const int dposq=A.dpos0-qrel;
  bool resc=false;
  #define START(P0,P1) do{ const float rm=rowmax(P0,P1); resc=false; \
    { const float dl=(MODE==1)?__builtin_fmaxf(rm,-20.f):rm; mhat=fadd_s(mhat,dl); \
      _Pragma("unroll") for(int r=0;r<16;++r){P0[r]=fsub_s(P0[r],dl);P1[r]=fsub_s(P1[r],dl);} \
      _Pragma("unroll") for(int r=0;r<16;++r)negm[r]=-mhat; asm volatile("":"+v"(negm)); } \
    _Pragma("unroll") for(int r=0;r<16;++r)P0[r]=__builtin_amdgcn_exp2f(P0[r]); }while(0)
  #define RESC() do{ if(resc){ asm volatile("s_waitcnt lgkmcnt(0)":::"memory"); \
      _Pragma("unroll") for(int d_=0;d_<2;++d_) _Pragma("unroll") for(int r=0;r<16;++r)o[d_][r]*=wsf[crow(r,hi)]; } }while(0)
  f32x16 pA0,pA1,pB0,pB1;
  int sl_prev=0,sl_cur=0,sl_next=SLOTB;
  #define ROT() do{sl_prev=sl_cur;sl_cur=sl_next;sl_next=(sl_next==(NSLOT-1)*SLOTB)?0:sl_next+SLOTB;}while(0)
  DMA_K(2,2*SLOTB);
  WAIT_BAR(3);
  if(MODE==1){wmask_c(pA0,pA1,negm,dposq,hi);qkt(pA0,pA1,Kbase,qr,pA0,pA1,r32,hi);}else{qkt(pA0,pA1,Kbase,qr,negm,negm,r32,hi);}asm volatile("s_nop 15\n\ts_nop 7":"+v"(pA0),"+v"(pA1));
  START(pA0,pA1);
  _Pragma("unroll") for(int r=0;r<16;++r)pA1[r]=__builtin_amdgcn_exp2f(pA1[r]);
  WAIT_BAR(0);
  DMA_K(3,0);DMA_V(1,SLOTB);
  ROT();
  kload8(kf,kp0+sl_cur);
  WAIT_BAR(2);
  s16x4 vlo[8],vhi[8]; u32x4 pw0,pw1,pw2,pw3;
  #define PKW(P,B) cvtpk_s(P[B],P[B+1])
  #define PAF(k) __builtin_bit_cast(bf16x8,pw##k)
  #define VFR(i) (bf16x8){vlo[i][0],vlo[i][1],vlo[i][2],vlo[i][3],vhi[i][0],vhi[i][1],vhi[i][2],vhi[i][3]}
  #define PIN(x) asm volatile("":"+v"(x))
  #define MX3(a,b,c) __builtin_fmaxf(__builtin_fmaxf((a),(b)),(c))
  #define GAPA(MF,A0,A1,A2,A3,W0,W1,PW) do{ MF; sacc+=A0; sacc+=A1; sacc+=A2; sacc+=A3; PIN(sacc); W0; W1; PIN(PW); SBAR(); }while(0)
  #define EX(v) __builtin_amdgcn_exp2f(v)
  #define GAPB(MF,X,B) do{ MF; X[B]=EX(X[B]); X[B+1]=EX(X[B+1]); X[B+2]=EX(X[B+2]); X[B+3]=EX(X[B+3]); PIN(X); SBAR(); }while(0)
  #define VRD(i) do{ vlo[i]=vtr(vp_+(((i)>>2)*4096+((i)&3)*1024)); vhi[i]=vtr(vp_+(((i)>>2)*4096+((i)&3)*1024+512)); }while(0)
  #define KRD(G,j) do{ if(G){ kload2(kf,kp0+sl_next,j); SBAR(); } }while(0)
  #define STEP(C0,C1,P0,P1,t,GK,GV,GL) do{ SBAR(); if(MODE==1){ wmask_c(C0,C1,negm,dposq+64*(t),hi); SBAR(); } \
    const lds_cptr vp_=vp0+sl_prev; \
    VRD(0); SBAR(); float sacc=(P0[0]+P0[1]); \
    GAPA(C0=__builtin_amdgcn_mfma_f32_32x32x16_bf16(kf[0],qr[0],(MODE==1?C0:negm),0,0,0), P0[2],P0[3],P0[4],P0[5],     pw0[0]=PKW(P0,0), pw0[1]=PKW(P0,2), pw0); \
    VRD(4); SBAR(); GAPA(C1=__builtin_amdgcn_mfma_f32_32x32x16_bf16(kf[1],qr[0],(MODE==1?C1:negm),0,0,0), P0[6],P0[7],P0[8],P0[9],     pw0[2]=PKW(P0,4), pw0[3]=PKW(P0,6), pw0); \
    VRD(1); SBAR(); GAPA(C0=__builtin_amdgcn_mfma_f32_32x32x16_bf16(kf[2],qr[1],C0,0,0,0),   P0[10],P0[11],P0[12],P0[13], pw1[0]=PKW(P0,8), pw1[1]=PKW(P0,10), pw1); \
    VRD(5); SBAR(); GAPA(C1=__builtin_amdgcn_mfma_f32_32x32x16_bf16(kf[3],qr[1],C1,0,0,0),   P0[14],P0[15],P1[0],P1[1],   pw1[2]=PKW(P0,12),pw1[3]=PKW(P0,14), pw1); \
    VRD(2); SBAR(); GAPA(C0=__builtin_amdgcn_mfma_f32_32x32x16_bf16(kf[4],qr[2],C0,0,0,0),   P1[2],P1[3],P1[4],P1[5],     pw2[0]=PKW(P1,0), pw2[1]=PKW(P1,2), pw2); \
    VRD(6); SBAR(); GAPA(C1=__builtin_amdgcn_mfma_f32_32x32x16_bf16(kf[5],qr[2],C1,0,0,0),   P1[6],P1[7],P1[8],P1[9],     pw2[2]=PKW(P1,4), pw2[3]=PKW(P1,6), pw2); \
    VRD(3); SBAR(); GAPA(C0=__builtin_amdgcn_mfma_f32_32x32x16_bf16(kf[6],qr[3],C0,0,0,0),   P1[10],P1[11],P1[12],P1[13], pw3[0]=PKW(P1,8), pw3[1]=PKW(P1,10), pw3); \
    VRD(7); SBAR(); GAPA(C1=__builtin_amdgcn_mfma_f32_32x32x16_bf16(kf[7],qr[3],C1,0,0,0),   P1[14],P1[15],0.f,0.f,       pw3[2]=PKW(P1,12),pw3[3]=PKW(P1,14), pw3); \
    l_reg+=sacc; \
    if(GK){DMA_K((t)+3,sl_cur);} if(GV){DMA_V((t)+1,sl_next);} \
    { float a=MX3(C0[0],C0[1],C1[0]),b=MX3(C0[2],C0[3],C1[1]); a=MX3(a,C1[2],C1[3]); \
      _Pragma("unroll") for(int r=4;r<16;r+=4){a=MX3(a,C0[r],C0[r+1]);b=MX3(b,C0[r+2],C0[r+3]);a=MX3(a,C1[r],C1[r+1]);b=MX3(b,C1[r+2],C1[r+3]);} \
      float rm=__builtin_fmaxf(a,b); { auto rr=__builtin_amdgcn_permlane32_swap(__float_as_uint(rm),__float_as_uint(rm),false,false); rm=__builtin_fmaxf(__uint_as_float(rr[0]),__uint_as_float(rr[1])); } \
      resc=false; \
      if(__builtin_expect(__any(rm>(float)THRL),0)){ const float dl=__builtin_fmaxf(rm,0.f); mhat+=dl; \
        _Pragma("unroll") for(int r=0;r<16;++r){C0[r]-=dl;C1[r]-=dl;} \
        _Pragma("unroll") for(int r=0;r<16;++r)negm[r]=-mhat; asm volatile("":"+v"(negm)); \
        const float f=__builtin_amdgcn_exp2f(-dl); l_reg*=f; if(hi==0)wsf[r32]=f; resc=true; } } \
    SBAR(); \
    GAPB(o[0]=__builtin_amdgcn_mfma_f32_32x32x16_bf16(PAF(0),VFR(0),o[0],0,0,0), C0,0); \
    GAPB(o[1]=__builtin_amdgcn_mfma_f32_32x32x16_bf16(PAF(0),VFR(4),o[1],0,0,0), C0,4); \
    KRD(GL,0); GAPB(o[0]=__builtin_amdgcn_mfma_f32_32x32x16_bf16(PAF(1),VFR(1),o[0],0,0,0), C0,8); \
    KRD(GL,1); GAPB(o[1]=__builtin_amdgcn_mfma_f32_32x32x16_bf16(PAF(1),VFR(5),o[1],0,0,0), C0,12); \
    KRD(GL,2); GAPB(o[0]=__builtin_amdgcn_mfma_f32_32x32x16_bf16(PAF(2),VFR(2),o[0],0,0,0), C1,0); \
    KRD(GL,3); GAPB(o[1]=__builtin_amdgcn_mfma_f32_32x32x16_bf16(PAF(2),VFR(6),o[1],0,0,0), C1,4); \
    GAPB(o[0]=__builtin_amdgcn_mfma_f32_32x32x16_bf16(PAF(3),VFR(3),o[0],0,0,0), C1,8); \
    GAPB(o[1]=__builtin_amdgcn_mfma_f32_32x32x16_bf16(PAF(3),VFR(7),o[1],0,0,0), C1,12); \
    }while(0)
  int t=1;
  if constexpr(MODE==0) for(;t+5<NT;t+=2){
    STEP(pB0,pB1,pA0,pA1,t,true,true,true);     WAIT_BAR(2); RESC(); ROT();
    STEP(pA0,pA1,pB0,pB1,t+1,true,true,true);   WAIT_BAR(2); RESC(); ROT();
  }
  #define ENDW(tt) do{ if((tt)+3<NT){WAIT_BAR(2);} else if((tt)+2<NT){WAIT_BAR(1);} else {WAIT_BAR(0);} }while(0)
  for(;t+1<NT;t+=2){
    STEP(pB0,pB1,pA0,pA1,t,(t+3<NT),(t+1<NT),(t+1<NT));       ENDW(t);   RESC(); ROT();
    STEP(pA0,pA1,pB0,pB1,t+1,(t+4<NT),(t+2<NT),(t+2<NT));     ENDW(t+1); RESC(); ROT();
  }
  STEP(pB0,pB1,pA0,pA1,NT-1,false,false,false); RESC();
  { float sacc=pB0[0]+pB0[1]; _Pragma("unroll") for(int r=2;r<16;++r)sacc+=pB0[r]; _Pragma("unroll") for(int r=0;r<16;++r)sacc+=pB1[r]; l_reg+=sacc;
    pw0=(u32x4){PKW(pB0,0),PKW(pB0,2),PKW(pB0,4),PKW(pB0,6)};pw1=(u32x4){PKW(pB0,8),PKW(pB0,10),PKW(pB0,12),PKW(pB0,14)};pw2=(u32x4){PKW(pB1,0),PKW(pB1,2),PKW(pB1,4),PKW(pB1,6)};pw3=(u32x4){PKW(pB1,8),PKW(pB1,10),PKW(pB1,12),PKW(pB1,14)};
    SBAR(); pv(o,vb0+sl_cur,PAF(0),PAF(1),PAF(2),PAF(3)); }
  #undef PKW
  #undef PAF
  #undef VFR
  #undef PIN
  #undef MX3
  #undef GAPA
  #undef GAPB
  #undef EX
  #undef VRD
  #undef KRD
  #undef STEP
  #undef ENDW
  {auto rr=__builtin_amdgcn_permlane32_swap(__float_as_uint(l_reg),__float_as_uint(l_reg),false,false);l_reg=__uint_as_float(rr[0])+__uint_as_float(rr[1]);}
  if(MODE==1)l_reg+=__builtin_amdgcn_exp2f(A.sinkl2-mhat);
  if(hi==0)wsf[32+r32]=l_reg;asm volatile("s_waitcnt lgkmcnt(0)":::"memory");
  float rli[16];
  #pragma unroll
  for(int r=0;r<16;++r)rli[r]=__builtin_amdgcn_rcpf(wsf[32+crow(r,hi)]);
  bf16*Ow=A.O+(A.qrow0+wid*QBLK)*dmo;
  { bf16*stg=(bf16*)(shm+LDS_OST)+wid*2048;
    #pragma unroll
    for(int r=0;r<16;++r){const int orow=crow(r,hi);
      #pragma unroll
      for(int d0=0;d0<2;++d0)stg[orow*64+d0*32+r32]=__float2bfloat16(o[d0][r]*rli[r]);}
    asm volatile("s_waitcnt lgkmcnt(0)":::"memory");
    #pragma unroll
    for(int i=0;i<4;++i){const int row=i*8+(lane>>3),ch=lane&7; const u32x4 v=*(const u32x4*)(stg+row*64+ch*8); ATTN_STORE16(Ow+(long)row*dmo+ch*8,v);} }
  asm volatile("s_waitcnt lgkmcnt(0)\n\ts_barrier":::"memory");
  #undef DMA_K
  #undef DMA_V
  #undef START
  #undef RESC
  #undef ROT
}
constexpr int ATTN_LDS_BYTES=LDS_BYTES;
#undef SBAR
#undef WAIT_BAR
}
constexpr int NWAVES = 8;
constexpr size_t MiB = 1u << 20;
#ifndef MK_DEBUG
#define MK_DEBUG 0
#endif
constexpr size_t WS_CTL = 0, CTL_ZERO_BYTES = 4096;
constexpr size_t WS_W_IN = 1 * MiB;
constexpr size_t WS_W_KVM = 10 * MiB;
constexpr size_t WS_W_BR = 11 * MiB;
constexpr size_t WS_W_OUT = 13 * MiB;
constexpr size_t WS_W_GU = 16 * MiB;
constexpr size_t WS_W_DN = 144 * MiB;
constexpr size_t WS_H = 208 * MiB;
constexpr size_t WS_MEMN = 240 * MiB;
constexpr size_t WS_KVM = 241 * MiB;
constexpr size_t WS_LIST = 242 * MiB;
constexpr size_t WS_SLOT = 244 * MiB;
constexpr size_t WS_TOPW = 245 * MiB;
constexpr size_t WS_Y = 246 * MiB;
constexpr size_t WS_MERGED = 278 * MiB;
constexpr size_t WS_X1 = 310 * MiB;
constexpr size_t WS_QKV = 374 * MiB;
constexpr size_t WS_G = 422 * MiB;
#if MK_DEBUG
constexpr size_t WS_ACT = 518 * MiB;
constexpr size_t WS_YS = 662 * MiB;
constexpr size_t WS_H2 = 806 * MiB;
constexpr size_t WS_DBG = 838 * MiB;
constexpr size_t WS_END = 839 * MiB;
#else
constexpr size_t WS_ACT = WS_QKV;
constexpr size_t WS_YS = 518 * MiB;
constexpr size_t WS_H2 = WS_H;
constexpr size_t WS_END = 662 * MiB;
#endif
static_assert((size_t)ACT_ROWS * 1024 * 2 == 144 * MiB && (size_t)T * NQKV * 2 == 48 * MiB && (size_t)T * NG * 2 == 96 * MiB, "map");

constexpr int RING_BYTES = 131072;
constexpr int LX_OFF = RING_BYTES;
constexpr int LDS_BYTES = 147456;

struct Params {
    const float *x, *mem, *norm_mix, *w_in, *qn, *kn, *sink, *norm_mem, *w_kvm, *w_bra, *w_brb, *w_brm, *w_out, *norm_ffn, *w_router, *b_router, *w_gu, *b_gu, *w_dn, *b_dn, *norm_final;
    float* out; unsigned char* ws; int ph_lo, ph_hi;
};

#define LDS_WAIT() asm volatile("s_waitcnt lgkmcnt(0)" ::: "memory")
__device__ __forceinline__ float wave_sum(float v) {
#pragma unroll
    for (int o = 1; o < 64; o <<= 1) v += __shfl_xor(v, o);
    return v;
}
__device__ __forceinline__ void tile_of(int L, int nM, int nN, int& pm, int& pn) {
    const int nwg = nM * nN; int wgid = L;
    { const int q = nwg / 8, r = nwg % 8, xcd = wgid % 8, off = wgid / 8; wgid = (xcd < r ? xcd * (q + 1) : r * (q + 1) + (xcd - r) * q) + off; }
    const int nig = 8 * nN, gid = wgid / nig, fm = gid * 8, gsz = (nM - fm) < 8 ? (nM - fm) : 8;
    pm = fm + ((wgid % nig) % gsz); pn = (wgid % nig) / gsz;
}
struct VA4 { unsigned v0, v1, v2, v3; };
__device__ __forceinline__ VA4 std_va(unsigned lda_bytes) {
    int R0, C0, R1, C1; pg8::lane_piece(0, R0, C0); pg8::lane_piece(1, R1, C1); VA4 r;
    r.v0 = (unsigned)R0 * lda_bytes + (unsigned)C0 * 2u; r.v1 = (unsigned)R1 * lda_bytes + (unsigned)C1 * 2u;
    r.v2 = (unsigned)(R0 + 128) * lda_bytes + (unsigned)C0 * 2u; r.v3 = (unsigned)(R1 + 128) * lda_bytes + (unsigned)C1 * 2u; return r;
}

__device__ __forceinline__ void transpose_item(const float* __restrict__ W, int ldw, int k0, int lbase, bool perm, bf16_t* __restrict__ WT, int ldt, int prow0, int kdst, LAS float* scr, int lane) {
    float v[32];
#pragma unroll
    for (int i = 0; i < 32; ++i) { const int kk = 2 * i + (lane >> 5); v[i] = W[(size_t)(k0 + kk) * ldw + lbase + (lane & 31)]; }
#pragma unroll
    for (int i = 0; i < 32; ++i) { const int kk = 2 * i + (lane >> 5); scr[kk * 33 + (lane & 31)] = v[i]; }
    LDS_WAIT(); asm volatile("" ::: "memory");
    const int c = lane & 7;
#pragma unroll
    for (int j = 0; j < 4; ++j) { const int n = (lane >> 3) + 8 * j; const int ln = perm ? p8perm(n) : n; const LAS float* s = scr + (8 * c) * 33 + ln;
        u32x4 o; o.x = cvt_pk_bf16(s[0 * 33], s[1 * 33]); o.y = cvt_pk_bf16(s[2 * 33], s[3 * 33]); o.z = cvt_pk_bf16(s[4 * 33], s[5 * 33]); o.w = cvt_pk_bf16(s[6 * 33], s[7 * 33]);
        *(u32x4*)(WT + (size_t)(prow0 + n) * ldt + kdst + 8 * c) = o; }
    LDS_WAIT(); asm volatile("" ::: "memory");
}
__device__ __forceinline__ void rms_row_to_bf16(const float* __restrict__ xrow, const float* __restrict__ g, bf16_t* __restrict__ orow, int lane) {
    const f32x4* xr = (const f32x4*)xrow + lane;
    f32x4 v[4]; float s = 0.f;
#pragma unroll
    for (int j = 0; j < 4; ++j) { v[j] = xr[64 * j]; s += (v[j].x * v[j].x + v[j].y * v[j].y) + (v[j].z * v[j].z + v[j].w * v[j].w); }
    const float r = rsqrtf(wave_sum(s) * (1.f / D) + EPS);
    u32x2* o8 = (u32x2*)orow + lane;
#pragma unroll
    for (int j = 0; j < 4; ++j) { const f32x4 gg = ((const f32x4*)g)[lane + 64 * j]; u32x2 w; w.x = cvt_pk_bf16(v[j].x * r * gg.x, v[j].y * r * gg.y); w.y = cvt_pk_bf16(v[j].z * r * gg.z, v[j].w * r * gg.w); o8[64 * j] = w; }
}
__device__ __forceinline__ void p0_prologue(const Params& P, LAS unsigned char* lds, int G) {
    const int tid = threadIdx.x, lane = tid & 63, wave = __builtin_amdgcn_readfirstlane(tid >> 6);
    LAS float* scr = (LAS float*)(lds + wave * 16384);
    const int gw = (int)blockIdx.x * NWAVES + wave, NGW = G * NWAVES;
    bf16_t* W_IN = (bf16_t*)(P.ws + WS_W_IN); bf16_t* W_KVM = (bf16_t*)(P.ws + WS_W_KVM); bf16_t* W_BR = (bf16_t*)(P.ws + WS_W_BR); bf16_t* W_OUT = (bf16_t*)(P.ws + WS_W_OUT);
    bf16_t* W_GU = (bf16_t*)(P.ws + WS_W_GU); bf16_t* W_DN = (bf16_t*)(P.ws + WS_W_DN);
    constexpr int I_IN = 16 * 144, I_KVM = 16 * 16, I_BRA = 6 * 32, I_BRM = 4 * 32, I_OUT = 16 * 32, I_GU = 32 * 16 * 64, I_DN = 32 * 16 * 32;
    constexpr int NITEMS = I_IN + I_KVM + 2 * I_BRA + I_BRM + I_OUT + I_GU + I_DN;
    for (int it = gw; it < NITEMS; it += NGW) {
        int r = it;
        if (r < I_IN) { const int kb = r / 144, g = r % 144, pn = g >> 3, bj = (g >> 2) & 1, wc = g & 3;
            if (pn < 6) transpose_item(P.w_in, INW, 64 * kb, 64 * (4 * pn + wc) + 32 * bj, false, W_IN, 1024, 32 * g, 64 * kb, scr, lane);
            else transpose_item(P.w_in, INW, 64 * kb, 32 * g, true, W_IN, 1024, 32 * g, 64 * kb, scr, lane);
            continue; } r -= I_IN;
        if (r < I_KVM) { const int kb = r / 16, g = r % 16; transpose_item(P.w_kvm, 512, 64 * kb, 32 * g, false, W_KVM, 1024, 32 * g, 64 * kb, scr, lane); continue; } r -= I_KVM;
        if (r < I_BRA) { const int kb = r / 32, g = r % 32; transpose_item(P.w_bra, 1024, 64 * kb, 32 * g, true, W_BR, 1024, 32 * g, 0 + 64 * kb, scr, lane); continue; } r -= I_BRA;
        if (r < I_BRA) { const int kb = r / 32, g = r % 32; transpose_item(P.w_brb, 1024, 64 * kb, 32 * g, true, W_BR, 1024, 32 * g, 384 + 64 * kb, scr, lane); continue; } r -= I_BRA;
        if (r < I_BRM) { const int kb = r / 32, g = r % 32; transpose_item(P.w_brm, 1024, 64 * kb, 32 * g, true, W_BR, 1024, 32 * g, 768 + 64 * kb, scr, lane); continue; } r -= I_BRM;
        if (r < I_OUT) { const int kb = r / 32, g = r % 32; transpose_item(P.w_out, 1024, 64 * kb, 32 * g, false, W_OUT, 1024, 32 * g, 64 * kb, scr, lane); continue; } r -= I_OUT;
        if (r < I_GU) { const int e = r >> 10, r2 = r & 1023, kb = r2 >> 6, g = r2 & 63, pn = g >> 3, bj = (g >> 2) & 1, wc = g & 3;
            transpose_item(P.w_gu + (size_t)e * 1024 * 2048, 2048, 64 * kb, 1024 * bj + 128 * pn + 32 * wc, true, W_GU + (size_t)e * 2048 * 1024, 1024, 32 * g, 64 * kb, scr, lane); continue; } r -= I_GU;
        { const int e = r >> 9, r2 = r & 511, kb = r2 >> 5, g = r2 & 31;
            transpose_item(P.w_dn + (size_t)e * 1024 * 1024, 1024, 64 * kb, 32 * g, true, W_DN + (size_t)e * 1024 * 1024, 1024, 32 * g, 64 * kb, scr, lane); }
    }
    bf16_t* H = (bf16_t*)(P.ws + WS_H); bf16_t* MEMN = (bf16_t*)(P.ws + WS_MEMN);
    for (int m = gw; m < T; m += NGW) rms_row_to_bf16(P.x + (size_t)m * D, P.norm_mix, H + (size_t)m * D, lane);
    for (int m = gw; m < BATCH * NMEM; m += NGW) rms_row_to_bf16(P.mem + (size_t)m * D, P.norm_mem, MEMN + (size_t)m * D, lane);
}

struct SchedP1 {
    const char* H; const char* W; const char* MEMN; const char* WKVM; int G, c; VA4 va;
    __device__ __forceinline__ bool next(int i, pg8::Unit& u) const {
        const int L = i * G + c; constexpr int NMAIN = 64 * 18;
        if (L >= NMAIN + 4) return false;
        u.nt = 16;
        u.va0 = va.v0; u.va1 = va.v1; u.va2 = va.v2; u.va3 = va.v3;
        if (L < NMAIN) { tile_of(L, 64, 18, u.pm, u.pn); u.aux = 0; u.a = H + (size_t)u.pm * 256 * 2048; u.b = W + (size_t)u.pn * 256 * 2048; }
        else { const int l = L - NMAIN; u.pm = l >> 1; u.pn = l & 1; u.aux = 1; u.a = MEMN + (size_t)u.pm * 256 * 2048; u.b = WKVM + (size_t)u.pn * 256 * 2048; }
        return true;
    }
};
struct EpiP1 {
    bf16_t* QKV; bf16_t* Gt; bf16_t* KVM; const float* qn; const float* kn;
    __device__ __forceinline__ void operator()(const f32x4 (&acc)[2][2][4][2], const pg8::Unit& u, int wr, int wc, int fr, int fq) const {
        asm volatile("" : "+v"(fr), "+v"(fq));
        const int row0 = u.pm * 256 + wr * 64 + fr;
        if (u.aux == 1) {
#pragma unroll
            for (int ai = 0; ai < 2; ++ai)
#pragma unroll
                for (int m = 0; m < 4; ++m) { bf16_t* rp = KVM + (size_t)(row0 + 128 * ai + 16 * m) * 512 + u.pn * 256 + 32 * wc + 4 * fq;
#pragma unroll
                    for (int bj = 0; bj < 2; ++bj)
#pragma unroll
                        for (int n = 0; n < 2; ++n) { const f32x4 v = acc[ai][bj][m][n]; u32x2 w; w.x = cvt_pk_bf16(v[0], v[1]); w.y = cvt_pk_bf16(v[2], v[3]); *(u32x2*)(rp + 128 * bj + 16 * n) = w; } }
            return;
        }
        if (u.pn >= 6) {
            const int gc0 = (u.pn - 6) * 256 + 32 * wc + 8 * fq;
#pragma unroll
            for (int ai = 0; ai < 2; ++ai)
#pragma unroll
                for (int m = 0; m < 4; ++m) { bf16_t* rp = Gt + (size_t)(row0 + 128 * ai + 16 * m) * NG + gc0;
#pragma unroll
                    for (int bj = 0; bj < 2; ++bj) { const f32x4 v0 = acc[ai][bj][m][0], v1 = acc[ai][bj][m][1]; u32x4 w;
                        w.x = cvt_pk_bf16(sigmoidf_fast(v0[0]), sigmoidf_fast(v0[1])); w.y = cvt_pk_bf16(sigmoidf_fast(v0[2]), sigmoidf_fast(v0[3]));
                        w.z = cvt_pk_bf16(sigmoidf_fast(v1[0]), sigmoidf_fast(v1[1])); w.w = cvt_pk_bf16(sigmoidf_fast(v1[2]), sigmoidf_fast(v1[3]));
                        *(u32x4*)(rp + 128 * bj) = w; } }
            return;
        }
        const int slot = 4 * u.pn + wc;
        const int type = slot < 6 ? 0 : slot < 8 ? 1 : slot < 10 ? 2 : slot < 16 ? 3 : slot < 18 ? 4 : slot < 20 ? 5 : 6;
        const bool normed = type <= 1, axial = type <= 1, rope1d = (type == 3 || type == 4);
        const float qscale = (type == 0 || type == 3 || type == 6) ? C2 : 1.f;
        f32x4 gg[2][2];
        { const float* gsrc = type == 0 ? qn : kn;
#pragma unroll
          for (int bj = 0; bj < 2; ++bj)
#pragma unroll
            for (int n = 0; n < 2; ++n) gg[bj][n] = normed ? *(const f32x4*)(gsrc + 32 * bj + 16 * n + 4 * fq) : (f32x4){1.f, 1.f, 1.f, 1.f}; }
        float inv_ax[4], inv_b[2][4];
#pragma unroll
        for (int j = 0; j < 4; ++j) { inv_ax[j] = exp2f(-(float)(2 * (4 * fq + j)) * (13.287712379549449f / 32.f));
#pragma unroll
            for (int n = 0; n < 2; ++n) inv_b[n][j] = exp2f(-(float)(2 * (16 * n + 4 * fq + j)) * (13.287712379549449f / 64.f)); }
#pragma unroll
        for (int ai = 0; ai < 2; ++ai)
#pragma unroll
            for (int m = 0; m < 4; ++m) {
                const int row = row0 + 128 * ai + 16 * m, s = row & (SEQ - 1);
                f32x4 v[2][2];
#pragma unroll
                for (int bj = 0; bj < 2; ++bj)
#pragma unroll
                    for (int n = 0; n < 2; ++n) v[bj][n] = acc[ai][bj][m][n];
                if (normed) {
                    float ss = 0.f;
#pragma unroll
                    for (int bj = 0; bj < 2; ++bj)
#pragma unroll
                        for (int n = 0; n < 2; ++n) ss += (v[bj][n][0] * v[bj][n][0] + v[bj][n][1] * v[bj][n][1]) + (v[bj][n][2] * v[bj][n][2] + v[bj][n][3] * v[bj][n][3]);
                    ss += __shfl_xor(ss, 16); ss += __shfl_xor(ss, 32);
                    const float r = rsqrtf(ss * (1.f / 64.f) + EPS);
#pragma unroll
                    for (int bj = 0; bj < 2; ++bj)
#pragma unroll
                        for (int n = 0; n < 2; ++n) v[bj][n] = v[bj][n] * r * gg[bj][n];
                }
                if (axial) {
#pragma unroll
                    for (int bj = 0; bj < 2; ++bj) { const float pos = (float)(bj ? (s & 63) : (s >> 6));
#pragma unroll
                        for (int j = 0; j < 4; ++j) { float sn, c; sincos_red(pos * inv_ax[j], sn, c); const float x1 = v[bj][0][j], x2 = v[bj][1][j]; v[bj][0][j] = x1 * c - x2 * sn; v[bj][1][j] = x2 * c + x1 * sn; } }
                }
                if (rope1d) { const float pos = (float)s;
#pragma unroll
                    for (int n = 0; n < 2; ++n)
#pragma unroll
                        for (int j = 0; j < 4; ++j) { float sn, c; sincos_red(pos * inv_b[n][j], sn, c); const float x1 = v[0][n][j], x2 = v[1][n][j]; v[0][n][j] = x1 * c - x2 * sn; v[1][n][j] = x2 * c + x1 * sn; }
                }
                bf16_t* rp = QKV + (size_t)row * NQKV + 64 * slot + 4 * fq;
#pragma unroll
                for (int bj = 0; bj < 2; ++bj)
#pragma unroll
                    for (int n = 0; n < 2; ++n) { const f32x4 o = v[bj][n] * qscale; u32x2 w; w.x = cvt_pk_bf16(o[0], o[1]); w.y = cvt_pk_bf16(o[2], o[3]); *(u32x2*)(rp + 32 * bj + 16 * n) = w; }
                __builtin_amdgcn_sched_barrier(0);
            }
    }
};

struct SchedP3 {
    const char* Y; const char* W; int G, c; VA4 va;
    __device__ __forceinline__ bool next(int i, pg8::Unit& u) const {
        const int ti = i / 3, br = i - 3 * ti, L = ti * G + c;
        if (L >= 256) return false;
        tile_of(L, 64, 4, u.pm, u.pn); u.aux = br; u.nt = br == 2 ? 4 : 6;
        const size_t kb = (size_t)br * 384 * 2;
        u.va0 = va.v0; u.va1 = va.v1; u.va2 = va.v2; u.va3 = va.v3;
        u.a = Y + (size_t)u.pm * 256 * 2048 + kb; u.b = W + (size_t)u.pn * 256 * 2048 + kb; return true;
    }
};
struct EpiP3 {
    const bf16_t* Gt; bf16_t* MERGED;
    __device__ __forceinline__ void operator()(const f32x4 (&acc)[2][2][4][2], const pg8::Unit& u, int wr, int wc, int fr, int fq) const {
        const int row0 = u.pm * 256 + wr * 64 + fr, col0 = u.pn * 256 + 32 * wc + 8 * fq, br = u.aux;
#pragma unroll
        for (int ai = 0; ai < 2; ++ai)
#pragma unroll
            for (int m = 0; m < 4; ++m) { const size_t row = (size_t)(row0 + 128 * ai + 16 * m);
#pragma unroll
                for (int bj = 0; bj < 2; ++bj) { const u32x4 g8 = *(const u32x4*)(Gt + row * NG + br * 1024 + col0 + 128 * bj); const f32x4 v0 = acc[ai][bj][m][0], v1 = acc[ai][bj][m][1];
                    float o[8] = {v0[0] * bflo(g8.x), v0[1] * bfhi(g8.x), v0[2] * bflo(g8.y), v0[3] * bfhi(g8.y), v1[0] * bflo(g8.z), v1[1] * bfhi(g8.z), v1[2] * bflo(g8.w), v1[3] * bfhi(g8.w)};
                    bf16_t* mp = MERGED + row * 1024 + col0 + 128 * bj;
                    if (br > 0) { const u32x4 p = *(const u32x4*)mp; o[0] += bflo(p.x); o[1] += bfhi(p.x); o[2] += bflo(p.y); o[3] += bfhi(p.y); o[4] += bflo(p.z); o[5] += bfhi(p.z); o[6] += bflo(p.w); o[7] += bfhi(p.w); }
                    u32x4 w; w.x = cvt_pk_bf16(o[0], o[1]); w.y = cvt_pk_bf16(o[2], o[3]); w.z = cvt_pk_bf16(o[4], o[5]); w.w = cvt_pk_bf16(o[6], o[7]);
                    *(u32x4*)mp = w; } }
    }
};
struct SchedP4 {
    const char* A; const char* W; int G, c; VA4 va;
    __device__ __forceinline__ bool next(int i, pg8::Unit& u) const {
        const int L = i * G + c; if (L >= 256) return false;
        tile_of(L, 64, 4, u.pm, u.pn); u.aux = 0; u.nt = 16;
        u.va0 = va.v0; u.va1 = va.v1; u.va2 = va.v2; u.va3 = va.v3;
        u.a = A + (size_t)u.pm * 256 * 2048; u.b = W + (size_t)u.pn * 256 * 2048; return true;
    }
};
struct EpiP4 {
    const float* x; float* X1;
    __device__ __forceinline__ void operator()(const f32x4 (&acc)[2][2][4][2], const pg8::Unit& u, int wr, int wc, int fr, int fq) const {
        const int row0 = u.pm * 256 + wr * 64 + fr, col0 = u.pn * 256 + 32 * wc + 4 * fq;
#pragma unroll
        for (int ai = 0; ai < 2; ++ai)
#pragma unroll
            for (int m = 0; m < 4; ++m) { const size_t off = (size_t)(row0 + 128 * ai + 16 * m) * D + col0;
#pragma unroll
                for (int bj = 0; bj < 2; ++bj)
#pragma unroll
                    for (int n = 0; n < 2; ++n) *(f32x4*)(X1 + off + 128 * bj + 16 * n) = *(const f32x4*)(x + off + 128 * bj + 16 * n) + acc[ai][bj][m][n]; }
    }
};

__device__ __forceinline__ int wr_off(int r, int q) { const int pr = (r & ~3) | ((r & 1) << 1) | ((r >> 1) & 1); return pr * 32 + ((q ^ ((r >> 2) & 7)) << 2); }
__device__ __forceinline__ void p5_router(const Params& P, LAS unsigned char* lds, int G) {
    const int tid = threadIdx.x, lane = tid & 63, wave = __builtin_amdgcn_readfirstlane(tid >> 6);
    LAS float* wl = (LAS float*)lds;
    LAS int* lcnt = (LAS int*)(lds + LX_OFF);
    LAS int* lbase = lcnt + 32;
    LAS int* pe = lbase + 32;
    LAS int* plp = pe + 256;
    const float* X1 = (const float*)(P.ws + WS_X1); bf16_t* H = (bf16_t*)(P.ws + WS_H2);
    int* gcnt = (int*)(P.ws + WS_CTL); int* LIST = (int*)(P.ws + WS_LIST); int* SLOT = (int*)(P.ws + WS_SLOT); float* TOPW = (float*)(P.ws + WS_TOPW);
    for (int u = tid; u < 1024 * 8; u += NWAVES * 64) { const int r = u >> 3, q = u & 7; *(LAS f32x4*)(wl + wr_off(r, q)) = *(const f32x4*)(P.w_router + (size_t)r * 32 + 4 * q); }
    f32x2 gn[8];
#pragma unroll
    for (int j = 0; j < 8; ++j) gn[j] = *(const f32x2*)(P.norm_ffn + 2 * lane + 128 * j);
    const float bias = P.b_router[lane & 31];
    for (int blk = blockIdx.x; blk < T / 64; blk += G) {
        if (tid < 32) lcnt[tid] = 0;
        __syncthreads();
        for (int tl = wave * 8; tl < wave * 8 + 8; ++tl) {
            const int t = blk * 64 + tl;
            f32x2 v[8]; float ss = 0.f;
#pragma unroll
            for (int j = 0; j < 8; ++j) { v[j] = *(const f32x2*)(X1 + (size_t)t * D + 2 * lane + 128 * j); ss += v[j].x * v[j].x + v[j].y * v[j].y; }
            const float rs = rsqrtf(wave_sum(ss) * (1.f / D) + EPS);
            float a[32];
#pragma unroll
            for (int e = 0; e < 32; ++e) a[e] = 0.f;
#pragma unroll
            for (int j = 0; j < 8; ++j) {
                v[j].x = v[j].x * rs * gn[j].x; v[j].y = v[j].y * rs * gn[j].y;
                *(unsigned*)(H + (size_t)t * D + 2 * lane + 128 * j) = cvt_pk_bf16(v[j].x, v[j].y);
#pragma unroll
                for (int c = 0; c < 2; ++c) { const int r = 2 * lane + 128 * j + c; const float hv = c ? v[j].y : v[j].x;
#pragma unroll
                    for (int q = 0; q < 8; ++q) { const f32x4 w4 = *(const LAS f32x4*)(wl + wr_off(r, q)); a[4 * q] = fmaf(hv, w4.x, a[4 * q]); a[4 * q + 1] = fmaf(hv, w4.y, a[4 * q + 1]); a[4 * q + 2] = fmaf(hv, w4.z, a[4 * q + 2]); a[4 * q + 3] = fmaf(hv, w4.w, a[4 * q + 3]); } }
            }
            float b16[16], b8[8], b4[4], b2[2], b1;
            { const bool hi = lane & 1;
#pragma unroll
              for (int k = 0; k < 16; ++k) { const float keep = hi ? a[2 * k + 1] : a[2 * k], send = hi ? a[2 * k] : a[2 * k + 1]; b16[k] = keep + __shfl_xor(send, 1); } }
            { const bool hi = lane & 2;
#pragma unroll
              for (int k = 0; k < 8; ++k) { const float keep = hi ? b16[2 * k + 1] : b16[2 * k], send = hi ? b16[2 * k] : b16[2 * k + 1]; b8[k] = keep + __shfl_xor(send, 2); } }
            { const bool hi = lane & 4;
#pragma unroll
              for (int k = 0; k < 4; ++k) { const float keep = hi ? b8[2 * k + 1] : b8[2 * k], send = hi ? b8[2 * k] : b8[2 * k + 1]; b4[k] = keep + __shfl_xor(send, 4); } }
            { const bool hi = lane & 8;
#pragma unroll
              for (int k = 0; k < 2; ++k) { const float keep = hi ? b4[2 * k + 1] : b4[2 * k], send = hi ? b4[2 * k] : b4[2 * k + 1]; b2[k] = keep + __shfl_xor(send, 8); } }
            { const bool hi = lane & 16; const float keep = hi ? b2[1] : b2[0], send = hi ? b2[0] : b2[1]; b1 = keep + __shfl_xor(send, 16); }
            float logit = b1 + __shfl_xor(b1, 32) + bias;
            const int e = lane & 31;
            float vals[4]; int idxs[4]; float cur = logit;
#pragma unroll
            for (int k = 0; k < 4; ++k) {
                float bv = cur; int bi = e;
#pragma unroll
                for (int o = 1; o < 32; o <<= 1) { const float ov = __shfl_xor(bv, o); const int oi = __shfl_xor(bi, o); if (ov > bv || (ov == bv && oi < bi)) { bv = ov; bi = oi; } }
                vals[k] = bv; idxs[k] = bi; if (e == bi) cur = -3.0e38f;
            }
            float ex[4], sum = 0.f;
#pragma unroll
            for (int k = 0; k < 4; ++k) { ex[k] = __expf(vals[k] - vals[0]); sum += ex[k]; }
            if (lane < 4) {
                const int k = lane;
                const int ee = k == 0 ? idxs[0] : k == 1 ? idxs[1] : k == 2 ? idxs[2] : idxs[3];
                const float ev = k == 0 ? ex[0] : k == 1 ? ex[1] : k == 2 ? ex[2] : ex[3];
                const int lp = __hip_atomic_fetch_add(lcnt + ee, 1, __ATOMIC_RELAXED, __HIP_MEMORY_SCOPE_WORKGROUP);
                pe[tl * 4 + k] = ee; plp[tl * 4 + k] = lp;
                TOPW[(size_t)t * 4 + k] = ev / sum;
            }
        }
        __syncthreads();
        if (tid < 32) lbase[tid] = atomicAdd(gcnt + tid, lcnt[tid]);
        __syncthreads();
        if (tid < 256) { const int ee = pe[tid], pos = lbase[ee] + plp[tid], pair = blk * 256 + tid; LIST[(size_t)ee * T + pos] = pair; SLOT[pair] = (ee << 16) | pos; }
        __syncthreads();
    }
}

__device__ __forceinline__ void moe_tables(const Params& P, LAS unsigned char* lds) {
    const int tid = threadIdx.x;
    LAS int* tb = (LAS int*)(lds + LX_OFF + 4096);
    const int* gcnt = (const int*)(P.ws + WS_CTL);
    if (tid == 0) { int s = 0; for (int e = 0; e < 32; ++e) { tb[e] = s; s += (gcnt[e] + 255) >> 8; } tb[32] = s; }
    __syncthreads();
}
template <int NPN, bool GATHER> struct SchedMoe {
    const char* A; const char* W; const int* LIST; const int* gcnt; const LAS int* tb; int G, c; VA4 va; size_t wstride;
    __device__ __forceinline__ bool next(int i, pg8::Unit& u) const {
        const int L = i * G + c, total = tb[32] * NPN;
        if (L >= total) return false;
        const int mtg = L / NPN, pn = L - mtg * NPN;
        int e = 0;
#pragma unroll
        for (int k = 1; k < 32; ++k) e += (tb[k] <= mtg) ? 1 : 0;
        u.pm = mtg; u.pn = pn; u.aux = e; u.nt = 16;
        u.b = W + (size_t)e * wstride + (size_t)pn * 256 * 2048;
        if constexpr (GATHER) {
            const int r0 = (mtg - tb[e]) * 256, ce = gcnt[e];
            int R0, C0, R1, C1; pg8::lane_piece(0, R0, C0); pg8::lane_piece(1, R1, C1);
            const int* le = LIST + (size_t)e * T;
            const int ra = r0 + R0, rb = r0 + R1, rc = r0 + 128 + R0, rd = r0 + 128 + R1;
            const int ta = ra < ce ? (le[ra] >> 2) : 0, tb2 = rb < ce ? (le[rb] >> 2) : 0, tc = rc < ce ? (le[rc] >> 2) : 0, td = rd < ce ? (le[rd] >> 2) : 0;
            u.va0 = (unsigned)ta * 2048u + (unsigned)C0 * 2u; u.va1 = (unsigned)tb2 * 2048u + (unsigned)C1 * 2u; u.va2 = (unsigned)tc * 2048u + (unsigned)C0 * 2u; u.va3 = (unsigned)td * 2048u + (unsigned)C1 * 2u;
            u.a = A;
        } else {
            u.va0 = va.v0; u.va1 = va.v1; u.va2 = va.v2; u.va3 = va.v3;
            u.a = A + (size_t)mtg * 256 * 2048;
        }
        return true;
    }
};
struct EpiP6 {
    const float* b_gu; bf16_t* ACT;
    __device__ __forceinline__ void operator()(const f32x4 (&acc)[2][2][4][2], const pg8::Unit& u, int wr, int wc, int fr, int fq) const {
        const int row0 = u.pm * 256 + wr * 64 + fr, col0 = u.pn * 128 + 32 * wc + 8 * fq;
        const float* bp = b_gu + (size_t)u.aux * 2048 + col0;
        const f32x4 bg0 = *(const f32x4*)bp, bg1 = *(const f32x4*)(bp + 4), bl0 = *(const f32x4*)(bp + 1024), bl1 = *(const f32x4*)(bp + 1028);
#pragma unroll
        for (int ai = 0; ai < 2; ++ai)
#pragma unroll
            for (int m = 0; m < 4; ++m) {
                float o[8];
#pragma unroll
                for (int n = 0; n < 2; ++n) { const f32x4 g4 = acc[ai][0][m][n] + (n ? bg1 : bg0), l4 = acc[ai][1][m][n] + (n ? bl1 : bl0);
#pragma unroll
                    for (int j = 0; j < 4; ++j) { const float g = fminf(g4[j], 7.f), l = fminf(fmaxf(l4[j], -7.f), 7.f); o[4 * n + j] = g * __builtin_amdgcn_rcpf(1.f + __builtin_amdgcn_exp2f(-1.702f * LOG2E * g)) * (l + 1.f); } }
                u32x4 w; w.x = cvt_pk_bf16(o[0], o[1]); w.y = cvt_pk_bf16(o[2], o[3]); w.z = cvt_pk_bf16(o[4], o[5]); w.w = cvt_pk_bf16(o[6], o[7]);
                *(u32x4*)(ACT + (size_t)(row0 + 128 * ai + 16 * m) * 1024 + col0) = w; }
    }
};
struct EpiP7 {
    const float* b_dn; bf16_t* YS;
    __device__ __forceinline__ void operator()(const f32x4 (&acc)[2][2][4][2], const pg8::Unit& u, int wr, int wc, int fr, int fq) const {
        const int row0 = u.pm * 256 + wr * 64 + fr, col0 = u.pn * 256 + 32 * wc + 8 * fq;
        const float* bp = b_dn + (size_t)u.aux * 1024 + col0;
        f32x4 bb[2][2];
#pragma unroll
        for (int bj = 0; bj < 2; ++bj) { bb[bj][0] = *(const f32x4*)(bp + 128 * bj); bb[bj][1] = *(const f32x4*)(bp + 128 * bj + 4); }
#pragma unroll
        for (int ai = 0; ai < 2; ++ai)
#pragma unroll
            for (int m = 0; m < 4; ++m)
#pragma unroll
                for (int bj = 0; bj < 2; ++bj) { const f32x4 v0 = acc[ai][bj][m][0] + bb[bj][0], v1 = acc[ai][bj][m][1] + bb[bj][1];
                    u32x4 w; w.x = cvt_pk_bf16(v0[0], v0[1]); w.y = cvt_pk_bf16(v0[2], v0[3]); w.z = cvt_pk_bf16(v1[0], v1[1]); w.w = cvt_pk_bf16(v1[2], v1[3]);
                    *(u32x4*)(YS + (size_t)(row0 + 128 * ai + 16 * m) * 1024 + col0 + 128 * bj) = w; }
    }
};

__device__ __forceinline__ void p8_final(const Params& P, LAS unsigned char* lds, int G) {
    const int tid = threadIdx.x, lane = tid & 63, wave = __builtin_amdgcn_readfirstlane(tid >> 6);
    const LAS int* tb = (const LAS int*)(lds + LX_OFF + 4096);
    const float* X1 = (const float*)(P.ws + WS_X1); const bf16_t* YS = (const bf16_t*)(P.ws + WS_YS); const int* SLOT = (const int*)(P.ws + WS_SLOT); const float* TOPW = (const float*)(P.ws + WS_TOPW);
    const int gw = (int)blockIdx.x * NWAVES + wave, NGW = G * NWAVES;
    for (int t = gw; t < T; t += NGW) {
        f32x4 v[4];
#pragma unroll
        for (int j = 0; j < 4; ++j) v[j] = *((const f32x4*)(X1 + (size_t)t * D) + lane + 64 * j);
#pragma unroll
        for (int k = 0; k < 4; ++k) { const int sl = SLOT[t * 4 + k]; const float w = TOPW[t * 4 + k]; const size_t row = (size_t)tb[sl >> 16] * 256 + (sl & 0xffff);
#pragma unroll
            for (int j = 0; j < 4; ++j) { const u32x2 y = *((const u32x2*)(YS + row * 1024) + lane + 64 * j); v[j].x += w * bflo(y.x); v[j].y += w * bfhi(y.x); v[j].z += w * bflo(y.y); v[j].w += w * bfhi(y.y); } }
        float s = 0.f;
#pragma unroll
        for (int j = 0; j < 4; ++j) s += (v[j].x * v[j].x + v[j].y * v[j].y) + (v[j].z * v[j].z + v[j].w * v[j].w);
        const float r = rsqrtf(wave_sum(s) * (1.f / D) + EPS);
#pragma unroll
        for (int j = 0; j < 4; ++j) { const f32x4 gg = ((const f32x4*)P.norm_final)[lane + 64 * j]; *((f32x4*)(P.out + (size_t)t * D) + lane + 64 * j) = v[j] * r * gg; }
    }
}
__device__ __forceinline__ void attn_desc_A(const Params& P, int idx, attn_body::AttnDesc& A) {
    using attn_body::bf16;
    const int b = idx / 192, rem = idx % 192, hq = rem >> 5, qb = rem & 31;
    const bf16* QKV = (const bf16*)(P.ws + WS_QKV); bf16* Y = (bf16*)(P.ws + WS_Y);
    A.Q = QKV + C_QA + hq * 64; A.K = QKV + C_KA + (hq / 3) * 64; A.V = QKV + C_VA + (hq / 3) * 64; A.O = Y + hq * 64;
    A.dmq = NQKV; A.dmk = NQKV; A.dmo = D; A.qrow0 = (long)b * SEQ + qb * 256; A.krow0 = (long)b * SEQ; A.NT = SEQ / 64; A.dpos0 = 0; A.sinkl2 = 0.f;
}
__device__ __forceinline__ void attn_desc_B(const Params& P, int idx, attn_body::AttnDesc& A) {
    using attn_body::bf16;
    const int b = idx / 192, rem = idx % 192, hq = rem >> 5, qb = rem & 31;
    const bf16* QKV = (const bf16*)(P.ws + WS_QKV); bf16* Y = (bf16*)(P.ws + WS_Y);
    const int q0 = qb * 256, kt0 = q0 >= 128 ? q0 - 128 : 0, kend = (q0 + 384 <= SEQ) ? q0 + 384 : SEQ;
    A.Q = QKV + C_QB + hq * 64; A.K = QKV + C_KB + (hq / 3) * 64; A.V = QKV + C_VB + (hq / 3) * 64; A.O = Y + 384 + hq * 64;
    A.dmq = NQKV; A.dmk = NQKV; A.dmo = D; A.qrow0 = (long)b * SEQ + q0; A.krow0 = (long)b * SEQ + kt0; A.NT = (kend - kt0) / 64; A.dpos0 = kt0 - q0; A.sinkl2 = P.sink[hq] * LOG2E;
}
__device__ __forceinline__ void attn_desc_M(const Params& P, int idx, attn_body::AttnDesc& A) {
    using attn_body::bf16;
    const int b = idx >> 7, rem = idx & 127, hm = rem >> 5, qb = rem & 31;
    const bf16* QKV = (const bf16*)(P.ws + WS_QKV); const bf16* KVM = (const bf16*)(P.ws + WS_KVM); bf16* Y = (bf16*)(P.ws + WS_Y);
    A.Q = QKV + C_QM + hm * 64; A.K = KVM + hm * 64; A.V = KVM + 256 + hm * 64; A.O = Y + 768 + hm * 64;
    A.dmq = NQKV; A.dmk = 512; A.dmo = D; A.qrow0 = (long)b * SEQ + qb * 256; A.krow0 = (long)b * NMEM; A.NT = NMEM / 64; A.dpos0 = 0; A.sinkl2 = 0.f;
}
#ifndef MK_ATTN_MODES
#define MK_ATTN_MODES 3
#endif
__device__ __forceinline__ void p2_attention(const Params& P, char* lds, int G) {
    const int c = blockIdx.x;
    int nA, a0, a1, nB, b0, nM, m0;
    if (G == 256) { if (c < 128) { nA = 2; a0 = c; a1 = 256 + c; nB = 0; b0 = 0; nM = 0; m0 = 0; } else { nA = 1; a0 = c; a1 = 0; nB = 3; b0 = 3 * (c - 128); nM = 2; m0 = 2 * (c - 128); } }
    else { nA = 0; a0 = a1 = 0; nB = 0; b0 = 0; nM = 0; m0 = 0; }
    if (G == 256) {
        for (int k = 0; k < nA + nM; ++k) { attn_body::AttnDesc A; if (k < nA) attn_desc_A(P, k == 0 ? a0 : a1, A); else attn_desc_M(P, m0 + (k - nA), A);
            if (MK_ATTN_MODES & 1) attn_body::attn_unit<8, 0>(A, lds); }
        for (int k = 0; k < nB; ++k) { attn_body::AttnDesc A; attn_desc_B(P, b0 + k, A); if (MK_ATTN_MODES & 2) attn_body::attn_unit<8, 1>(A, lds); }
    } else {
        for (int u = c; u < 384 + 256; u += G) { attn_body::AttnDesc A; if (u < 384) attn_desc_A(P, u, A); else attn_desc_M(P, u - 384, A); if (MK_ATTN_MODES & 1) attn_body::attn_unit<8, 0>(A, lds); }
        for (int u = c; u < 384; u += G) { attn_body::AttnDesc A; attn_desc_B(P, u, A); if (MK_ATTN_MODES & 2) attn_body::attn_unit<8, 1>(A, lds); }
    }
}

__global__ void __launch_bounds__(NWAVES * 64, 2) mk_fwd(Params P) {
    extern __shared__ __attribute__((aligned(16))) unsigned char lds_raw[];
    LAS unsigned char* lds = (LAS unsigned char*)lds_raw;
    cg::grid_group grid = cg::this_grid();
    const int G = gridDim.x, c = blockIdx.x;
    unsigned char* ws = P.ws;
#ifndef MK_PHASE_MASK
#define MK_PHASE_MASK 0x1ff
#endif
#define IN(k) (((MK_PHASE_MASK >> (k)) & 1) && P.ph_lo <= (k) && (k) < P.ph_hi)
#define SEAM(k) do { if (IN(k) && IN((k) + 1)) grid.sync(); } while (0)
    if (IN(0)) p0_prologue(P, lds, G);
    SEAM(0);
    if (IN(1)) {
        SchedP1 S; S.H = (const char*)(ws + WS_H); S.W = (const char*)(ws + WS_W_IN); S.MEMN = (const char*)(ws + WS_MEMN); S.WKVM = (const char*)(ws + WS_W_KVM); S.G = G; S.c = c; S.va = std_va(2048u);
        EpiP1 E{(bf16_t*)(ws + WS_QKV), (bf16_t*)(ws + WS_G), (bf16_t*)(ws + WS_KVM), P.qn, P.kn};
        pg8::gemm_phase<EpiP1, SchedP1, true>(lds, S, E, 2048u);
    }
    SEAM(1);
    if (IN(2)) p2_attention(P, (char*)lds_raw, G);
    SEAM(2);
    if (IN(3)) {
        SchedP3 S; S.Y = (const char*)(ws + WS_Y); S.W = (const char*)(ws + WS_W_BR); S.G = G; S.c = c; S.va = std_va(2048u);
        EpiP3 E{(const bf16_t*)(ws + WS_G), (bf16_t*)(ws + WS_MERGED)};
        pg8::gemm_phase<EpiP3, SchedP3, false>(lds, S, E, 2048u);
    }
    SEAM(3);
    if (IN(4)) {
        SchedP4 S; S.A = (const char*)(ws + WS_MERGED); S.W = (const char*)(ws + WS_W_OUT); S.G = G; S.c = c; S.va = std_va(2048u);
        EpiP4 E{P.x, (float*)(ws + WS_X1)};
        pg8::gemm_phase<EpiP4, SchedP4, false>(lds, S, E, 2048u);
    }
    SEAM(4);
    if (IN(5)) p5_router(P, lds, G);
    SEAM(5);
    if (IN(6)) {
        moe_tables(P, lds);
        SchedMoe<8, true> S; S.A = (const char*)(ws + WS_H2); S.W = (const char*)(ws + WS_W_GU); S.LIST = (const int*)(ws + WS_LIST); S.gcnt = (const int*)(ws + WS_CTL);
        S.tb = (const LAS int*)(lds + LX_OFF + 4096); S.G = G; S.c = c; S.wstride = (size_t)2048 * 2048; S.va = std_va(2048u);
        EpiP6 E{P.b_gu, (bf16_t*)(ws + WS_ACT)};
        pg8::gemm_phase<EpiP6, SchedMoe<8, true>, true>(lds, S, E, 2048u);
    }
    SEAM(6);
    if (IN(7)) {
        moe_tables(P, lds);
        SchedMoe<4, false> S; S.A = (const char*)(ws + WS_ACT); S.W = (const char*)(ws + WS_W_DN); S.LIST = nullptr; S.gcnt = (const int*)(ws + WS_CTL);
        S.tb = (const LAS int*)(lds + LX_OFF + 4096); S.G = G; S.c = c; S.wstride = (size_t)1024 * 2048; S.va = std_va(2048u);
        EpiP7 E{P.b_dn, (bf16_t*)(ws + WS_YS)};
        pg8::gemm_phase<EpiP7, SchedMoe<4, false>, true>(lds, S, E, 2048u);
    }
    SEAM(7);
    if (IN(8)) { moe_tables(P, lds); p8_final(P, lds, G); }
#undef IN
#undef SEAM
}
#if MK_DEBUG
#ifndef MK_VSEL
#define MK_VSEL 1
#endif
#ifndef MK_CK_ROUND
#define MK_CK_ROUND 1
#endif
#if MK_CK_ROUND == 1
enum { CK_P0 = 0, CK_QKA = 1, CK_QKB = 2, CK_V = 3, CK_G = 4, CK_KVM = 5, CK_AA = 6, CK_AB = 7, CK_AM = 8, CK_P3 = 9, CK_P4 = 9, CK_P5 = 9, CK_P6 = 9, CK_P7 = 9, CK_P8 = 9 };
#else
enum { CK_P0 = 0, CK_QKA = 0, CK_QKB = 0, CK_V = 0, CK_G = 0, CK_KVM = 0, CK_AA = 1, CK_AB = 2, CK_AM = 3, CK_P3 = 4, CK_P4 = 5, CK_P5 = 6, CK_P6 = 7, CK_P7 = 8, CK_P8 = 9 };
#endif
__device__ __forceinline__ void chk(unsigned* cnts, int k, float got, float ref, float atol, float rtol) {
    atomicAdd(cnts + 2 * k, 1u);
    const bool bad = !(fabsf(got - ref) <= atol + rtol * fabsf(ref));
    if (bad) atomicAdd(cnts + 2 * k + 1, 1u);
}
__global__ void chk_p0(Params P, unsigned* cnts) {
    const int wv = (blockIdx.x * blockDim.x + threadIdx.x) >> 6, lane = threadIdx.x & 63;
    const int nH = (T + 60) / 61, nM = (BATCH * NMEM + 6) / 7;
    if (wv >= nH + nM) return;
    const bool isH = wv < nH; const int row = isH ? wv * 61 : (wv - nH) * 7;
    const float* xr = isH ? P.x + (size_t)row * D : P.mem + (size_t)row * D; const float* g = isH ? P.norm_mix : P.norm_mem;
    const bf16_t* hr = (const bf16_t*)(P.ws + (isH ? WS_H : WS_MEMN)) + (size_t)row * D;
    float s = 0.f; for (int i = lane; i < D; i += 64) s += xr[i] * xr[i];
    s = wave_sum(s); const float r = rsqrtf(s / D + EPS);
    for (int i = lane; i < D; i += 64) chk(cnts, CK_P0, bf2f(hr[i]), xr[i] * r * g[i], 0.02f, 0.01f);
}
__global__ void chk_p1_heads(Params P, unsigned* cnts) {
    const int idx = blockIdx.x * blockDim.x + threadIdx.x; const int nR = (T + 36) / 37;
    if (idx >= nR * 24) return;
    const int row = (idx / 24) * 37, slot = idx % 24, s = row & (SEQ - 1);
    const bf16_t* hr = (const bf16_t*)(P.ws + WS_H) + (size_t)row * D;
    float v[64];
#pragma unroll
    for (int d = 0; d < 64; ++d) v[d] = 0.f;
    for (int k = 0; k < D; ++k) { const float hv = bf2f(hr[k]); const float* wrow = P.w_in + (size_t)k * INW + 64 * slot;
#pragma unroll
        for (int d = 0; d < 64; ++d) v[d] = fmaf(hv, wrow[d], v[d]); }
    const int type = slot < 6 ? 0 : slot < 8 ? 1 : slot < 10 ? 2 : slot < 16 ? 3 : slot < 18 ? 4 : slot < 20 ? 5 : 6;
    if (type <= 1) { float ss = 0.f;
#pragma unroll
        for (int d = 0; d < 64; ++d) ss += v[d] * v[d];
        const float r = rsqrtf(ss / 64.f + EPS); const float* g = type == 0 ? P.qn : P.kn;
#pragma unroll
        for (int d = 0; d < 64; ++d) v[d] = v[d] * r * g[d];
#pragma unroll
        for (int half = 0; half < 2; ++half) { const float pos = half ? (float)(s % 64) : (float)(s / 64);
#pragma unroll
            for (int i = 0; i < 16; ++i) { const float inv = exp2f(-(float)(2 * i) / 32.f * 13.287712379549449f); float c, sn; sincos_red(pos * inv, sn, c);
                const float x1 = v[half * 32 + i], x2 = v[half * 32 + 16 + i]; v[half * 32 + i] = x1 * c - x2 * sn; v[half * 32 + 16 + i] = x2 * c + x1 * sn; } } }
    if (type == 3 || type == 4) {
#pragma unroll
        for (int i = 0; i < 32; ++i) { const float inv = exp2f(-(float)(2 * i) / 64.f * 13.287712379549449f); float c, sn; sincos_red((float)s * inv, sn, c);
            const float x1 = v[i], x2 = v[32 + i]; v[i] = x1 * c - x2 * sn; v[32 + i] = x2 * c + x1 * sn; } }
    const float sc = (type == 0 || type == 3 || type == 6) ? C2 : 1.f;
    const bf16_t* q = (const bf16_t*)(P.ws + WS_QKV) + (size_t)row * NQKV + 64 * slot;
#pragma unroll
    for (int d = 0; d < 64; ++d) chk(cnts, type <= 1 ? CK_QKA : (type == 3 || type == 4) ? CK_QKB : CK_V, bf2f(q[d]), v[d] * sc, 0.012f * sc, 0.012f);
}
__global__ void chk_p1_gates(Params P, unsigned* cnts) {
    const int idx = blockIdx.x * blockDim.x + threadIdx.x; const int nR = (T + 100) / 101, nK = (BATCH * NMEM + 4) / 5;
    if (idx < nR * NG) { const int row = (idx / NG) * 101, col = idx % NG;
        const bf16_t* hr = (const bf16_t*)(P.ws + WS_H) + (size_t)row * D; float a = 0.f;
        for (int k = 0; k < D; ++k) a = fmaf(bf2f(hr[k]), P.w_in[(size_t)k * INW + 1536 + col], a);
        { const float got = bf2f(((const bf16_t*)(P.ws + WS_G))[(size_t)row * NG + col]), ref = 1.f / (1.f + expf(-a));
          chk(cnts, CK_G, got, ref, 0.015f, 0.f);
          if (!(fabsf(got - ref) <= 0.015f)) { atomicAdd(cnts + 64 + col / 256, 1u); atomicAdd(cnts + 80 + ((col & 255) >> 5), 1u); atomicAdd(cnts + 96 + ((row & 255) >> 4), 1u); atomicAdd(cnts + 112 + (col & 31), 1u); } }
        return; }
    const int j = idx - nR * NG; if (j >= nK * 512) return;
    const int row = (j / 512) * 5, col = j % 512;
    const bf16_t* mr = (const bf16_t*)(P.ws + WS_MEMN) + (size_t)row * D; float a = 0.f;
    for (int k = 0; k < D; ++k) a = fmaf(bf2f(mr[k]), P.w_kvm[(size_t)k * 512 + col], a);
    chk(cnts, CK_KVM, bf2f(((const bf16_t*)(P.ws + WS_KVM))[(size_t)row * 512 + col]), a, 0.04f, 0.03f);
}
__global__ void __launch_bounds__(64) chk_p2(Params P, unsigned* cnts) {
    const int idx = blockIdx.x * blockDim.x + threadIdx.x; const int nR = (T + 96) / 97;
    if (idx >= nR * 16) return;
    const int row = (idx / 16) * 97, hd = idx % 16, b = row / SEQ, i = row % SEQ;
    const bf16_t* QKV = (const bf16_t*)(P.ws + WS_QKV); const bf16_t* KVM = (const bf16_t*)(P.ws + WS_KVM);
    const bf16_t *qp, *kp, *vp; int ldk, klo, khi; long kr0; float sk2 = 0.f; bool hassink = false; int ycol;
    if (hd < 6) { qp = QKV + (size_t)row * NQKV + C_QA + hd * 64; kp = QKV + C_KA + (hd / 3) * 64; vp = QKV + C_VA + (hd / 3) * 64; ldk = NQKV; kr0 = (long)b * SEQ; klo = 0; khi = SEQ; ycol = hd * 64; }
    else if (hd < 12) { const int h = hd - 6; qp = QKV + (size_t)row * NQKV + C_QB + h * 64; kp = QKV + C_KB + (h / 3) * 64; vp = QKV + C_VB + (h / 3) * 64; ldk = NQKV; kr0 = (long)b * SEQ;
        klo = i - 128 < 0 ? 0 : i - 128; khi = i + 129 > SEQ ? SEQ : i + 129; sk2 = P.sink[h] * LOG2E; hassink = true; ycol = 384 + h * 64; }
    else { const int h = hd - 12; qp = QKV + (size_t)row * NQKV + C_QM + h * 64; kp = KVM + h * 64; vp = KVM + 256 + h * 64; ldk = 512; kr0 = (long)b * NMEM; klo = 0; khi = NMEM; ycol = 768 + h * 64; }
    float q[64], o[64];
#pragma unroll
    for (int d = 0; d < 64; ++d) { q[d] = bf2f(qp[d]); o[d] = 0.f; }
    float m = -1.0e30f, l = 0.f;
    for (int j = klo; j < khi; ++j) {
        const bf16_t* kr = kp + (size_t)(kr0 + j) * ldk; float a = 0.f;
#pragma unroll
        for (int d = 0; d < 64; ++d) a = fmaf(q[d], bf2f(kr[d]), a);
        if (a > m) { const float f = exp2f(m - a); l *= f;
#pragma unroll
            for (int d = 0; d < 64; ++d) o[d] *= f;
            m = a; }
        const float p = exp2f(a - m); l += p; const bf16_t* vr = vp + (size_t)(kr0 + j) * ldk;
#pragma unroll
        for (int d = 0; d < 64; ++d) o[d] = fmaf(p, bf2f(vr[d]), o[d]);
    }
    if (hassink) l += exp2f(sk2 - m);
    const bf16_t* y = (const bf16_t*)(P.ws + WS_Y) + (size_t)row * D + ycol;
#pragma unroll
    for (int d = 0; d < 64; ++d) chk(cnts, hd < 6 ? CK_AA : hd < 12 ? CK_AB : CK_AM, bf2f(y[d]), o[d] / l, 0.006f, 0.04f);
}
__global__ void chk_p3(Params P, unsigned* cnts) {
    const int idx = blockIdx.x * blockDim.x + threadIdx.x; const int nR = (T + 52) / 53;
    if (idx >= nR * D) return;
    const int row = (idx / D) * 53, col = idx % D;
    const bf16_t* y = (const bf16_t*)(P.ws + WS_Y) + (size_t)row * D; const bf16_t* g = (const bf16_t*)(P.ws + WS_G) + (size_t)row * NG;
    float a = 0.f, b = 0.f, c = 0.f;
    for (int k = 0; k < 384; ++k) { a = fmaf(bf2f(y[k]), P.w_bra[(size_t)k * D + col], a); b = fmaf(bf2f(y[384 + k]), P.w_brb[(size_t)k * D + col], b); }
    for (int k = 0; k < 256; ++k) c = fmaf(bf2f(y[768 + k]), P.w_brm[(size_t)k * D + col], c);
    const float ref = bf2f(g[col]) * a + bf2f(g[D + col]) * b + bf2f(g[2 * D + col]) * c;
    chk(cnts, CK_P3, bf2f(((const bf16_t*)(P.ws + WS_MERGED))[(size_t)row * D + col]), ref, 0.01f, 0.04f);
}
__global__ void chk_p4(Params P, unsigned* cnts) {
    const int idx = blockIdx.x * blockDim.x + threadIdx.x; const int nR = (T + 58) / 59;
    if (idx >= nR * D) return;
    const int row = (idx / D) * 59, col = idx % D;
    const bf16_t* mr = (const bf16_t*)(P.ws + WS_MERGED) + (size_t)row * D; float a = 0.f;
    for (int k = 0; k < D; ++k) a = fmaf(bf2f(mr[k]), P.w_out[(size_t)k * D + col], a);
    chk(cnts, CK_P4, ((const float*)(P.ws + WS_X1))[(size_t)row * D + col], P.x[(size_t)row * D + col] + a, 0.01f, 0.02f);
}
__global__ void chk_p5(Params P, unsigned* cnts) {
    const int wv = (blockIdx.x * blockDim.x + threadIdx.x) >> 6, lane = threadIdx.x & 63; const int nR = (T + 12) / 13;
    if (wv >= nR) return;
    const int t = wv * 13; const float* xr = (const float*)(P.ws + WS_X1) + (size_t)t * D; const bf16_t* hr = (const bf16_t*)(P.ws + WS_H2) + (size_t)t * D;
    float s = 0.f; for (int i = lane; i < D; i += 64) s += xr[i] * xr[i];
    s = wave_sum(s); const float r = rsqrtf(s / D + EPS);
    for (int i = lane; i < D; i += 64) chk(cnts, CK_P5, bf2f(hr[i]), xr[i] * r * P.norm_ffn[i], 0.02f, 0.01f);
    const int e = lane & 31, half = lane >> 5; float a = 0.f;
    for (int k = half * 512; k < half * 512 + 512; ++k) a = fmaf(xr[k] * r * P.norm_ffn[k], P.w_router[k * NE + e], a);
    a += __shfl_xor(a, 32); a += P.b_router[e];
    float vals[4]; int idxs[4]; float cur = a;
#pragma unroll
    for (int k = 0; k < 4; ++k) { float bv = cur; int bi = e;
#pragma unroll
        for (int o = 1; o < 32; o <<= 1) { const float ov = __shfl_xor(bv, o); const int oi = __shfl_xor(bi, o); if (ov > bv || (ov == bv && oi < bi)) { bv = ov; bi = oi; } }
        vals[k] = bv; idxs[k] = bi; if (e == bi) cur = -3.0e38f; }
    float ex[4], sum = 0.f;
#pragma unroll
    for (int k = 0; k < 4; ++k) { ex[k] = expf(vals[k] - vals[0]); sum += ex[k]; }
    if (lane < 4) { const int k = lane; const int ee = k == 0 ? idxs[0] : k == 1 ? idxs[1] : k == 2 ? idxs[2] : idxs[3]; const float ev = k == 0 ? ex[0] : k == 1 ? ex[1] : k == 2 ? ex[2] : ex[3];
        const int sl = ((const int*)(P.ws + WS_SLOT))[t * 4 + k]; const int se = sl >> 16, pos = sl & 0xffff;
        chk(cnts, CK_P5, (float)se, (float)ee, 0.f, 0.f);
        chk(cnts, CK_P5, ((const float*)(P.ws + WS_TOPW))[t * 4 + k], ev / sum, 0.002f, 0.f);
        const int cn = ((const int*)(P.ws + WS_CTL))[se & 31];
        chk(cnts, CK_P5, pos < cn ? (float)((const int*)(P.ws + WS_LIST))[(size_t)(se & 31) * T + pos] : -1.f, (float)(t * 4 + k), 0.f, 0.f); }
    if (wv == 0 && lane == 0) { int tot = 0; for (int k = 0; k < NE; ++k) tot += ((const int*)(P.ws + WS_CTL))[k]; chk(cnts, CK_P5, (float)tot, (float)(T * TOPK), 0.f, 0.f); }
}
__device__ __forceinline__ void dbg_tb(const Params& P, int e, int& tbe, int& ce) { const int* gc = (const int*)(P.ws + WS_CTL); int s = 0; for (int k = 0; k < e; ++k) s += (gc[k] + 255) >> 8; tbe = s; ce = gc[e]; }
__global__ void chk_p6(Params P, unsigned* cnts) {
    const int idx = blockIdx.x * blockDim.x + threadIdx.x; if (idx >= NE * 8 * FF) return;
    const int e = idx / (8 * FF), i = (idx / FF) % 8, col = idx % FF; int tbe, ce; dbg_tb(P, e, tbe, ce); if (ce == 0) return;
    const int r = (i * 97 + 5) % ce; const int tok = ((const int*)(P.ws + WS_LIST))[(size_t)e * T + r] >> 2;
    const bf16_t* hr = (const bf16_t*)(P.ws + WS_H2) + (size_t)tok * D; const float* w = P.w_gu + (size_t)e * D * 2 * FF; float g = 0.f, l = 0.f;
    for (int k = 0; k < D; ++k) { const float hv = bf2f(hr[k]); g = fmaf(hv, w[(size_t)k * 2 * FF + col], g); l = fmaf(hv, w[(size_t)k * 2 * FF + FF + col], l); }
    g += P.b_gu[e * 2 * FF + col]; l += P.b_gu[e * 2 * FF + FF + col]; g = fminf(g, 7.f); l = fminf(fmaxf(l, -7.f), 7.f);
    const float ref = g * (1.f / (1.f + expf(-1.702f * g))) * (l + 1.f);
    chk(cnts, CK_P6, bf2f(((const bf16_t*)(P.ws + WS_ACT))[((size_t)tbe * 256 + r) * FF + col]), ref, 0.03f, 0.04f);
}
__global__ void chk_p7(Params P, unsigned* cnts) {
    const int idx = blockIdx.x * blockDim.x + threadIdx.x; if (idx >= NE * 8 * D) return;
    const int e = idx / (8 * D), i = (idx / D) % 8, col = idx % D; int tbe, ce; dbg_tb(P, e, tbe, ce); if (ce == 0) return;
    const int r = (i * 89 + 3) % ce; const bf16_t* ar = (const bf16_t*)(P.ws + WS_ACT) + ((size_t)tbe * 256 + r) * FF; const float* w = P.w_dn + (size_t)e * FF * D; float a = 0.f;
    for (int k = 0; k < FF; ++k) a = fmaf(bf2f(ar[k]), w[(size_t)k * D + col], a);
    a += P.b_dn[e * D + col];
    chk(cnts, CK_P7, bf2f(((const bf16_t*)(P.ws + WS_YS))[((size_t)tbe * 256 + r) * D + col]), a, 0.03f, 0.04f);
}
__global__ void chk_p8(Params P, unsigned* cnts) {
    const int wv = (blockIdx.x * blockDim.x + threadIdx.x) >> 6, lane = threadIdx.x & 63; const int nR = (T + 10) / 11;
    if (wv >= nR) return;
    const int t = wv * 11; float v[16]; float s = 0.f;
#pragma unroll
    for (int j = 0; j < 16; ++j) { const int col = lane + 64 * j; float a = ((const float*)(P.ws + WS_X1))[(size_t)t * D + col];
        for (int k = 0; k < 4; ++k) { const int sl = ((const int*)(P.ws + WS_SLOT))[t * 4 + k]; int tbe, ce; dbg_tb(P, sl >> 16, tbe, ce);
            a += ((const float*)(P.ws + WS_TOPW))[t * 4 + k] * bf2f(((const bf16_t*)(P.ws + WS_YS))[((size_t)tbe * 256 + (sl & 0xffff)) * D + col]); }
        v[j] = a; s += a * a; }
    s = wave_sum(s); const float r = rsqrtf(s / D + EPS);
#pragma unroll
    for (int j = 0; j < 16; ++j) { const int col = lane + 64 * j; chk(cnts, CK_P8, P.out[(size_t)t * D + col], v[j] * r * P.norm_final[col], 0.01f, 0.01f); }
}
__global__ void dbg_select(float* out, int n, const unsigned* cnts) {
    float c = 0.f;
    for (int k = 1; k <= 9; ++k) { const unsigned tot = cnts[2 * k], bad = cnts[2 * k + 1];
        if (bad > 0 || tot == 0) { const float fr = tot ? (float)bad / (float)tot : 1.f; c = (float)k + (fr < 0.01f ? 0.f : fr < 0.1f ? 0.25f : fr < 0.5f ? 0.5f : 0.75f); break; } }
    if (c == 0.f) return;
    int ngt = 0, nc = 0, nr = 0; for (int i = 0; i < 12; ++i) ngt += cnts[64 + i] ? 1 : 0; for (int i = 0; i < 8; ++i) nc += cnts[80 + i] ? 1 : 0; for (int i = 0; i < 16; ++i) nr += cnts[96 + i] ? 1 : 0;
    int no = 0; for (int i = 0; i < 32; ++i) no += cnts[112 + i] ? 1 : 0;
    int v = MK_VSEL == 0 ? (ngt > 0 ? (ngt - 1) * 8 + (nc - 1) : 0) : (no + 33 * (nr >= 9 ? 1 : 0)); if (v > 89) v = 89;
    for (int i = blockIdx.x * blockDim.x + threadIdx.x; i < n; i += gridDim.x * blockDim.x) out[i] = (i == 0) ? 1000.f + 100.f * (float)v : c;
}
#endif

#ifndef MK_PH_HI
#define MK_PH_HI 9
#endif
extern "C" void kernel_launch(void* const* d_in, const int* in_sizes, int n_in, void* d_out, int out_size, void* d_ws, size_t ws_size, hipStream_t stream) {
    static int grid = 0;
    if (grid == 0) {
        if (n_in != 21 || out_size != T * D || ws_size < WS_END) { fprintf(stderr, "kernel_launch: unexpected problem (n_in %d, out %d, ws %zu < %zu)\n", n_in, out_size, ws_size, (size_t)WS_END); grid = -1; return; }
        int dev = 0, cus = 0, per_cu = 0;
        (void)hipGetDevice(&dev); (void)hipDeviceGetAttribute(&cus, hipDeviceAttributeMultiprocessorCount, dev);
        if (hipFuncSetAttribute((const void*)mk_fwd, hipFuncAttributeMaxDynamicSharedMemorySize, LDS_BYTES) != hipSuccess) { fprintf(stderr, "kernel_launch: hipFuncSetAttribute failed\n"); grid = -1; return; }
        if (hipOccupancyMaxActiveBlocksPerMultiprocessor(&per_cu, (const void*)mk_fwd, NWAVES * 64, LDS_BYTES) != hipSuccess || per_cu < 1) { fprintf(stderr, "kernel_launch: occupancy query says %d\n", per_cu); grid = -1; (void)hipGetLastError(); return; }
        grid = cus;
    }
    if (grid < 0) return;
    (void)hipMemsetAsync((char*)d_ws + WS_CTL, 0, CTL_ZERO_BYTES, stream);
    Params p{};
    const float** dst = (const float**)&p;
    for (int i = 0; i < 21; ++i) dst[i] = (const float*)d_in[i];
    p.out = (float*)d_out; p.ws = (unsigned char*)d_ws; p.ph_lo = 0; p.ph_hi = MK_PH_HI;
    void* args[] = {&p};
    const hipError_t e = hipLaunchCooperativeKernel((const void*)mk_fwd, dim3(grid), dim3(NWAVES * 64), args, LDS_BYTES, stream);
    if (e != hipSuccess) fprintf(stderr, "kernel_launch: cooperative launch failed: %s (grid %d)\n", hipGetErrorString(e), grid);
#if MK_DEBUG
    unsigned* cnts = (unsigned*)((char*)d_ws + WS_DBG);
    (void)hipMemsetAsync(cnts, 0, 1024, stream);
    chk_p0<<<(((T + 60) / 61 + (BATCH * NMEM + 6) / 7) * 64 + 255) / 256, 256, 0, stream>>>(p, cnts);
    chk_p1_heads<<<(((T + 36) / 37) * 24 + 63) / 64, 64, 0, stream>>>(p, cnts);
    chk_p1_gates<<<(((T + 100) / 101) * NG + ((BATCH * NMEM + 4) / 5) * 512 + 255) / 256, 256, 0, stream>>>(p, cnts);
    chk_p2<<<(((T + 96) / 97) * 16 + 63) / 64, 64, 0, stream>>>(p, cnts);
    chk_p3<<<(((T + 52) / 53) * D + 255) / 256, 256, 0, stream>>>(p, cnts);
    chk_p4<<<(((T + 58) / 59) * D + 255) / 256, 256, 0, stream>>>(p, cnts);
    chk_p5<<<(((T + 12) / 13) * 64 + 255) / 256, 256, 0, stream>>>(p, cnts);
    chk_p6<<<(NE * 8 * FF + 255) / 256, 256, 0, stream>>>(p, cnts);
    chk_p7<<<(NE * 8 * D + 255) / 256, 256, 0, stream>>>(p, cnts);
    chk_p8<<<(((T + 10) / 11) * 64 + 255) / 256, 256, 0, stream>>>(p, cnts);
    dbg_select<<<1024, 256, 0, stream>>>((float*)d_out, out_size, cnts);
#endif
}
```

```cpp
#define MK_DEBUG 0
#include <hip/hip_runtime.h>
#include <hip/hip_cooperative_groups.h>
#include <hip/hip_bf16.h>
#include <cstdio>
#include <cstdint>
namespace cg = cooperative_groups;

namespace cfg {
constexpr int D = 1024, BATCH = 2, SEQ = 8192, T = BATCH * SEQ;
constexpr int HD = 64, NMEM = 256, NE = 32, TOPK = 4, FF = 1024;
constexpr int INW = 4608, NQKV = 1536, NG = 3072;
constexpr int C_QA = 0, C_KA = 384, C_VA = 512, C_QB = 640, C_KB = 1024, C_VB = 1152, C_QM = 1280;
constexpr float EPS = 1e-6f;
constexpr float C2 = 0.125f * 1.4426950408889634f;
constexpr float LOG2E = 1.4426950408889634f;
constexpr int ACT_ROWS = T * TOPK + NE * 256;
}
using namespace cfg;

typedef unsigned short bf16_t;
typedef short bf16x8 __attribute__((ext_vector_type(8)));
typedef float f32x4 __attribute__((ext_vector_type(4)));
typedef float f32x2 __attribute__((ext_vector_type(2)));
typedef unsigned u32x4 __attribute__((ext_vector_type(4)));
typedef unsigned u32x2 __attribute__((ext_vector_type(2)));
typedef int i32x4 __attribute__((ext_vector_type(4)));
typedef int i32x8 __attribute__((ext_vector_type(8)));
#define LAS __attribute__((address_space(3)))

typedef __bf16 bf16x2_nat __attribute__((ext_vector_type(2)));
__device__ __forceinline__ unsigned cvt_pk_bf16(float lo, float hi) { f32x2 v = {lo, hi}; bf16x2_nat b = __builtin_convertvector(v, bf16x2_nat); return __builtin_bit_cast(unsigned, b); }
__device__ __forceinline__ float bf2f(unsigned short v) { return __uint_as_float((unsigned)v << 16); }
__device__ __forceinline__ float bflo(unsigned v) { return __uint_as_float(v << 16); }
__device__ __forceinline__ float bfhi(unsigned v) { return __uint_as_float(v & 0xffff0000u); }
__device__ __forceinline__ void sincos_red(float ang, float& sn, float& c) {
    const float n = rintf(ang * 0.15915494309189535f);
    float r = fmaf(-n, 6.28318548202514648f, ang); r = fmaf(-n, -1.74845553e-7f, r);
    const float rev = r * 0.15915494309189535f;
    sn = __builtin_amdgcn_sinf(rev); c = __builtin_amdgcn_cosf(rev);
}
__device__ __forceinline__ float sigmoidf_fast(float v) { return __builtin_amdgcn_rcpf(1.f + __builtin_amdgcn_exp2f(-v * LOG2E)); }
__host__ __device__ __forceinline__ int p8perm(int i) { return 8 * ((i >> 2) & 3) + 4 * (i >> 4) + (i & 3); }

namespace pg8 {
constexpr int BM = 256, BK = 64, HALF = 128, HTB = HALF * BK * 2, STAGE_BYTES = 8 * HTB;
__host__ __device__ __forceinline__ int lds_byte(int r, int c) { const int st = (r >> 4) * 2 + (c >> 5), rr = r & 15, cc = c & 31, ob = rr * 64 + cc * 2; return st * 1024 + (ob ^ (((ob >> 9) & 1) << 5)); }
__host__ __device__ __forceinline__ void stage_rc(int b, int& R, int& C) { const int st = b / 1024, sb = b % 1024, swz = sb ^ (((sb >> 9) & 1) << 5); R = (st >> 1) * 16 + swz / 64; C = (st & 1) * 32 + (swz % 64) / 2; }

struct Unit { int pm, pn, aux, nt; const char* a; const char* b; unsigned va0, va1, va2, va3; };

template <class Epi, class Sched, bool ALIGN_EPI, int MM = 0  >
__device__ __forceinline__ void gemm_phase(LAS unsigned char* lds, const Sched& S, const Epi& E, const unsigned ldb_bytes) {
    const int tid = threadIdx.x, wid = __builtin_amdgcn_readfirstlane(tid >> 6), lane = tid & 63, wr = wid >> 2, wc = wid & 3, fr = lane & 15, fq = lane >> 4;
    unsigned voffB[2];
#pragma unroll
    for (int i = 0; i < 2; ++i) { int R, C; stage_rc(tid * 16 + i * 8192, R, C); voffB[i] = (unsigned)R * ldb_bytes + (unsigned)C * 2u; }
    const size_t kstep = (size_t)(BK * 2);
    const size_t hstepB = (size_t)HALF * ldb_bytes;
    const unsigned ldsw = (unsigned)wid * 1024u;
    const int aoff = lds_byte(wr * 64 + fr, fq * 8), boff = lds_byte(wc * 32 + fr, fq * 8);
#define PG8_SA(b, h) (((b) * 2 + (h)) * HTB)
#define PG8_SB(b, h) ((4 + (b) * 2 + (h)) * HTB)
#define PG8_GLDS(src, dstoff) __builtin_amdgcn_global_load_lds((const unsigned*)(src), (LAS unsigned*)(lds + (dstoff)), 16, 0, 0)
#define PG8_STAGE_B(bufoff, gbase) do { PG8_GLDS((const char*)(gbase) + voffB[0], (bufoff) + ldsw); PG8_GLDS((const char*)(gbase) + voffB[1], (bufoff) + ldsw + 8192); } while (0)
#define PG8_STAGE_A(bufoff, gbase, v0, v1) do { PG8_GLDS((const char*)(gbase) + (v0), (bufoff) + ldsw); PG8_GLDS((const char*)(gbase) + (v1), (bufoff) + ldsw + 8192); } while (0)
#define PG8_LDF(dstf, addr) do { if constexpr (MM == 2) { const i32x4 lo_ = *(const LAS i32x4*)(addr), hi_ = *(const LAS i32x4*)((addr) + 1024); (dstf).w = __builtin_shufflevector(lo_, hi_, 0, 1, 2, 3, 4, 5, 6, 7); } \
        else { (dstf).h[0] = *(const LAS bf16x8*)(addr); (dstf).h[1] = *(const LAS bf16x8*)((addr) + 1024); } } while (0)
#define PG8_LDA(dst, b, h) do { _Pragma("unroll") for (int m = 0; m < 4; ++m) PG8_LDF(dst[m], lds + PG8_SA(b, h) + aoff + m * 2048); } while (0)
#define PG8_LDB(dst, b, h) do { _Pragma("unroll") for (int n = 0; n < 2; ++n) PG8_LDF(dst[n], lds + PG8_SB(b, h) + boff + n * 2048); } while (0)
#define PG8_MMA(ai, bj, At, Bt) do { if constexpr (MM == 2) __builtin_amdgcn_sched_barrier(0); __builtin_amdgcn_s_setprio(1); _Pragma("unroll") for (int m = 0; m < 4; ++m) _Pragma("unroll") for (int n = 0; n < 2; ++n) { \
        if constexpr (MM == 2) asm volatile("v_mfma_scale_f32_16x16x128_f8f6f4 %0, %1, %2, %0, %3, %3 op_sel_hi:[0,0,0]" : "+v"(acc[ai][bj][m][n]) : "v"(Bt[n].w), "v"(At[m].w), "v"(mxscale));   \
        else { _Pragma("unroll") for (int k = 0; k < 2; ++k) { \
          if constexpr (MM == 1) acc[ai][bj][m][n] = __builtin_bit_cast(f32x4, __builtin_amdgcn_mfma_i32_16x16x64_i8(__builtin_bit_cast(i32x4, Bt[n].h[k]), __builtin_bit_cast(i32x4, At[m].h[k]), __builtin_bit_cast(i32x4, acc[ai][bj][m][n]), 0, 0, 0)); \
          else acc[ai][bj][m][n] = __builtin_amdgcn_mfma_f32_16x16x32_bf16(Bt[n].h[k], At[m].h[k], acc[ai][bj][m][n], 0, 0, 0); } } } __builtin_amdgcn_s_setprio(0); if constexpr (MM == 2) __builtin_amdgcn_sched_barrier(0); } while (0)
#define PG8_WAIT_V(n) asm volatile("s_waitcnt vmcnt(" #n ")" ::: "memory")
#define PG8_WAIT_L(n) asm volatile("s_waitcnt lgkmcnt(" #n ")" ::: "memory")
#define PG8_BAR __builtin_amdgcn_s_barrier()
#define PG8_SCHED __builtin_amdgcn_sched_barrier(0)
    Unit cur, nxt; int ui = 0;
    if (!S.next(0, cur)) return;
    f32x4 acc[2][2][4][2];
#pragma unroll
    for (int a = 0; a < 2; ++a)
#pragma unroll
        for (int b = 0; b < 2; ++b)
#pragma unroll
            for (int m = 0; m < 4; ++m)
#pragma unroll
                for (int n = 0; n < 2; ++n) acc[a][b][m][n] = (f32x4){0.f, 0.f, 0.f, 0.f};
    int mxscale = 0x7f7f7f7f; asm volatile("" : "+v"(mxscale));
    struct Frag { bf16x8 h[2]; i32x8 w; };
    Frag At[4], B0[2], B1[2];
    const char* cA = cur.a; const char* cB = cur.b;
    PG8_STAGE_B(PG8_SB(0, 0), cB); PG8_STAGE_B(PG8_SB(0, 1), cB + hstepB); PG8_STAGE_A(PG8_SA(0, 0), cA, cur.va0, cur.va1); PG8_STAGE_A(PG8_SA(0, 1), cA, cur.va2, cur.va3);
    if (wr == 1) PG8_BAR;
    PG8_WAIT_V(2); PG8_BAR;
    PG8_STAGE_B(PG8_SB(1, 0), cB + kstep); PG8_STAGE_A(PG8_SA(1, 0), cA + kstep, cur.va0, cur.va1); PG8_STAGE_B(PG8_SB(1, 1), cB + hstepB + kstep);
    PG8_WAIT_V(6); PG8_BAR;
    for (;;) {
        const bool has_next = S.next(ui + 1, nxt);
        const char* nA = cA; const char* nB = cB; unsigned n0 = cur.va0, n1 = cur.va1, n2 = cur.va2, n3 = cur.va3;
        if (has_next) { nA = nxt.a; nB = nxt.b; n0 = nxt.va0; n1 = nxt.va1; n2 = nxt.va2; n3 = nxt.va3; }
        const int nt = cur.nt & 0xffff; const bool lowhalf = (cur.nt >> 16) != 0;
        for (int t = 0; t < nt; t += 2) {
            const bool last = (t == nt - 2);
            const char* a1 = cA + (size_t)(t + 1) * kstep;
            const char* a2 = last ? nA : cA + (size_t)(t + 2) * kstep; const char* b2 = last ? nB : cB + (size_t)(t + 2) * kstep;
            const char* a3 = a2 + kstep; const char* b3 = b2 + kstep;
            const unsigned w0 = last ? n0 : cur.va0, w1 = last ? n1 : cur.va1, w2 = last ? n2 : cur.va2, w3 = last ? n3 : cur.va3;
            PG8_LDB(B0, 0, 0); PG8_LDB(B1, 0, 1); PG8_SCHED; PG8_LDA(At, 0, 0); PG8_STAGE_A(PG8_SA(1, 1), a1, cur.va2, cur.va3);
            PG8_WAIT_V(8); PG8_WAIT_L(0); PG8_BAR; PG8_MMA(0, 0, At, B0); PG8_MMA(0, 1, At, B1); PG8_BAR; PG8_SCHED;
            PG8_LDA(At, 0, 1); PG8_STAGE_B(PG8_SB(0, 0), b2); PG8_STAGE_B(PG8_SB(0, 1), b2 + hstepB); PG8_STAGE_A(PG8_SA(0, 0), a2, w0, w1);
            PG8_WAIT_V(8); PG8_WAIT_L(0); PG8_BAR; if (!lowhalf) { PG8_MMA(1, 0, At, B0); PG8_MMA(1, 1, At, B1); } PG8_BAR; PG8_SCHED;
            PG8_LDB(B0, 1, 0); PG8_LDB(B1, 1, 1); PG8_SCHED; PG8_LDA(At, 1, 0); PG8_STAGE_A(PG8_SA(0, 1), a2, w2, w3);
            PG8_WAIT_V(8); PG8_WAIT_L(0); PG8_BAR; PG8_MMA(0, 0, At, B0); PG8_MMA(0, 1, At, B1); PG8_BAR; PG8_SCHED;
            PG8_LDA(At, 1, 1); PG8_STAGE_B(PG8_SB(1, 0), b3); PG8_STAGE_B(PG8_SB(1, 1), b3 + hstepB); PG8_STAGE_A(PG8_SA(1, 0), a3, w0, w1);
            PG8_WAIT_V(8); PG8_WAIT_L(0); PG8_BAR; if (!lowhalf) { PG8_MMA(1, 0, At, B0); PG8_MMA(1, 1, At, B1); } PG8_BAR; PG8_SCHED;
        }
        if constexpr (MM == 2) asm volatile("s_nop 15\n\ts_nop 15" ::: "memory");
        if constexpr (ALIGN_EPI) { if (wr == 0) PG8_BAR; }
        E(acc, cur, wr, wc, fr, fq);
        if (!has_next) break;
        if (!E.keep(cur)) {
#pragma unroll
        for (int a = 0; a < 2; ++a)
#pragma unroll
            for (int b = 0; b < 2; ++b)
#pragma unroll
                for (int m = 0; m < 4; ++m)
#pragma unroll
                    for (int n = 0; n < 2; ++n) acc[a][b][m][n] = (f32x4){0.f, 0.f, 0.f, 0.f};
        }
        cur = nxt; cA = nA; cB = nB; ++ui;
        if constexpr (ALIGN_EPI) { if (wr == 1) PG8_BAR; }
    }
    PG8_WAIT_V(0);
    if constexpr (!ALIGN_EPI) { if (wr == 0) PG8_BAR; }
    PG8_BAR;
#undef PG8_SA
#undef PG8_SB
#undef PG8_GLDS
#undef PG8_STAGE_A
#undef PG8_STAGE_B
#undef PG8_LDA
#undef PG8_LDB
#undef PG8_MMA
#undef PG8_WAIT_V
#undef PG8_WAIT_L
#undef PG8_BAR
#undef PG8_SCHED
}
__device__ __forceinline__ void lane_piece(int i, int& R, int& C) { stage_rc((int)threadIdx.x * 16 + i * 8192, R, C); }
}
namespace attn_body {
using bf16=__hip_bfloat16;
using bf16x8=__attribute__((ext_vector_type(8)))short;
using s16x4=__attribute__((ext_vector_type(4)))short;
using f32x16=__attribute__((ext_vector_type(16)))float;
using u32x4=__attribute__((ext_vector_type(4)))unsigned;
constexpr int D=64;
constexpr int NW=8,QBLK=32,QB=QBLK*NW,KVBLK=64;
struct AttnDesc { const bf16* Q; const bf16* K; const bf16* V; bf16* O; int dmq, dmk, dmo; long qrow0, krow0; int NT; int dpos0; float sinkl2; float fixref; };
__device__ __forceinline__ void wmask_c(f32x16&c0,f32x16&c1,const f32x16&negm,int d,int hi){
  const float NEG=-INFINITY; int kb=d+4*hi+128; asm volatile("":"+v"(kb));
  #pragma unroll
  for(int r=0;r<16;++r){const unsigned kv=(unsigned)(kb+(r&3)+8*(r>>2)); c0[r]=(kv>256u)?NEG:negm[r]; c1[r]=(kv+32u>256u)?NEG:negm[r];}
}
__device__ __forceinline__ int crow(int r,int hi){return (r&3)+8*(r>>2)+4*hi;}
#define SBAR() __builtin_amdgcn_sched_barrier(0)
constexpr int NSLOT=3, SLOTB=8192;
constexpr int LDS_K=0, LDS_V=NSLOT*SLOTB, LDS_WS=2*NSLOT*SLOTB, LDS_OST=LDS_WS+NW*64*4, LDS_BYTES=LDS_OST+NW*4096;
__device__ __forceinline__ void glds16(const void*gsrc,unsigned lds_dst){unsigned keep;
  asm volatile("s_mov_b32 %0, m0\n\ts_mov_b32 m0, %2\n\ts_nop 0\n\tglobal_load_lds_dwordx4 %1, off\n\ts_mov_b32 m0, %0":"=&s"(keep):"v"(gsrc),"s"(lds_dst):"memory");}
__device__ __forceinline__ float max3f(float a,float b,float c){float r;asm("v_max3_f32 %0, %1, %2, %3":"=v"(r):"v"(a),"v"(b),"v"(c));return r;}
__device__ __forceinline__ float max2f(float a,float b){float r;asm("v_max_f32_e32 %0, %1, %2":"=v"(r):"v"(a),"v"(b));return r;}
__device__ __forceinline__ float fadd_s(float a,float b){float r;asm("v_add_f32_e32 %0, %1, %2":"=v"(r):"v"(a),"v"(b));return r;}
__device__ __forceinline__ float fsub_s(float a,float b){float r;asm("v_sub_f32_e32 %0, %1, %2":"=v"(r):"v"(a),"v"(b));return r;}
typedef float f32x2_t __attribute__((ext_vector_type(2))); typedef __bf16 bf16x2_t __attribute__((ext_vector_type(2)));
__device__ __forceinline__ unsigned cvtpk_s(float lo,float hi){f32x2_t v={lo,hi};bf16x2_t b=__builtin_convertvector(v,bf16x2_t);return __builtin_bit_cast(unsigned,b);}
#define WAIT_BAR(N) asm volatile("s_waitcnt vmcnt(" #N ") lgkmcnt(0)\n\ts_barrier":::"memory")

__device__ __forceinline__ void qkt(f32x16&p0,f32x16&p1,const char*Kslot,const bf16x8*qr,const f32x16&c0,const f32x16&c1,int r32,int hi){
  const char*kb=Kslot+hi*1024+r32*16;
  #pragma unroll
  for(int d0=0;d0<4;++d0){
    const bf16x8 b0=*reinterpret_cast<const bf16x8*>(kb+d0*2048);
    const bf16x8 b1=*reinterpret_cast<const bf16x8*>(kb+d0*2048+512);
    if(d0==0){p0=__builtin_amdgcn_mfma_f32_32x32x16_bf16(b0,qr[0],c0,0,0,0);p1=__builtin_amdgcn_mfma_f32_32x32x16_bf16(b1,qr[0],c1,0,0,0);}
    else{p0=__builtin_amdgcn_mfma_f32_32x32x16_bf16(b0,qr[d0],p0,0,0,0);p1=__builtin_amdgcn_mfma_f32_32x32x16_bf16(b1,qr[d0],p1,0,0,0);}}
}
typedef __attribute__((address_space(3))) const char* lds_cptr;
typedef short v4i16_t __attribute__((ext_vector_type(4)));
__device__ __forceinline__ void kload8(bf16x8*kf,lds_cptr kp){
  kf[0]=*(const __attribute__((address_space(3))) bf16x8*)(kp);      kf[1]=*(const __attribute__((address_space(3))) bf16x8*)(kp+512);
  kf[2]=*(const __attribute__((address_space(3))) bf16x8*)(kp+2048); kf[3]=*(const __attribute__((address_space(3))) bf16x8*)(kp+2560);
  kf[4]=*(const __attribute__((address_space(3))) bf16x8*)(kp+4096); kf[5]=*(const __attribute__((address_space(3))) bf16x8*)(kp+4608);
  kf[6]=*(const __attribute__((address_space(3))) bf16x8*)(kp+6144); kf[7]=*(const __attribute__((address_space(3))) bf16x8*)(kp+6656);
}
__device__ __forceinline__ void kload2(bf16x8*kf,lds_cptr kp,int j){ kf[2*j]=*(const __attribute__((address_space(3))) bf16x8*)(kp+j*2048); kf[2*j+1]=*(const __attribute__((address_space(3))) bf16x8*)(kp+j*2048+512); }
__device__ __forceinline__ s16x4 vtr(lds_cptr p){ return __builtin_bit_cast(s16x4,__builtin_amdgcn_ds_read_tr16_b64_v4i16((__attribute__((address_space(3))) v4i16_t*)p)); }
__device__ __forceinline__ float rowmax(const f32x16&p0,const f32x16&p1){
  float a=max3f(p0[0],p0[1],p1[0]),b=max3f(p0[2],p0[3],p1[1]);a=max3f(a,p1[2],p1[3]);
  #pragma unroll
  for(int r=4;r<16;r+=4){a=max3f(a,p0[r],p0[r+1]);b=max3f(b,p0[r+2],p0[r+3]);a=max3f(a,p1[r],p1[r+1]);b=max3f(b,p1[r+2],p1[r+3]);}
  const float m=max2f(a,b);
  auto rr=__builtin_amdgcn_permlane32_swap(__float_as_uint(m),__float_as_uint(m),false,false);
  return max2f(__uint_as_float(rr[0]),__uint_as_float(rr[1]));
}
__device__ __forceinline__ void pv(f32x16*o,int vb,bf16x8 pa0,bf16x8 pa1,bf16x8 pa2,bf16x8 pa3){
  #pragma unroll
  for(int d0=0;d0<2;++d0){s16x4 lo[4],hi[4];
    #pragma unroll
    for(int ks=0;ks<4;++ks){
      asm volatile("ds_read_b64_tr_b16 %0,%1 offset:%c2":"=&v"(lo[ks]):"v"(vb),"i"(d0*4096+ks*1024):"memory");
      asm volatile("ds_read_b64_tr_b16 %0,%1 offset:%c2":"=&v"(hi[ks]):"v"(vb),"i"(d0*4096+ks*1024+512):"memory");}
    asm volatile("s_waitcnt lgkmcnt(0)":::"memory");SBAR();
    #define PK(k) (bf16x8){lo[k][0],lo[k][1],lo[k][2],lo[k][3],hi[k][0],hi[k][1],hi[k][2],hi[k][3]}
    o[d0]=__builtin_amdgcn_mfma_f32_32x32x16_bf16(pa0,PK(0),o[d0],0,0,0);
    o[d0]=__builtin_amdgcn_mfma_f32_32x32x16_bf16(pa1,PK(1),o[d0],0,0,0);
    o[d0]=__builtin_amdgcn_mfma_f32_32x32x16_bf16(pa2,PK(2),o[d0],0,0,0);
    o[d0]=__builtin_amdgcn_mfma_f32_32x32x16_bf16(pa3,PK(3),o[d0],0,0,0);
    #undef PK
  }
}

#ifndef ATTN_STORE16
#define ATTN_STORE16(p,v) (*(u32x4*)(p)=(v))
#endif
template<int THRL,int MODE> __device__ __forceinline__ void attn_unit(const AttnDesc&A,char*shm){
  const int tid=threadIdx.x,lane=tid&63,r32=lane&31,hi=lane>>5; const int wid=__builtin_amdgcn_readfirstlane(tid>>6);
  const int dmq=A.dmq,dmk=A.dmk,dmo=A.dmo;
  const bf16*Qw=A.Q+(A.qrow0+wid*QBLK)*dmq;
  const bf16*Kh=A.K+A.krow0*dmk,*Vh=A.V+A.krow0*dmk;
  const unsigned lds0=(unsigned)(uintptr_t)shm;
  float*wsf=(float*)(shm+LDS_WS)+wid*64;
  const bf16*ksrc=Kh+(long)lane*dmk+wid*8;
  const bf16*vsrc=Vh+(long)(16*(wid&3)+(lane>>2))*dmk+(wid>>2)*32+(lane&3)*8;
  const unsigned kdst=lds0+LDS_K+wid*1024, vdst=lds0+LDS_V+wid*1024;
  #define DMA_K(t,slot) glds16(ksrc+(long)(t)*KVBLK*dmk,(unsigned)__builtin_amdgcn_readfirstlane(kdst+(slot)))
  #define DMA_V(t,slot) glds16(vsrc+(long)(t)*KVBLK*dmk,(unsigned)__builtin_amdgcn_readfirstlane(vdst+(slot)))
  const int vb0=(int)(lds0+LDS_V)+((lane>>4)&1)*32+(lane&3)*8+(4*hi+((lane&15)>>2))*64;
  const char*Kbase=shm+LDS_K; bf16x8 kf[8];
  const lds_cptr shm3=(lds_cptr)shm; const lds_cptr kp0=shm3+LDS_K+hi*1024+r32*16; const lds_cptr vp0=shm3+LDS_V+((lane>>4)&1)*32+(lane&3)*8+(4*hi+((lane&15)>>2))*64;
  const int NT=A.NT;
  DMA_K(0,0);DMA_V(0,0);DMA_K(1,SLOTB);
  bf16x8 qr[4];
  #pragma unroll
  for(int d0=0;d0<4;++d0)qr[d0]=*reinterpret_cast<const bf16x8*>(&Qw[(long)r32*dmq+d0*16+hi*8]);
  float mhat=0.f,l_reg=0.f;f32x16 o[2];o[0]=f32x16{};o[1]=f32x16{};f32x16 negm=f32x16{};asm volatile("":"+v"(negm));
  const int qrel=wid*QBLK+r32; const int dposq=A.dpos0-qrel;
  if(MODE==2){ mhat=A.fixref; _Pragma("unroll") for(int r=0;r<16;++r)negm[r]=-mhat; asm volatile("":"+v"(negm)); }
  bool resc=false;
  #define START(P0,P1) do{ resc=false; if(MODE!=2) \
    { const float rm=rowmax(P0,P1); const float dl=(MODE==1)?__builtin_fmaxf(rm,-20.f):rm; mhat=fadd_s(mhat,dl); \
      _Pragma("unroll") for(int r=0;r<16;++r){P0[r]=fsub_s(P0[r],dl);P1[r]=fsub_s(P1[r],dl);} \
      _Pragma("unroll") for(int r=0;r<16;++r)negm[r]=-mhat; asm volatile("":"+v"(negm)); } \
    _Pragma("unroll") for(int r=0;r<16;++r)P0[r]=__builtin_amdgcn_exp2f(P0[r]); }while(0)
  #define RESC() do{ if(resc){ asm volatile("s_waitcnt lgkmcnt(0)":::"memory"); \
      _Pragma("unroll") for(int d_=0;d_<2;++d_) _Pragma("unroll") for(int r=0;r<16;++r)o[d_][r]*=wsf[crow(r,hi)]; } }while(0)
  f32x16 pA0,pA1,pB0,pB1;
  int sl_prev=0,sl_cur=0,sl_next=SLOTB;
  #define ROT() do{sl_prev=sl_cur;sl_cur=sl_next;sl_next=(sl_next==(NSLOT-1)*SLOTB)?0:sl_next+SLOTB;}while(0)
  DMA_K(2,2*SLOTB);
  WAIT_BAR(3);
  if(MODE==1){wmask_c(pA0,pA1,negm,dposq,hi);qkt(pA0,pA1,Kbase,qr,pA0,pA1,r32,hi);}else{qkt(pA0,pA1,Kbase,qr,negm,negm,r32,hi);}asm volatile("s_nop 15\n\ts_nop 7":"+v"(pA0),"+v"(pA1));
  START(pA0,pA1);
  _Pragma("unroll") for(int r=0;r<16;++r)pA1[r]=__builtin_amdgcn_exp2f(pA1[r]);
  WAIT_BAR(0);
  DMA_K(3,0);DMA_V(1,SLOTB);
  ROT();
  kload8(kf,kp0+sl_cur);
  WAIT_BAR(2);
  s16x4 vlo[8],vhi[8]; u32x4 pw0,pw1,pw2,pw3;
  #define PKW(P,B) cvtpk_s(P[B],P[B+1])
  #define PAF(k) __builtin_bit_cast(bf16x8,pw##k)
  #define VFR(i) (bf16x8){vlo[i][0],vlo[i][1],vlo[i][2],vlo[i][3],vhi[i][0],vhi[i][1],vhi[i][2],vhi[i][3]}
  #define PIN(x) asm volatile("":"+v"(x))
  #define MX3(a,b,c) __builtin_fmaxf(__builtin_fmaxf((a),(b)),(c))
  #define GAPA(MF,A0,A1,A2,A3,W0,W1,PW) do{ MF; sacc+=A0; sacc+=A1; sacc+=A2; sacc+=A3; PIN(sacc); W0; W1; PIN(PW); SBAR(); }while(0)
  #define EX(v) __builtin_amdgcn_exp2f(v)
  #define GAPB(MF,X,B) do{ MF; X[B]=EX(X[B]); X[B+1]=EX(X[B+1]); X[B+2]=EX(X[B+2]); X[B+3]=EX(X[B+3]); PIN(X); SBAR(); }while(0)
  #define VRD(i) do{ vlo[i]=vtr(vp_+(((i)>>2)*4096+((i)&3)*1024)); vhi[i]=vtr(vp_+(((i)>>2)*4096+((i)&3)*1024+512)); }while(0)
  #define KRD(G,j) do{ if(G){ kload2(kf,kp0+sl_next,j); SBAR(); } }while(0)
  #define STEP(C0,C1,P0,P1,t,GK,GV,GL) do{ SBAR(); if(MODE==1){ wmask_c(C0,C1,negm,dposq+64*(t),hi); SBAR(); } \
    const lds_cptr vp_=vp0+sl_prev; \
    VRD(0); SBAR(); float sacc=(P0[0]+P0[1]); \
    GAPA(C0=__builtin_amdgcn_mfma_f32_32x32x16_bf16(kf[0],qr[0],(MODE==1?C0:negm),0,0,0), P0[2],P0[3],P0[4],P0[5],     pw0[0]=PKW(P0,0), pw0[1]=PKW(P0,2), pw0); \
    VRD(4); SBAR(); GAPA(C1=__builtin_amdgcn_mfma_f32_32x32x16_bf16(kf[1],qr[0],(MODE==1?C1:negm),0,0,0), P0[6],P0[7],P0[8],P0[9],     pw0[2]=PKW(P0,4), pw0[3]=PKW(P0,6), pw0); \
    VRD(1); SBAR(); GAPA(C0=__builtin_amdgcn_mfma_f32_32x32x16_bf16(kf[2],qr[1],C0,0,0,0),   P0[10],P0[11],P0[12],P0[13], pw1[0]=PKW(P0,8), pw1[1]=PKW(P0,10), pw1); \
    VRD(5); SBAR(); GAPA(C1=__builtin_amdgcn_mfma_f32_32x32x16_bf16(kf[3],qr[1],C1,0,0,0),   P0[14],P0[15],P1[0],P1[1],   pw1[2]=PKW(P0,12),pw1[3]=PKW(P0,14), pw1); \
    VRD(2); SBAR(); GAPA(C0=__builtin_amdgcn_mfma_f32_32x32x16_bf16(kf[4],qr[2],C0,0,0,0),   P1[2],P1[3],P1[4],P1[5],     pw2[0]=PKW(P1,0), pw2[1]=PKW(P1,2), pw2); \
    VRD(6); SBAR(); GAPA(C1=__builtin_amdgcn_mfma_f32_32x32x16_bf16(kf[5],qr[2],C1,0,0,0),   P1[6],P1[7],P1[8],P1[9],     pw2[2]=PKW(P1,4), pw2[3]=PKW(P1,6), pw2); \
    VRD(3); SBAR(); GAPA(C0=__builtin_amdgcn_mfma_f32_32x32x16_bf16(kf[6],qr[3],C0,0,0,0),   P1[10],P1[11],P1[12],P1[13], pw3[0]=PKW(P1,8), pw3[1]=PKW(P1,10), pw3); \
    VRD(7); SBAR(); GAPA(C1=__builtin_amdgcn_mfma_f32_32x32x16_bf16(kf[7],qr[3],C1,0,0,0),   P1[14],P1[15],0.f,0.f,       pw3[2]=PKW(P1,12),pw3[3]=PKW(P1,14), pw3); \
    l_reg+=sacc; \
    if(GK){DMA_K((t)+3,sl_cur);} if(GV){DMA_V((t)+1,sl_next);} \
    if(MODE!=2){ float a=MX3(C0[0],C0[1],C1[0]),b=MX3(C0[2],C0[3],C1[1]); a=MX3(a,C1[2],C1[3]); \
      _Pragma("unroll") for(int r=4;r<16;r+=4){a=MX3(a,C0[r],C0[r+1]);b=MX3(b,C0[r+2],C0[r+3]);a=MX3(a,C1[r],C1[r+1]);b=MX3(b,C1[r+2],C1[r+3]);} \
      float rm=__builtin_fmaxf(a,b); { auto rr=__builtin_amdgcn_permlane32_swap(__float_as_uint(rm),__float_as_uint(rm),false,false); rm=__builtin_fmaxf(__uint_as_float(rr[0]),__uint_as_float(rr[1])); } \
      resc=false; \
      if(__builtin_expect(__any(rm>(float)THRL),0)){ const float dl=__builtin_fmaxf(rm,0.f); mhat+=dl; \
        _Pragma("unroll") for(int r=0;r<16;++r){C0[r]-=dl;C1[r]-=dl;} \
        _Pragma("unroll") for(int r=0;r<16;++r)negm[r]=-mhat; asm volatile("":"+v"(negm)); \
        const float f=__builtin_amdgcn_exp2f(-dl); l_reg*=f; if(hi==0)wsf[r32]=f; resc=true; } } \
    SBAR(); \
    GAPB(o[0]=__builtin_amdgcn_mfma_f32_32x32x16_bf16(PAF(0),VFR(0),o[0],0,0,0), C0,0); \
    GAPB(o[1]=__builtin_amdgcn_mfma_f32_32x32x16_bf16(PAF(0),VFR(4),o[1],0,0,0), C0,4); \
    KRD(GL,0); GAPB(o[0]=__builtin_amdgcn_mfma_f32_32x32x16_bf16(PAF(1),VFR(1),o[0],0,0,0), C0,8); \
    KRD(GL,1); GAPB(o[1]=__builtin_amdgcn_mfma_f32_32x32x16_bf16(PAF(1),VFR(5),o[1],0,0,0), C0,12); \
    KRD(GL,2); GAPB(o[0]=__builtin_amdgcn_mfma_f32_32x32x16_bf16(PAF(2),VFR(2),o[0],0,0,0), C1,0); \
    KRD(GL,3); GAPB(o[1]=__builtin_amdgcn_mfma_f32_32x32x16_bf16(PAF(2),VFR(6),o[1],0,0,0), C1,4); \
    GAPB(o[0]=__builtin_amdgcn_mfma_f32_32x32x16_bf16(PAF(3),VFR(3),o[0],0,0,0), C1,8); \
    GAPB(o[1]=__builtin_amdgcn_mfma_f32_32x32x16_bf16(PAF(3),VFR(7),o[1],0,0,0), C1,12); \
    }while(0)
  int t=1;
  if constexpr(MODE!=1) for(;t+5<NT;t+=2){
    STEP(pB0,pB1,pA0,pA1,t,true,true,true);     WAIT_BAR(2); RESC(); ROT();
    STEP(pA0,pA1,pB0,pB1,t+1,true,true,true);   WAIT_BAR(2); RESC(); ROT();
  }
  #define ENDW(tt) do{ if((tt)+3<NT){WAIT_BAR(2);} else if((tt)+2<NT){WAIT_BAR(1);} else {WAIT_BAR(0);} }while(0)
  for(;t+1<NT;t+=2){
    STEP(pB0,pB1,pA0,pA1,t,(t+3<NT),(t+1<NT),(t+1<NT));       ENDW(t);   RESC(); ROT();
    STEP(pA0,pA1,pB0,pB1,t+1,(t+4<NT),(t+2<NT),(t+2<NT));     ENDW(t+1); RESC(); ROT();
  }
  STEP(pB0,pB1,pA0,pA1,NT-1,false,false,false); RESC();
  { float sacc=pB0[0]+pB0[1]; _Pragma("unroll") for(int r=2;r<16;++r)sacc+=pB0[r]; _Pragma("unroll") for(int r=0;r<16;++r)sacc+=pB1[r]; l_reg+=sacc;
    pw0=(u32x4){PKW(pB0,0),PKW(pB0,2),PKW(pB0,4),PKW(pB0,6)};pw1=(u32x4){PKW(pB0,8),PKW(pB0,10),PKW(pB0,12),PKW(pB0,14)};pw2=(u32x4){PKW(pB1,0),PKW(pB1,2),PKW(pB1,4),PKW(pB1,6)};pw3=(u32x4){PKW(pB1,8),PKW(pB1,10),PKW(pB1,12),PKW(pB1,14)};
    SBAR(); pv(o,vb0+sl_cur,PAF(0),PAF(1),PAF(2),PAF(3)); }
  #undef PKW
  #undef PAF
  #undef VFR
  #undef PIN
  #undef MX3
  #undef GAPA
  #undef GAPB
  #undef EX
  #undef VRD
  #undef KRD
  #undef STEP
  #undef ENDW
  {auto rr=__builtin_amdgcn_permlane32_swap(__float_as_uint(l_reg),__float_as_uint(l_reg),false,false);l_reg=__uint_as_float(rr[0])+__uint_as_float(rr[1]);}
  if(MODE==1)l_reg+=__builtin_amdgcn_exp2f(A.sinkl2-mhat);
  if(hi==0)wsf[32+r32]=l_reg;asm volatile("s_waitcnt lgkmcnt(0)":::"memory");
  float rli[16];
  #pragma unroll
  for(int r=0;r<16;++r)rli[r]=__builtin_amdgcn_rcpf(wsf[32+crow(r,hi)]);
  bf16*Ow=A.O+(A.qrow0+wid*QBLK)*dmo;
  { bf16*stg=(bf16*)(shm+LDS_OST)+wid*2048;
    #pragma unroll
    for(int r=0;r<16;++r){const int orow=crow(r,hi);
      #pragma unroll
      for(int d0=0;d0<2;++d0)stg[orow*64+d0*32+r32]=__float2bfloat16(o[d0][r]*rli[r]);}
    asm volatile("s_waitcnt lgkmcnt(0)":::"memory");
    #pragma unroll
    for(int i=0;i<4;++i){const int row=i*8+(lane>>3),ch=lane&7; const u32x4 v=*(const u32x4*)(stg+row*64+ch*8); ATTN_STORE16(Ow+(long)row*dmo+ch*8,v);} }
  asm volatile("s_waitcnt lgkmcnt(0)\n\ts_barrier":::"memory");
  #undef DMA_K
  #undef DMA_V
  #undef START
  #undef RESC
  #undef ROT
}
constexpr int ATTN_LDS_BYTES=LDS_BYTES;
#undef SBAR
#undef WAIT_BAR
}
constexpr int NWAVES = 8;
constexpr size_t MiB = 1u << 20;
#ifndef MK_DEBUG
#define MK_DEBUG 0
#endif
constexpr size_t WS_CTL = 0, CTL_ZERO_BYTES = 32768;
constexpr size_t CTL_BAR_OFF = 4096;
constexpr size_t WS_W_IN = 1 * MiB;
constexpr size_t WS_W_KVM = 10 * MiB;
constexpr size_t WS_W_BR = 11 * MiB;
constexpr size_t WS_W_OUT = 13 * MiB;
constexpr size_t WS_W_GU = 16 * MiB;
constexpr size_t WS_SCL = 15 * MiB;
constexpr size_t WS_SB_IN = WS_SCL, WS_SB_KVM = WS_SCL + 32768, WS_SAM = WS_SCL + 40960, WS_SAH = WS_SCL + 65536, WS_SB_GU = WS_SCL + 262144, WS_SB_DN = WS_SCL + 524288, WS_SB_OUT = WS_SCL + 655360;
constexpr size_t WS_SAL = 80 * MiB;
constexpr size_t WS_W_DN = 144 * MiB;
constexpr size_t WS_H = 208 * MiB;
constexpr size_t WS_MEMN = 240 * MiB;
constexpr size_t WS_KVM = 241 * MiB;
constexpr size_t WS_LIST = 242 * MiB;
constexpr size_t WS_SLOT = 244 * MiB;
constexpr size_t WS_TOPW = 245 * MiB;
constexpr size_t WS_Y = 246 * MiB;
constexpr size_t WS_MERGED = 278 * MiB;
constexpr size_t WS_X1 = 310 * MiB;
constexpr size_t WS_QKV = 374 * MiB;
constexpr size_t WS_G = 422 * MiB;
#if MK_DEBUG
constexpr size_t WS_ACT = 518 * MiB;
constexpr size_t WS_YS = 662 * MiB;
constexpr size_t WS_H2 = 806 * MiB;
constexpr size_t WS_DBG = 838 * MiB;
constexpr size_t WS_END = 839 * MiB;
#else
constexpr size_t WS_ACT = WS_QKV;
constexpr size_t WS_YS = 518 * MiB;
constexpr size_t WS_H2 = WS_H;
constexpr size_t WS_END = 662 * MiB;
#endif
constexpr size_t WS_YSS = WS_YS + 80 * MiB;
static_assert((size_t)ACT_ROWS * 1024 * 2 == 144 * MiB && (size_t)T * NQKV * 2 == 48 * MiB && (size_t)T * NG * 2 == 96 * MiB, "map");

constexpr int RING_BYTES = 131072;
constexpr int LX_OFF = RING_BYTES;
constexpr int LX2_OFF = 147456;
constexpr int LDS_BYTES = 157696;

struct Params {
    const float *x, *mem, *norm_mix, *w_in, *qn, *kn, *sink, *norm_mem, *w_kvm, *w_bra, *w_brb, *w_brm, *w_out, *norm_ffn, *w_router, *b_router, *w_gu, *b_gu, *w_dn, *b_dn, *norm_final;
    float* out; unsigned char* ws; int ph_lo, ph_hi;
};

#define LDS_WAIT() asm volatile("s_waitcnt lgkmcnt(0)" ::: "memory")
__device__ __forceinline__ float wave_sum(float v) {
#pragma unroll
    for (int o = 1; o < 64; o <<= 1) v += __shfl_xor(v, o);
    return v;
}
template <int CTRL, int RM = 0xf, int BM = 0xf> __device__ __forceinline__ float dppf(float old, float src) {
    return __int_as_float(__builtin_amdgcn_update_dpp(__float_as_int(old), __float_as_int(src), CTRL, RM, BM, false)); }
__device__ __forceinline__ float xl1(float v) { return dppf<0xB1>(0.f, v); }
__device__ __forceinline__ float xl2(float v) { return dppf<0x4E>(0.f, v); }
__device__ __forceinline__ float xl4(float v) { return dppf<0x1B>(0.f, dppf<0x141>(0.f, v)); }
__device__ __forceinline__ float xl8(float v) { return dppf<0x128>(0.f, v); }
__device__ __forceinline__ float xl16(float v, int lane) { const auto r = __builtin_amdgcn_permlane16_swap(__float_as_uint(v), __float_as_uint(v), false, false); return __uint_as_float((lane & 16) ? r[0] : r[1]); }
__device__ __forceinline__ float sum_halves(float v) { const auto r = __builtin_amdgcn_permlane32_swap(__float_as_uint(v), __float_as_uint(v), false, false); return __uint_as_float(r[0]) + __uint_as_float(r[1]); }
__device__ __forceinline__ float wave_sum_s(float v) {
    v += xl1(v); v += xl2(v); v += dppf<0x124>(0.f, v); v += xl8(v);
    v += dppf<0x142, 0xa>(0.f, v); v += dppf<0x143, 0xc>(0.f, v);
    return __int_as_float(__builtin_amdgcn_readlane(__float_as_int(v), 63)); }
__device__ __forceinline__ float wave_max_s(float v) {
    v = fmaxf(v, dppf<0xB1>(v, v)); v = fmaxf(v, dppf<0x4E>(v, v)); v = fmaxf(v, dppf<0x124>(v, v)); v = fmaxf(v, dppf<0x128>(v, v));
    v = fmaxf(v, dppf<0x142, 0xa>(v, v)); v = fmaxf(v, dppf<0x143, 0xc>(v, v));
    return __int_as_float(__builtin_amdgcn_readlane(__float_as_int(v), 63)); }
__device__ __forceinline__ void tile_of(int L, int nM, int nN, int& pm, int& pn) {
    const int nwg = nM * nN; int wgid = L;
    { const int q = nwg / 8, r = nwg % 8, xcd = wgid % 8, off = wgid / 8; wgid = (xcd < r ? xcd * (q + 1) : r * (q + 1) + (xcd - r) * q) + off; }
    const int nig = 8 * nN, gid = wgid / nig, fm = gid * 8, gsz = (nM - fm) < 8 ? (nM - fm) : 8;
    pm = fm + ((wgid % nig) % gsz); pn = (wgid % nig) / gsz;
}
struct VA4 { unsigned v0, v1, v2, v3; };
__device__ __forceinline__ VA4 std_va(unsigned lda_bytes) {
    int R0, C0, R1, C1; pg8::lane_piece(0, R0, C0); pg8::lane_piece(1, R1, C1); VA4 r;
    r.v0 = (unsigned)R0 * lda_bytes + (unsigned)C0 * 2u; r.v1 = (unsigned)R1 * lda_bytes + (unsigned)C1 * 2u;
    r.v2 = (unsigned)(R0 + 128) * lda_bytes + (unsigned)C0 * 2u; r.v3 = (unsigned)(R1 + 128) * lda_bytes + (unsigned)C1 * 2u; return r;
}

__device__ __forceinline__ void transpose_item(const float* __restrict__ W, int ldw, int k0, int lbase, bool perm, bf16_t* __restrict__ WT, int ldt, int prow0, int kdst, LAS float* scr, int lane) {
    float v[32];
#pragma unroll
    for (int i = 0; i < 32; ++i) { const int kk = 2 * i + (lane >> 5); v[i] = W[(size_t)(k0 + kk) * ldw + lbase + (lane & 31)]; }
#pragma unroll
    for (int i = 0; i < 32; ++i) { const int kk = 2 * i + (lane >> 5); scr[kk * 33 + (lane & 31)] = v[i]; }
    LDS_WAIT(); asm volatile("" ::: "memory");
    const int c = lane & 7;
#pragma unroll
    for (int j = 0; j < 4; ++j) { const int n = (lane >> 3) + 8 * j; const int ln = perm ? p8perm(n) : n; const LAS float* s = scr + (8 * c) * 33 + ln;
        u32x4 o; o.x = cvt_pk_bf16(s[0 * 33], s[1 * 33]); o.y = cvt_pk_bf16(s[2 * 33], s[3 * 33]); o.z = cvt_pk_bf16(s[4 * 33], s[5 * 33]); o.w = cvt_pk_bf16(s[6 * 33], s[7 * 33]);
        *(u32x4*)(WT + (size_t)(prow0 + n) * ldt + kdst + 8 * c) = o; }
    LDS_WAIT(); asm volatile("" ::: "memory");
}
__device__ __forceinline__ void rms_row_to_bf16(const float* __restrict__ xrow, const float* __restrict__ g, bf16_t* __restrict__ orow, int lane) {
    const f32x4* xr = (const f32x4*)xrow + lane;
    f32x4 v[4]; float s = 0.f;
#pragma unroll
    for (int j = 0; j < 4; ++j) { v[j] = xr[64 * j]; s += (v[j].x * v[j].x + v[j].y * v[j].y) + (v[j].z * v[j].z + v[j].w * v[j].w); }
    const float r = rsqrtf(wave_sum(s) * (1.f / D) + EPS);
    u32x2* o8 = (u32x2*)orow + lane;
#pragma unroll
    for (int j = 0; j < 4; ++j) { const f32x4 gg = ((const f32x4*)g)[lane + 64 * j]; u32x2 w; w.x = cvt_pk_bf16(v[j].x * r * gg.x, v[j].y * r * gg.y); w.y = cvt_pk_bf16(v[j].z * r * gg.z, v[j].w * r * gg.w); o8[64 * j] = w; }
}
__device__ __forceinline__ float wave_max(float v) {
#pragma unroll
    for (int o = 1; o < 64; o <<= 1) v = fmaxf(v, __shfl_xor(v, o));
    return v;
}
__device__ __forceinline__ unsigned pack_i8x4(float a, float b, float c, float d) {
    const int qa = (int)rintf(a), qb = (int)rintf(b), qc = (int)rintf(c), qd = (int)rintf(d);
    return (unsigned)(qa & 0xff) | ((unsigned)(qb & 0xff) << 8) | ((unsigned)(qc & 0xff) << 16) | ((unsigned)qd << 24);
}
__device__ __forceinline__ void rms_row_to_i8(const float* __restrict__ xrow, const float* __restrict__ g, signed char* __restrict__ orow, float* __restrict__ scale_out, int lane) {
    const f32x4* xr = (const f32x4*)xrow + lane;
    f32x4 v[4]; float s = 0.f;
#pragma unroll
    for (int j = 0; j < 4; ++j) { v[j] = xr[64 * j]; s += (v[j].x * v[j].x + v[j].y * v[j].y) + (v[j].z * v[j].z + v[j].w * v[j].w); }
    const float r = rsqrtf(wave_sum(s) * (1.f / D) + EPS);
    float mx = 0.f;
#pragma unroll
    for (int j = 0; j < 4; ++j) { const f32x4 gg = ((const f32x4*)g)[lane + 64 * j]; v[j] = v[j] * r * gg; mx = fmaxf(fmaxf(mx, fmaxf(fabsf(v[j].x), fabsf(v[j].y))), fmaxf(fabsf(v[j].z), fabsf(v[j].w))); }
    mx = wave_max(mx);
    const float inv = mx > 0.f ? 127.f / mx : 0.f;
    unsigned* o4 = (unsigned*)orow + lane;
#pragma unroll
    for (int j = 0; j < 4; ++j) o4[64 * j] = pack_i8x4(v[j].x * inv, v[j].y * inv, v[j].z * inv, v[j].w * inv);
    if (lane == 0) *scale_out = mx * (1.f / 127.f);
}
template <int NB> __device__ __forceinline__ void rms_rows_to_i8(const float* __restrict__ X, const float* __restrict__ g, signed char* __restrict__ O, float* __restrict__ S, int m0, int stride, int M, int lane) {
    f32x4 v[NB][4], gv[4];
#pragma unroll
    for (int j = 0; j < 4; ++j) gv[j] = ((const f32x4*)g)[lane + 64 * j];
#pragma unroll
    for (int q = 0; q < NB; ++q) { const int m = min(m0 + q * stride, M - 1); const f32x4* xr = (const f32x4*)(X + (size_t)m * D) + lane;
#pragma unroll
        for (int j = 0; j < 4; ++j) v[q][j] = xr[64 * j]; }
#pragma unroll
    for (int q = 0; q < NB; ++q) { const int m = m0 + q * stride;
        if (m < M) {
            float s = 0.f;
#pragma unroll
            for (int j = 0; j < 4; ++j) s += (v[q][j].x * v[q][j].x + v[q][j].y * v[q][j].y) + (v[q][j].z * v[q][j].z + v[q][j].w * v[q][j].w);
            const float r = rsqrtf(wave_sum_s(s) * (1.f / D) + EPS);
            float mx = 0.f;
#pragma unroll
            for (int j = 0; j < 4; ++j) { const f32x4 gg = gv[j]; v[q][j] = v[q][j] * r * gg; mx = fmaxf(fmaxf(mx, fmaxf(fabsf(v[q][j].x), fabsf(v[q][j].y))), fmaxf(fabsf(v[q][j].z), fabsf(v[q][j].w))); }
            mx = wave_max_s(mx);
            const float inv = mx > 0.f ? 127.f / mx : 0.f;
            unsigned* o4 = (unsigned*)(O + (size_t)m * D) + lane;
#pragma unroll
            for (int j = 0; j < 4; ++j) o4[64 * j] = pack_i8x4(v[q][j].x * inv, v[q][j].y * inv, v[q][j].z * inv, v[q][j].w * inv);
            if (lane == 0) S[m] = mx * (1.f / 127.f);
        } }
}
struct QTask { const float* W; int ldw, lbase; bool perm; signed char* WQ; int prow0; float* SB; bool fp8; };
__device__ __forceinline__ void quant_load(const QTask& q, f32x4 (&v)[16], int wave, int lane) {
    const unsigned loff = (unsigned)((lane >> 3) * 16 * q.ldw + 4 * (lane & 7));
#pragma unroll
    for (int i = 0; i < 16; ++i) { const float* rowp = q.W + (size_t)(128 * wave + i) * q.ldw + q.lbase;
        v[i] = __builtin_nontemporal_load((const f32x4*)(rowp + loff)); }
}
__device__ __forceinline__ void quant_finish(const QTask& q, const f32x4 (&v)[16], LAS unsigned char* lds, int wave, int lane) {
    LAS unsigned* cmax = (LAS unsigned*)(lds + LX_OFF + 12288);
    if (threadIdx.x < 32) cmax[threadIdx.x] = 0u;
    __syncthreads();
    f32x4 m = {0.f, 0.f, 0.f, 0.f};
#pragma unroll
    for (int i = 0; i < 16; ++i) m = __builtin_elementwise_max(m, __builtin_elementwise_abs(v[i]));
#pragma unroll
    for (int j = 0; j < 4; ++j) { m[j] = fmaxf(m[j], xl8(m[j])); m[j] = fmaxf(m[j], xl16(m[j], lane)); }
    { const auto r0 = __builtin_amdgcn_permlane32_swap(__float_as_uint(m[0]), __float_as_uint(m[0]), false, false), r1 = __builtin_amdgcn_permlane32_swap(__float_as_uint(m[1]), __float_as_uint(m[1]), false, false),
                 r2 = __builtin_amdgcn_permlane32_swap(__float_as_uint(m[2]), __float_as_uint(m[2]), false, false), r3 = __builtin_amdgcn_permlane32_swap(__float_as_uint(m[3]), __float_as_uint(m[3]), false, false);
      m[0] = fmaxf(__uint_as_float(r0[0]), __uint_as_float(r0[1])); m[1] = fmaxf(__uint_as_float(r1[0]), __uint_as_float(r1[1])); m[2] = fmaxf(__uint_as_float(r2[0]), __uint_as_float(r2[1])); m[3] = fmaxf(__uint_as_float(r3[0]), __uint_as_float(r3[1])); }
    if (lane < 8) {
#pragma unroll
        for (int j = 0; j < 4; ++j) __hip_atomic_fetch_max(cmax + 4 * lane + j, __float_as_uint(m[j]), __ATOMIC_RELAXED, __HIP_MEMORY_SCOPE_WORKGROUP); }
    __syncthreads();
    const int c4 = lane & 7, r8 = lane >> 3;
    const float qmax = q.fp8 ? 384.f : 127.f; f32x4 inv;
#pragma unroll
    for (int j = 0; j < 4; ++j) { const float mj = __uint_as_float(cmax[4 * c4 + j]); inv[j] = mj > 0.f ? qmax / mj : 0.f; }
    const int prow = q.prow0 + (q.perm ? 16 * (c4 & 1) + 4 * (c4 >> 1) : 4 * c4);
    signed char* dst = q.WQ + (size_t)prow * 1024 + 128 * wave + 16 * r8;
#pragma unroll
    for (int j = 0; j < 4; ++j) {
        u32x4 o;
#pragma unroll
        for (int w = 0; w < 4; ++w) {
            const float s0 = v[4 * w][j] * inv[j], s1 = v[4 * w + 1][j] * inv[j], s2 = v[4 * w + 2][j] * inv[j], s3 = v[4 * w + 3][j] * inv[j];
            unsigned d;
            if (q.fp8) { int t_ = __builtin_amdgcn_cvt_pk_fp8_f32(s0, s1, 0, false); t_ = __builtin_amdgcn_cvt_pk_fp8_f32(s2, s3, t_, true); d = (unsigned)t_; }
            else d = pack_i8x4(s0, s1, s2, s3);
            o[w] = d; }
        *(u32x4*)(dst + (size_t)j * 1024) = o; }
    if (wave == 0 && lane < 32) { const int ln = q.perm ? p8perm(lane) : lane; q.SB[q.prow0 + lane] = __uint_as_float(cmax[ln]) * (q.fp8 ? 1.f / 384.f : 1.f / 127.f); }
    __syncthreads();
}
__device__ __forceinline__ QTask moe_task(const Params& P, int it) {
    QTask q;
    if (it < 2048) { const int e = it >> 6, g = it & 63, pn = g >> 3, bj = (g >> 2) & 1, wc = g & 3;
        q.W = P.w_gu + (size_t)e * 1024 * 2048; q.ldw = 2048; q.lbase = 1024 * bj + 128 * pn + 32 * wc; q.perm = true; q.WQ = (signed char*)(P.ws + WS_W_GU) + (size_t)e * 2048 * 1024; q.prow0 = 32 * g;
        q.SB = (float*)(P.ws + WS_SB_GU) + e * 2048; q.fp8 = false; }
    else { const int r = it - 2048, e = r >> 5, g = r & 31;
        q.W = P.w_dn + (size_t)e * 1024 * 1024; q.ldw = 1024; q.lbase = 32 * g; q.perm = true; q.WQ = (signed char*)(P.ws + WS_W_DN) + (size_t)e * 1024 * 1024; q.prow0 = 32 * g;
        q.SB = (float*)(P.ws + WS_SB_DN) + e * 1024; q.fp8 = true; }
    return q;
}
template <bool PIPE> __device__ __forceinline__ void convert_moe_items(const Params& P, LAS unsigned char* lds, int gs, int gn) {
    const int tid = threadIdx.x, lane = tid & 63, wave = __builtin_amdgcn_readfirstlane(tid >> 6);
    if constexpr (!PIPE) { for (int it = gs; it < gs + gn; ++it) { f32x4 v[16]; const QTask q = moe_task(P, it); quant_load(q, v, wave, lane); quant_finish(q, v, lds, wave, lane); } }
    else if (gn > 0) {
        f32x4 va[16], vb[16]; const int last = gs + gn - 1;
        QTask qa = moe_task(P, gs), qb; quant_load(qa, va, wave, lane);
        for (int it = gs; it <= last; it += 2) {
            qb = moe_task(P, min(it + 1, last)); quant_load(qb, vb, wave, lane);
            quant_finish(qa, va, lds, wave, lane);
            qa = moe_task(P, min(it + 2, last)); quant_load(qa, va, wave, lane);
            quant_finish(qb, vb, lds, wave, lane);
        }
    }
}
__device__ __forceinline__ void p0_prologue(const Params& P, LAS unsigned char* lds, int G) {
    const int tid = threadIdx.x, lane = tid & 63, wave = __builtin_amdgcn_readfirstlane(tid >> 6);
    LAS float* scr = (LAS float*)(lds + wave * 16384);
    const int gw = (int)blockIdx.x * NWAVES + wave, NGW = G * NWAVES;
    bf16_t* W_BR = (bf16_t*)(P.ws + WS_W_BR);
    for (int task = blockIdx.x; task < 144 + 16 + 32; task += G) {
        const bool ow = task >= 160, kv = !ow && task >= 144; const int g = ow ? task - 160 : kv ? task - 144 : task, pn = g >> 3, bj = (g >> 2) & 1, wc = g & 3;
        const bool heads = !kv && !ow && pn < 6;
        QTask q; q.W = ow ? P.w_out : kv ? P.w_kvm : P.w_in; q.ldw = ow ? 1024 : kv ? 512 : INW; q.lbase = heads ? 64 * (4 * pn + wc) + 32 * bj : ow ? 256 * pn + 64 * wc + 32 * bj : 32 * g; q.perm = !kv && !heads;
        q.WQ = (signed char*)(P.ws + (ow ? WS_W_OUT : kv ? WS_W_KVM : WS_W_IN)); q.prow0 = 32 * g;
        q.SB = (float*)(P.ws + (ow ? WS_SB_OUT : kv ? WS_SB_KVM : WS_SB_IN)); q.fp8 = ow;
        f32x4 v[16]; quant_load(q, v, wave, lane); quant_finish(q, v, lds, wave, lane);
    }
    constexpr int I_BRA = 6 * 32, I_BRM = 4 * 32;
    constexpr int NITEMS = 2 * I_BRA + I_BRM;
    for (int it = NGW - 1 - gw; it < NITEMS; it += NGW) {
        int r = it;
        if (r < I_BRA) { const int kb = r / 32, g = r % 32; transpose_item(P.w_bra, 1024, 64 * kb, 32 * g, true, W_BR, 1024, 32 * g, 0 + 64 * kb, scr, lane); continue; } r -= I_BRA;
        if (r < I_BRA) { const int kb = r / 32, g = r % 32; transpose_item(P.w_brb, 1024, 64 * kb, 32 * g, true, W_BR, 1024, 32 * g, 384 + 64 * kb, scr, lane); continue; } r -= I_BRA;
        { const int kb = r / 32, g = r % 32; transpose_item(P.w_brm, 1024, 64 * kb, 32 * g, true, W_BR, 1024, 32 * g, 768 + 64 * kb, scr, lane); }
    }
    if (G != 256) { const int ng = (3072 + G - 1) / G, g0 = min((int)blockIdx.x * ng, 3072); convert_moe_items<false>(P, lds, g0, min(ng, 3072 - g0)); }
    signed char* HQ = (signed char*)(P.ws + WS_H); signed char* MEMNQ = (signed char*)(P.ws + WS_MEMN); float* SAH = (float*)(P.ws + WS_SAH); float* SAM = (float*)(P.ws + WS_SAM);
    for (int m = gw; m < T; m += 8 * NGW) rms_rows_to_i8<8>(P.x, P.norm_mix, HQ, SAH, m, NGW, T, lane);
    for (int m = NGW - 1 - gw; m < BATCH * NMEM; m += NGW) rms_row_to_i8(P.mem + (size_t)m * D, P.norm_mem, MEMNQ + (size_t)m * D, SAM + m, lane);
}

struct SchedP1 {
    const char* H; const char* W; const char* MEMN; const char* WKVM; int G, c; VA4 va;
    __device__ __forceinline__ bool next(int i, pg8::Unit& u) const {
        const int L = i * G + c; constexpr int NMAIN = 64 * 18;
        if (L >= NMAIN + 4) return false;
        u.nt = 8;
        u.va0 = va.v0; u.va1 = va.v1; u.va2 = va.v2; u.va3 = va.v3;
        if (L < NMAIN) { tile_of(L, 64, 18, u.pm, u.pn); u.aux = 0; u.a = H + (size_t)u.pm * 256 * 1024; u.b = W + (size_t)u.pn * 256 * 1024; }
        else { const int l = L - NMAIN; u.pm = l >> 1; u.pn = l & 1; u.aux = 1; u.a = MEMN + (size_t)u.pm * 256 * 1024; u.b = WKVM + (size_t)u.pn * 256 * 1024; }
        return true;
    }
};
__device__ __forceinline__ void dequant_acc(f32x4 (&acc)[2][2][4][2], const float* sa_rows  , const float* sb_cols  ) {
    f32x4 sb[2][2];
#pragma unroll
    for (int bj = 0; bj < 2; ++bj)
#pragma unroll
        for (int n = 0; n < 2; ++n) sb[bj][n] = *(const f32x4*)(sb_cols + 128 * bj + 16 * n);
#pragma unroll
    for (int ai = 0; ai < 2; ++ai)
#pragma unroll
        for (int m = 0; m < 4; ++m) { const float sa = sa_rows[128 * ai + 16 * m];
#pragma unroll
            for (int bj = 0; bj < 2; ++bj)
#pragma unroll
                for (int n = 0; n < 2; ++n) { const i32x4 q = __builtin_bit_cast(i32x4, acc[ai][bj][m][n]); acc[ai][bj][m][n] = (f32x4){(float)q[0], (float)q[1], (float)q[2], (float)q[3]} * (sb[bj][n] * sa); } }
}
__device__ __forceinline__ unsigned gate_pk4(float a, float b, float c, float d) {
    return (unsigned)(int)rintf(a * 255.f) | ((unsigned)(int)rintf(b * 255.f) << 8) | ((unsigned)(int)rintf(c * 255.f) << 16) | ((unsigned)(int)rintf(d * 255.f) << 24); }
struct EpiP1 {
    bf16_t* QKV; unsigned char* G8; bf16_t* KVM; const float* qn; const float* kn; const float *SAH, *SAM, *SB_IN, *SB_KVM;
    __device__ __forceinline__ bool keep(const pg8::Unit&) const { return false; }
    __device__ __forceinline__ void operator()(f32x4 (&acc)[2][2][4][2], const pg8::Unit& u, int wr, int wc, int fr, int fq) const {
        asm volatile("" : "+v"(fr), "+v"(fq));
        const int row0 = u.pm * 256 + wr * 64 + fr;
        dequant_acc(acc, (u.aux == 1 ? SAM : SAH) + row0, (u.aux == 1 ? SB_KVM : SB_IN) + u.pn * 256 + 32 * wc + 4 * fq);
        if (u.aux == 1) {
#pragma unroll
            for (int ai = 0; ai < 2; ++ai)
#pragma unroll
                for (int m = 0; m < 4; ++m) { bf16_t* rp = KVM + (size_t)(row0 + 128 * ai + 16 * m) * 512 + u.pn * 256 + 32 * wc + 4 * fq;
#pragma unroll
                    for (int bj = 0; bj < 2; ++bj)
#pragma unroll
                        for (int n = 0; n < 2; ++n) { const f32x4 v = acc[ai][bj][m][n]; u32x2 w; w.x = cvt_pk_bf16(v[0], v[1]); w.y = cvt_pk_bf16(v[2], v[3]); *(u32x2*)(rp + 128 * bj + 16 * n) = w; } }
            return;
        }
        if (u.pn >= 6) {
            const int gc0 = (u.pn - 6) * 256 + 32 * wc + 8 * fq;
#pragma unroll
            for (int ai = 0; ai < 2; ++ai)
#pragma unroll
                for (int m = 0; m < 4; ++m) { unsigned char* rp = G8 + (size_t)(row0 + 128 * ai + 16 * m) * NG + gc0;
#pragma unroll
                    for (int bj = 0; bj < 2; ++bj) { const f32x4 v0 = acc[ai][bj][m][0], v1 = acc[ai][bj][m][1]; u32x2 w;
                        w.x = gate_pk4(sigmoidf_fast(v0[0]), sigmoidf_fast(v0[1]), sigmoidf_fast(v0[2]), sigmoidf_fast(v0[3]));
                        w.y = gate_pk4(sigmoidf_fast(v1[0]), sigmoidf_fast(v1[1]), sigmoidf_fast(v1[2]), sigmoidf_fast(v1[3]));
                        *(u32x2*)(rp + 128 * bj) = w; } }
            return;
        }
        const int slot = 4 * u.pn + wc;
        const int type = slot < 6 ? 0 : slot < 8 ? 1 : slot < 10 ? 2 : slot < 16 ? 3 : slot < 18 ? 4 : slot < 20 ? 5 : 6;
        const bool normed = type <= 1, axial = type <= 1, rope1d = (type == 3 || type == 4);
        const float qscale = (type == 0 || type == 3 || type == 6) ? C2 : 1.f;
        f32x4 gg[2][2];
        { const float* gsrc = type == 0 ? qn : kn;
#pragma unroll
          for (int bj = 0; bj < 2; ++bj)
#pragma unroll
            for (int n = 0; n < 2; ++n) gg[bj][n] = normed ? *(const f32x4*)(gsrc + 32 * bj + 16 * n + 4 * fq) : (f32x4){1.f, 1.f, 1.f, 1.f}; }
        float inv_ax[4], inv_b[2][4];
#pragma unroll
        for (int j = 0; j < 4; ++j) { inv_ax[j] = exp2f(-(float)(2 * (4 * fq + j)) * (13.287712379549449f / 32.f));
#pragma unroll
            for (int n = 0; n < 2; ++n) inv_b[n][j] = exp2f(-(float)(2 * (16 * n + 4 * fq + j)) * (13.287712379549449f / 64.f)); }
#pragma unroll
        for (int ai = 0; ai < 2; ++ai)
#pragma unroll
            for (int m = 0; m < 4; ++m) {
                const int row = row0 + 128 * ai + 16 * m, s = row & (SEQ - 1);
                f32x4 v[2][2];
#pragma unroll
                for (int bj = 0; bj < 2; ++bj)
#pragma unroll
                    for (int n = 0; n < 2; ++n) v[bj][n] = acc[ai][bj][m][n];
                if (normed) {
                    float ss = 0.f;
#pragma unroll
                    for (int bj = 0; bj < 2; ++bj)
#pragma unroll
                        for (int n = 0; n < 2; ++n) ss += (v[bj][n][0] * v[bj][n][0] + v[bj][n][1] * v[bj][n][1]) + (v[bj][n][2] * v[bj][n][2] + v[bj][n][3] * v[bj][n][3]);
                    ss += xl16(ss, (int)threadIdx.x & 63); ss = sum_halves(ss);
                    const float r = rsqrtf(ss * (1.f / 64.f) + EPS);
#pragma unroll
                    for (int bj = 0; bj < 2; ++bj)
#pragma unroll
                        for (int n = 0; n < 2; ++n) v[bj][n] = v[bj][n] * r * gg[bj][n];
                }
                if (axial) {
#pragma unroll
                    for (int bj = 0; bj < 2; ++bj) { const float pos = (float)(bj ? (s & 63) : (s >> 6));
#pragma unroll
                        for (int j = 0; j < 4; ++j) { float sn, c; sincos_red(pos * inv_ax[j], sn, c); const float x1 = v[bj][0][j], x2 = v[bj][1][j]; v[bj][0][j] = x1 * c - x2 * sn; v[bj][1][j] = x2 * c + x1 * sn; } }
                }
                if (rope1d) { const float pos = (float)s;
#pragma unroll
                    for (int n = 0; n < 2; ++n)
#pragma unroll
                        for (int j = 0; j < 4; ++j) { float sn, c; sincos_red(pos * inv_b[n][j], sn, c); const float x1 = v[0][n][j], x2 = v[1][n][j]; v[0][n][j] = x1 * c - x2 * sn; v[1][n][j] = x2 * c + x1 * sn; }
                }
                bf16_t* rp = QKV + (size_t)row * NQKV + 64 * slot + 4 * fq;
#pragma unroll
                for (int bj = 0; bj < 2; ++bj)
#pragma unroll
                    for (int n = 0; n < 2; ++n) { const f32x4 o = v[bj][n] * qscale; u32x2 w; w.x = cvt_pk_bf16(o[0], o[1]); w.y = cvt_pk_bf16(o[2], o[3]); *(__attribute__((address_space(1))) u32x2*)(rp + 32 * bj + 16 * n) = w; }
            }
    }
};

struct SchedP3 {
    const char* Y; const char* W; int G, c; VA4 va;
    __device__ __forceinline__ bool next(int i, pg8::Unit& u) const {
        const int ti = i / 3, br = i - 3 * ti, L = ti * G + c;
        if (L >= 256) return false;
        tile_of(L, 64, 4, u.pm, u.pn); u.aux = br; u.nt = br == 2 ? 4 : 6;
        const size_t kb = (size_t)br * 384 * 2;
        u.va0 = va.v0; u.va1 = va.v1; u.va2 = va.v2; u.va3 = va.v3;
        u.a = Y + (size_t)u.pm * 256 * 2048 + kb; u.b = W + (size_t)u.pn * 256 * 2048 + kb; return true;
    }
};
struct EpiP3 {
    const unsigned char* G8; unsigned char* MERGED8;
    __device__ __forceinline__ bool keep(const pg8::Unit& u) const { return u.aux < 2; }
    __device__ __forceinline__ void operator()(f32x4 (&acc)[2][2][4][2], const pg8::Unit& u, int wr, int wc, int fr, int fq) const {
        asm volatile("" : "+v"(fr), "+v"(fq));
        const int row0 = u.pm * 256 + wr * 64 + fr, col0 = u.pn * 256 + 32 * wc + 8 * fq, br = u.aux;
        const float GEPS = 9.094947e-13f;
        const int brd = br < 2 ? br + 1 : 2;
#pragma unroll
        for (int ai = 0; ai < 2; ++ai) {
            u32x2 gnv[4][2], gdv[4][2];
#pragma unroll
            for (int m = 0; m < 4; ++m) { const size_t row = (size_t)(row0 + 128 * ai + 16 * m);
#pragma unroll
                for (int bj = 0; bj < 2; ++bj) { gnv[m][bj] = *(const u32x2*)(G8 + row * NG + br * 1024 + col0 + 128 * bj); gdv[m][bj] = *(const u32x2*)(G8 + row * NG + brd * 1024 + col0 + 128 * bj); } }
#pragma unroll
            for (int m = 0; m < 4; ++m) { const size_t row = (size_t)(row0 + 128 * ai + 16 * m);
#pragma unroll
                for (int bj = 0; bj < 2; ++bj) {
                    const u32x2 gn8 = gnv[m][bj], gd8 = gdv[m][bj];
                    float f[8];
#pragma unroll
                    for (int k = 0; k < 4; ++k) { f[k] = (float)((gn8.x >> (8 * k)) & 0xff) * (1.f / 255.f); f[4 + k] = (float)((gn8.y >> (8 * k)) & 0xff) * (1.f / 255.f); }
#pragma unroll
                    for (int k = 0; k < 8; ++k) f[k] = fmaxf(f[k], GEPS);
                    if (br < 2) {
                        float d[8];
#pragma unroll
                        for (int k = 0; k < 4; ++k) { d[k] = (float)((gd8.x >> (8 * k)) & 0xff) * (1.f / 255.f); d[4 + k] = (float)((gd8.y >> (8 * k)) & 0xff) * (1.f / 255.f); }
#pragma unroll
                        for (int k = 0; k < 8; ++k) f[k] = f[k] * __builtin_amdgcn_rcpf(fmaxf(d[k], GEPS)); }
                    f32x4 v0 = acc[ai][bj][m][0], v1 = acc[ai][bj][m][1];
                    v0[0] *= f[0]; v0[1] *= f[1]; v0[2] *= f[2]; v0[3] *= f[3]; v1[0] *= f[4]; v1[1] *= f[5]; v1[2] *= f[6]; v1[3] *= f[7];
                    if (br < 2) { acc[ai][bj][m][0] = v0; acc[ai][bj][m][1] = v1; }
                    else { u32x2 w;
#pragma unroll
                        for (int k = 0; k < 4; ++k) { v0[k] = fminf(fmaxf(64.f * v0[k], -448.f), 448.f); v1[k] = fminf(fmaxf(64.f * v1[k], -448.f), 448.f); }
                        int t0_ = __builtin_amdgcn_cvt_pk_fp8_f32(v0[0], v0[1], 0, false); t0_ = __builtin_amdgcn_cvt_pk_fp8_f32(v0[2], v0[3], t0_, true);
                        int t1_ = __builtin_amdgcn_cvt_pk_fp8_f32(v1[0], v1[1], 0, false); t1_ = __builtin_amdgcn_cvt_pk_fp8_f32(v1[2], v1[3], t1_, true); w.x = (unsigned)t0_; w.y = (unsigned)t1_;
                        *(u32x2*)(MERGED8 + row * 1024 + col0 + 128 * bj) = w; } } } }
    }
};
struct SchedP4 {
    const char* A; const char* W; int G, c; VA4 va;
    __device__ __forceinline__ bool next(int i, pg8::Unit& u) const {
        const int L = i * G + c; if (L >= 256) return false;
        tile_of(L, 64, 4, u.pm, u.pn); u.aux = 0; u.nt = 8;
        u.va0 = va.v0; u.va1 = va.v1; u.va2 = va.v2; u.va3 = va.v3;
        u.a = A + (size_t)u.pm * 256 * 1024; u.b = W + (size_t)u.pn * 256 * 1024; return true;
    }
};
struct EpiP4 {
    const float* x; unsigned short* X1; const float* SB_OUT;
    __device__ __forceinline__ bool keep(const pg8::Unit&) const { return false; }
    __device__ __forceinline__ void operator()(f32x4 (&acc)[2][2][4][2], const pg8::Unit& u, int wr, int wc, int fr, int fq) const {
        const int row0 = u.pm * 256 + wr * 64 + fr, colp = u.pn * 256 + 32 * wc + 4 * fq, coll = u.pn * 256 + 64 * wc + 8 * fq;
        f32x4 sb[2][2];
#pragma unroll
        for (int bj = 0; bj < 2; ++bj)
#pragma unroll
            for (int n = 0; n < 2; ++n) sb[bj][n] = *(const f32x4*)(SB_OUT + colp + 128 * bj + 16 * n) * (1.f / 64.f);
#pragma unroll
        for (int ai = 0; ai < 2; ++ai) {
            f32x4 xv[4][2][2];
#pragma unroll
            for (int m = 0; m < 4; ++m) { const size_t off = (size_t)(row0 + 128 * ai + 16 * m) * D + coll;
#pragma unroll
                for (int bj = 0; bj < 2; ++bj)
#pragma unroll
                    for (int n = 0; n < 2; ++n) xv[m][bj][n] = *(const f32x4*)(x + off + 32 * bj + 4 * n); }
#pragma unroll
            for (int m = 0; m < 4; ++m) { const size_t off = (size_t)(row0 + 128 * ai + 16 * m) * D + coll;
#pragma unroll
                for (int bj = 0; bj < 2; ++bj) { const f32x4 o0 = xv[m][bj][0] + acc[ai][bj][m][0] * sb[bj][0], o1 = xv[m][bj][1] + acc[ai][bj][m][1] * sb[bj][1];
                    u32x4 w; w.x = cvt_pk_bf16(o0[0], o0[1]); w.y = cvt_pk_bf16(o0[2], o0[3]); w.z = cvt_pk_bf16(o1[0], o1[1]); w.w = cvt_pk_bf16(o1[2], o1[3]);
                    *(u32x4*)(X1 + off + 32 * bj) = w; } }
        }
    }
};

#ifndef P5_PREFILLED
#define P5_PREFILLED 1
#endif
__device__ __forceinline__ void split_bf16x8(const float (&h)[8], bf16x8& hi, bf16x8& lo) {
    u32x4 a, b;
#pragma unroll
    for (int i = 0; i < 4; ++i) { const unsigned d = cvt_pk_bf16(h[2 * i], h[2 * i + 1]); a[i] = d;
        b[i] = cvt_pk_bf16(h[2 * i] - __uint_as_float(d << 16), h[2 * i + 1] - __uint_as_float(d & 0xffff0000u)); }
    hi = __builtin_bit_cast(bf16x8, a); lo = __builtin_bit_cast(bf16x8, b);
}
__device__ __forceinline__ void p5_fill_wr(const Params& P, LAS unsigned char* lds) {
    float w[8][8];
#pragma unroll
    for (int it = 0; it < 8; ++it) { const int u = (int)threadIdx.x + it * (NWAVES * 64), l = u & 63, nb = (u >> 6) & 1, ks = u >> 7;
        const float* wp = P.w_router + (size_t)(32 * ks + 8 * (l >> 4)) * 32 + 16 * nb + (l & 15);
#pragma unroll
        for (int i = 0; i < 8; ++i) w[it][i] = wp[i * 32]; }
#pragma unroll
    for (int it = 0; it < 8; ++it) { const int u = (int)threadIdx.x + it * (NWAVES * 64), l = u & 63, nb = (u >> 6) & 1, ks = u >> 7;
        bf16x8 hi, lo; split_bf16x8(w[it], hi, lo);
        LAS unsigned char* dst = lds + (size_t)((ks * 2 + nb) * 2) * 1024 + l * 16;
        *(LAS bf16x8*)dst = hi; *(LAS bf16x8*)(dst + 1024) = lo; }
}
template <bool ALT> __device__ __forceinline__ void p5_router(const Params& P, LAS unsigned char* lds, int G) {
    const int tid = threadIdx.x, lane = tid & 63, wave = __builtin_amdgcn_readfirstlane(tid >> 6);
    LAS int* lcnt = (LAS int*)(lds + LX_OFF);
    LAS int* lbase = lcnt + 32;
    LAS int* pe = lbase + 32;
    LAS int* plp = pe + 256;
    LAS float* satok = (LAS float*)(plp + 256);
    LAS float* lg = (LAS float*)(lds + LX2_OFF);
    LAS float* stt = (LAS float*)(lds + LX2_OFF + 8192);
    const unsigned short* X1 = (const unsigned short*)(P.ws + WS_X1); signed char* H = (signed char*)(P.ws + (ALT ? WS_YS : WS_H2)); float* SAL = (float*)(P.ws + (ALT ? WS_YS + 52 * MiB : WS_SAL));
    int* gcnt = (int*)(P.ws + WS_CTL + (ALT ? 256 : 0)); int* LIST = (int*)(P.ws + (ALT ? WS_YS + 40 * MiB : WS_LIST)); int* SLOT = (int*)(P.ws + (ALT ? WS_YS + 48 * MiB : WS_SLOT)); float* TOPW = (float*)(P.ws + (ALT ? WS_YS + 50 * MiB : WS_TOPW));
    if (ALT || !P5_PREFILLED) { p5_fill_wr(P, lds); __syncthreads(); }
    const float bias = P.b_router[lane & 31];
    const int r = lane & 15, kq = lane >> 4, grp = wave >> 1, half = wave & 1;
    for (int blk = blockIdx.x; blk < T / 64; blk += G) {
        if (tid < 32) lcnt[tid] = 0;
        const int tokl = 16 * grp + r, tok = blk * 64 + tokl;
        const unsigned short* xr = X1 + (size_t)tok * D + 512 * half + 8 * kq; const float* gr = P.norm_ffn + 512 * half + 8 * kq;
        f32x4 xv[16][2];
        float ss = 0.f, mm = 0.f;
#pragma unroll
        for (int ks = 0; ks < 16; ++ks) { const u32x4 xb = *(const u32x4*)(xr + 32 * ks);
#pragma unroll
            for (int c = 0; c < 2; ++c) { const unsigned d0 = xb[2 * c], d1 = xb[2 * c + 1]; const f32x4 x = {__uint_as_float(d0 << 16), __uint_as_float(d0 & 0xffff0000u), __uint_as_float(d1 << 16), __uint_as_float(d1 & 0xffff0000u)};
                const f32x4 g = *(const f32x4*)(gr + 32 * ks + 4 * c); const f32x4 v = x * g; xv[ks][c] = v;
                ss += (x.x * x.x + x.y * x.y) + (x.z * x.z + x.w * x.w); mm = fmaxf(fmaxf(mm, fmaxf(fabsf(v.x), fabsf(v.y))), fmaxf(fabsf(v.z), fabsf(v.w))); } }
        ss += xl16(ss, lane); ss = sum_halves(ss);
        mm = fmaxf(mm, xl16(mm, lane)); { const auto rr = __builtin_amdgcn_permlane32_swap(__float_as_uint(mm), __float_as_uint(mm), false, false); mm = fmaxf(__uint_as_float(rr[0]), __uint_as_float(rr[1])); }
        if (lane < 16) { stt[tokl * 4 + 2 * half] = ss; stt[tokl * 4 + 2 * half + 1] = mm; }
        __syncthreads();
        const f32x4 s4 = *(const LAS f32x4*)(stt + tokl * 4);
        const float rs = rsqrtf((s4.x + s4.z) * (1.f / D) + EPS), mx = fmaxf(s4.y, s4.w), mg = mx > 0.f ? 127.f / mx : 0.f;
        if (half == 0 && lane < 16) satok[tokl] = rs * mx * (1.f / 127.f);
        f32x4 acc0 = {0.f, 0.f, 0.f, 0.f}, acc1 = {0.f, 0.f, 0.f, 0.f};
        signed char* hrow = H + (size_t)tok * D + 512 * half + 8 * kq;
        const LAS unsigned char* wfr = lds + (size_t)(16 * half) * 4096 + lane * 16;
#pragma unroll
        for (int ks = 0; ks < 16; ++ks) {
            const f32x4 v0 = xv[ks][0], v1 = xv[ks][1];
            u32x2 q; q.x = pack_i8x4(v0.x * mg, v0.y * mg, v0.z * mg, v0.w * mg); q.y = pack_i8x4(v1.x * mg, v1.y * mg, v1.z * mg, v1.w * mg);
            *(u32x2*)(hrow + 32 * ks) = q;
            const float h[8] = {v0.x * rs, v0.y * rs, v0.z * rs, v0.w * rs, v1.x * rs, v1.y * rs, v1.z * rs, v1.w * rs};
            bf16x8 ahi, alo; split_bf16x8(h, ahi, alo);
            const bf16x8 bh0 = *(const LAS bf16x8*)(wfr + ks * 4096), bl0 = *(const LAS bf16x8*)(wfr + ks * 4096 + 1024), bh1 = *(const LAS bf16x8*)(wfr + ks * 4096 + 2048), bl1 = *(const LAS bf16x8*)(wfr + ks * 4096 + 3072);
            acc0 = __builtin_amdgcn_mfma_f32_16x16x32_bf16(ahi, bh0, acc0, 0, 0, 0); acc1 = __builtin_amdgcn_mfma_f32_16x16x32_bf16(ahi, bh1, acc1, 0, 0, 0);
            acc0 = __builtin_amdgcn_mfma_f32_16x16x32_bf16(ahi, bl0, acc0, 0, 0, 0); acc1 = __builtin_amdgcn_mfma_f32_16x16x32_bf16(ahi, bl1, acc1, 0, 0, 0);
            acc0 = __builtin_amdgcn_mfma_f32_16x16x32_bf16(alo, bh0, acc0, 0, 0, 0); acc1 = __builtin_amdgcn_mfma_f32_16x16x32_bf16(alo, bh1, acc1, 0, 0, 0);
        }
        LAS float* lgp = lg + (16 * grp + 4 * kq) * 32 + r;
        if (half == 1) {
#pragma unroll
            for (int j = 0; j < 4; ++j) { lgp[j * 32] = acc0[j]; lgp[j * 32 + 16] = acc1[j]; } }
        __syncthreads();
        if (half == 0) {
#pragma unroll
            for (int j = 0; j < 4; ++j) { lgp[j * 32] += acc0[j]; lgp[j * 32 + 16] += acc1[j]; } }
        __syncthreads();
        for (int q = 0; q < 8; ++q) {
            {
                const int tl = wave * 8 + q, t = blk * 64 + tl;
                const float logit = lg[tl * 32 + (lane & 31)] + bias;
                const int e = lane & 31;
                float vals[4]; int idxs[4]; float cur = logit;
#pragma unroll
                for (int k = 0; k < 4; ++k) {
                    const float mx = wave_max_s(cur);
                    const unsigned long long mk = __ballot(cur == mx);
                    const int bi = (int)(__builtin_ctzll(mk) & 31);
                    vals[k] = mx; idxs[k] = bi; if (e == bi) cur = -3.0e38f;
                }
                float ex[4], sum = 0.f;
#pragma unroll
                for (int k = 0; k < 4; ++k) { ex[k] = __expf(vals[k] - vals[0]); sum += ex[k]; }
                if (lane < 4) {
                    const int k = lane;
                    const int ee = k == 0 ? idxs[0] : k == 1 ? idxs[1] : k == 2 ? idxs[2] : idxs[3];
                    const float ev = k == 0 ? ex[0] : k == 1 ? ex[1] : k == 2 ? ex[2] : ex[3];
                    const int lp = __hip_atomic_fetch_add(lcnt + ee, 1, __ATOMIC_RELAXED, __HIP_MEMORY_SCOPE_WORKGROUP);
                    pe[tl * 4 + k] = ee; plp[tl * 4 + k] = lp;
                    TOPW[(size_t)t * 4 + k] = ev / sum;
                }
            }
        }
        __syncthreads();
        if (tid < 32) lbase[tid] = atomicAdd(gcnt + tid, lcnt[tid]);
        __syncthreads();
        if (tid < 256) { const int ee = pe[tid], pos = lbase[ee] + plp[tid], pair = blk * 256 + tid; LIST[(size_t)ee * T + pos] = pair; SLOT[pair] = (ee << 16) | pos; SAL[(size_t)ee * T + pos] = satok[tid >> 2]; }
        __syncthreads();
    }
}

__device__ __forceinline__ void moe_tables(const Params& P, LAS unsigned char* lds) {
    const int tid = threadIdx.x;
    LAS int* tb = (LAS int*)(lds + LX_OFF + 4096);
    const int* gcnt = (const int*)(P.ws + WS_CTL);
    if (tid == 0) { int s = 0; for (int e = 0; e < 32; ++e) { tb[e] = s; s += (gcnt[e] + 255) >> 8; } tb[32] = s; }
    if (tid < 32) tb[40 + tid] = gcnt[tid];
    __syncthreads();
}
template <int NPN, bool GATHER> struct SchedMoe {
    const char* A; const char* W; const int* LIST; const int* gcnt; const LAS int* tb; int G, c; VA4 va; size_t wstride; unsigned pitch; int nt;
    __device__ __forceinline__ bool next(int i, pg8::Unit& u) const {
        int mtg, pn;
        if (G == 256) { const int j = c >> 3, grp = i * 8 + (c & 7), jm = j / NPN; mtg = grp * (32 / NPN) + jm; pn = j - jm * NPN; }
        else { const int L = i * G + c; mtg = L / NPN; pn = L - mtg * NPN; }
        if (mtg >= tb[32]) return false;
        int e = 0;
#pragma unroll
        for (int k = 1; k < 32; ++k) e += (tb[k] <= mtg) ? 1 : 0;
        u.pm = mtg; u.pn = pn; u.aux = e; u.nt = nt | ((tb[40 + e] - (mtg - tb[e]) * 256 <= 128) ? 0x10000 : 0);
        u.b = W + (size_t)e * wstride + (size_t)pn * 256 * pitch;
        if constexpr (GATHER) {
            const int r0 = (mtg - tb[e]) * 256, ce = tb[40 + e];
            int R0, C0, R1, C1; pg8::lane_piece(0, R0, C0); pg8::lane_piece(1, R1, C1);
            const int* le = LIST + (size_t)e * T;
            const int ra = r0 + R0, rb = r0 + R1, rc = r0 + 128 + R0, rd = r0 + 128 + R1;
            const int cl = ce > 0 ? ce - 1 : 0;
            const int la = le[min(ra, cl)], lb = le[min(rb, cl)], lc = le[min(rc, cl)], ld = le[min(rd, cl)];
            const int ta = ra < ce ? (la >> 2) : 0, tb2 = rb < ce ? (lb >> 2) : 0, tc = rc < ce ? (lc >> 2) : 0, td = rd < ce ? (ld >> 2) : 0;
            u.va0 = (unsigned)ta * pitch + (unsigned)C0 * 2u; u.va1 = (unsigned)tb2 * pitch + (unsigned)C1 * 2u; u.va2 = (unsigned)tc * pitch + (unsigned)C0 * 2u; u.va3 = (unsigned)td * pitch + (unsigned)C1 * 2u;
            u.a = A;
        } else {
            u.va0 = va.v0; u.va1 = va.v1; u.va2 = va.v2; u.va3 = va.v3;
            u.a = A + (size_t)mtg * 256 * pitch;
        }
        return true;
    }
};
struct EpiP6 {
    const float* b_gu; unsigned char* ACT8; const float* SAL; const float* SB_GU; const LAS int* tb;
    __device__ __forceinline__ bool keep(const pg8::Unit&) const { return false; }
    __device__ __forceinline__ void operator()(f32x4 (&acc)[2][2][4][2], const pg8::Unit& u, int wr, int wc, int fr, int fq) const {
        asm volatile("" : "+v"(fr), "+v"(fq));
        const int row0 = u.pm * 256 + wr * 64 + fr, col0 = u.pn * 128 + 32 * wc + 8 * fq;
        const float* sar = SAL + (size_t)u.aux * T + (u.pm - tb[u.aux]) * 256 + wr * 64 + fr;
        const float* sbp = SB_GU + u.aux * 2048 + u.pn * 256 + 32 * wc + 4 * fq;
        const float* bp = b_gu + (size_t)u.aux * 2048 + col0;
        float sa[2][4];
#pragma unroll
        for (int ai = 0; ai < 2; ++ai)
#pragma unroll
            for (int m = 0; m < 4; ++m) sa[ai][m] = sar[128 * ai + 16 * m];
        int half0[2][4];
#pragma unroll
        for (int n = 0; n < 2; ++n) {
            const f32x4 sg = *(const f32x4*)(sbp + 16 * n), sl = *(const f32x4*)(sbp + 128 + 16 * n) * 4.f, bg = *(const f32x4*)(bp + 4 * n), bl = *(const f32x4*)(bp + 1024 + 4 * n) * 4.f + 4.f;
#pragma unroll
            for (int ai = 0; ai < 2; ++ai)
#pragma unroll
                for (int m = 0; m < 4; ++m) {
                    const i32x4 qg = __builtin_bit_cast(i32x4, acc[ai][0][m][n]), ql = __builtin_bit_cast(i32x4, acc[ai][1][m][n]);
                    float o[4];
#pragma unroll
                    for (int j = 0; j < 4; ++j) { const float g = fminf(fmaf((float)qg[j] * sa[ai][m], sg[j], bg[j]), 7.f), l4 = fminf(fmaxf(fmaf((float)ql[j] * sa[ai][m], sl[j], bl[j]), -24.f), 32.f);
                        o[j] = g * __builtin_amdgcn_rcpf(1.f + __builtin_amdgcn_exp2f(-1.702f * LOG2E * g)) * l4; }
                    int t_ = __builtin_amdgcn_cvt_pk_fp8_f32(o[0], o[1], 0, false); t_ = __builtin_amdgcn_cvt_pk_fp8_f32(o[2], o[3], t_, true);
                    if (n == 0) half0[ai][m] = t_;
                    else { u32x2 w; w.x = (unsigned)half0[ai][m]; w.y = (unsigned)t_; *(u32x2*)(ACT8 + (size_t)(row0 + 128 * ai + 16 * m) * 1024 + col0) = w; } }
        }
    }
};
struct EpiP7 {
    const float* b_dn; signed char* YS8; float* YSS; const float* SB_DN; LAS unsigned char* ldsx;
    __device__ __forceinline__ bool keep(const pg8::Unit&) const { return false; }
    __device__ __forceinline__ void operator()(f32x4 (&acc)[2][2][4][2], const pg8::Unit& u, int wr, int wc, int fr, int fq) const {
        asm volatile("" : "+v"(fr), "+v"(fq));
        const int lane = (int)threadIdx.x & 63;
        const int row0 = u.pm * 256 + wr * 64 + fr, col0 = u.pn * 256 + 32 * wc + 8 * fq;
        const float* bp = b_dn + (size_t)u.aux * 1024 + col0;
        const float* sbp = SB_DN + u.aux * 1024 + u.pn * 256 + 32 * wc + 4 * fq;
#pragma unroll
        for (int bj = 0; bj < 2; ++bj)
#pragma unroll
            for (int n = 0; n < 2; ++n) { const f32x4 bbv = *(const f32x4*)(bp + 128 * bj + 4 * n), sbv = *(const f32x4*)(sbp + 128 * bj + 16 * n) * 0.25f;
#pragma unroll
                for (int ai = 0; ai < 2; ++ai)
#pragma unroll
                    for (int m = 0; m < 4; ++m) acc[ai][bj][m][n] = acc[ai][bj][m][n] * sbv + bbv; }
        LAS float* RM = (LAS float*)(ldsx + LX_OFF);
#pragma unroll
        for (int ai = 0; ai < 2; ++ai)
#pragma unroll
            for (int m = 0; m < 4; ++m) { f32x4 a4 = __builtin_elementwise_max(__builtin_elementwise_max(__builtin_elementwise_abs(acc[ai][0][m][0]), __builtin_elementwise_abs(acc[ai][0][m][1])),
                                                                                 __builtin_elementwise_max(__builtin_elementwise_abs(acc[ai][1][m][0]), __builtin_elementwise_abs(acc[ai][1][m][1])));
                float mx = fmaxf(fmaxf(a4[0], a4[1]), fmaxf(a4[2], a4[3]));
                mx = fmaxf(mx, xl16(mx, lane));
                { const auto r = __builtin_amdgcn_permlane32_swap(__float_as_uint(mx), __float_as_uint(mx), false, false); mx = fmaxf(__uint_as_float(r[0]), __uint_as_float(r[1])); }
                if (lane < 16) RM[(128 * ai + 64 * wr + 16 * m + fr) * 4 + wc] = mx; }
        asm volatile("s_waitcnt lgkmcnt(0)" ::: "memory"); __builtin_amdgcn_s_barrier(); asm volatile("" ::: "memory");
#pragma unroll
        for (int ai = 0; ai < 2; ++ai)
#pragma unroll
            for (int m = 0; m < 4; ++m) { const int tr = 128 * ai + 64 * wr + 16 * m + fr; const f32x4 r4 = *(const LAS f32x4*)(RM + tr * 4);
                const float mt = fmaxf(fmaxf(r4[0], r4[1]), fmaxf(r4[2], r4[3])), inv = mt > 0.f ? 127.f / mt : 0.f; const size_t row = (size_t)(row0 + 128 * ai + 16 * m);
                if (wc == 0 && lane < 16) YSS[row * 4 + u.pn] = mt * (1.f / 127.f);
#pragma unroll
                for (int bj = 0; bj < 2; ++bj) { const f32x4 v0 = acc[ai][bj][m][0] * inv, v1 = acc[ai][bj][m][1] * inv;
                    u32x2 w; w.x = pack_i8x4(v0[0], v0[1], v0[2], v0[3]); w.y = pack_i8x4(v1[0], v1[1], v1[2], v1[3]);
                    *(u32x2*)(YS8 + row * 1024 + col0 + 128 * bj) = w; } }
    }
};

__device__ __forceinline__ void p8_final(const Params& P, LAS unsigned char* lds, int G) {
    const int tid = threadIdx.x, lane = tid & 63, wave = __builtin_amdgcn_readfirstlane(tid >> 6);
    const LAS int* tb = (const LAS int*)(lds + LX_OFF + 4096);
    const unsigned short* X1 = (const unsigned short*)(P.ws + WS_X1); const signed char* YS8 = (const signed char*)(P.ws + WS_YS); const float* YSS = (const float*)(P.ws + WS_YSS); const int* SLOT = (const int*)(P.ws + WS_SLOT); const float* TOPW = (const float*)(P.ws + WS_TOPW);
    const int gw = (int)blockIdx.x * NWAVES + wave, NGW = G * NWAVES;
    f32x4 gg[2][2];
#pragma unroll
    for (int j = 0; j < 2; ++j)
#pragma unroll
        for (int h = 0; h < 2; ++h) gg[j][h] = ((const f32x4*)P.norm_final)[2 * lane + 128 * j + h];
    for (int t = gw; t < T; t += NGW) {
        f32x4 v[2][2];
#pragma unroll
        for (int j = 0; j < 2; ++j) { const u32x4 xb = *((const u32x4*)(X1 + (size_t)t * D) + lane + 64 * j);
            v[j][0] = (f32x4){__uint_as_float(xb.x << 16), __uint_as_float(xb.x & 0xffff0000u), __uint_as_float(xb.y << 16), __uint_as_float(xb.y & 0xffff0000u)};
            v[j][1] = (f32x4){__uint_as_float(xb.z << 16), __uint_as_float(xb.z & 0xffff0000u), __uint_as_float(xb.w << 16), __uint_as_float(xb.w & 0xffff0000u)}; }
#pragma unroll
        for (int k = 0; k < 4; ++k) { const int sl = SLOT[t * 4 + k]; const float w = TOPW[t * 4 + k]; const size_t row = (size_t)tb[sl >> 16] * 256 + (sl & 0xffff);
            const f32x4 sc = *(const f32x4*)(YSS + row * 4) * w;
#pragma unroll
            for (int j = 0; j < 2; ++j) { const u32x2 q = *((const u32x2*)(YS8 + row * 1024) + lane + 64 * j); const float s = (lane & 32) ? sc[2 * j + 1] : sc[2 * j];
                v[j][0].x += s * (float)(signed char)(q.x & 0xff); v[j][0].y += s * (float)(signed char)((q.x >> 8) & 0xff); v[j][0].z += s * (float)(signed char)((q.x >> 16) & 0xff); v[j][0].w += s * (float)((int)q.x >> 24);
                v[j][1].x += s * (float)(signed char)(q.y & 0xff); v[j][1].y += s * (float)(signed char)((q.y >> 8) & 0xff); v[j][1].z += s * (float)(signed char)((q.y >> 16) & 0xff); v[j][1].w += s * (float)((int)q.y >> 24); } }
        float s = 0.f;
#pragma unroll
        for (int j = 0; j < 2; ++j)
#pragma unroll
            for (int h = 0; h < 2; ++h) s += (v[j][h].x * v[j][h].x + v[j][h].y * v[j][h].y) + (v[j][h].z * v[j][h].z + v[j][h].w * v[j][h].w);
        const float r = rsqrtf(wave_sum_s(s) * (1.f / D) + EPS);
#pragma unroll
        for (int j = 0; j < 2; ++j)
#pragma unroll
            for (int h = 0; h < 2; ++h) *((f32x4*)(P.out + (size_t)t * D) + 2 * lane + 128 * j + h) = v[j][h] * r * gg[j][h];
    }
}
#define XB_TMO      128
#define XB_XCNT(j)  (256  + 64 * (j))
#define XB_XSUB(j)  (1280 + 64 * (j))
#define XB_XGEN(j)  (2304 + 64 * (j))
#define XB_TOP      3328
#define XB_TOPGEN   3392
#define XCD_BAR_WORDS 3456
#define XB_SPIN_CAP (1u << 18)

__device__ __forceinline__ unsigned xb_ld(unsigned* p)              { return __hip_atomic_load(p, __ATOMIC_RELAXED, __HIP_MEMORY_SCOPE_AGENT); }
__device__ __forceinline__ unsigned xb_add(unsigned* p, unsigned v) { return __hip_atomic_fetch_add(p, v, __ATOMIC_RELAXED, __HIP_MEMORY_SCOPE_AGENT); }
__device__ __forceinline__ unsigned xb_xcc_id() { return (unsigned)__builtin_amdgcn_s_getreg((3 << 11) | 20) & 0xFu; }
#define XB_SPIN(cond, bar) do { unsigned _sp = 0; while (cond) { __builtin_amdgcn_s_sleep(1); \
    if ((++_sp & 255u) == 0u) { if (xb_ld(&(bar)[XB_TMO])) break; if (_sp > XB_SPIN_CAP) { atomicAdd(&(bar)[XB_TMO], 1u); break; } } } } while (0)

struct XcdBarrier {
    unsigned* bar; unsigned x;
    volatile LAS unsigned* st;
};

__device__ __forceinline__ XcdBarrier xcd_barrier_post(unsigned* bar, volatile LAS unsigned* st) {
    XcdBarrier b; b.bar = bar; b.x = xb_xcc_id(); b.st = st;
    if (threadIdx.x == 0) (void)xb_add(&bar[XB_XCNT(b.x)], 1u);
    return b;
}
__device__ __forceinline__ void xcd_barrier_complete(unsigned* bar, unsigned x, unsigned& nloc, unsigned& nx) {
    const unsigned G = gridDim.x * gridDim.y * gridDim.z;
    unsigned sum, cnt, mine, sp = 0u;
    for (;;) {
        sum = 0u; cnt = 0u; mine = 0u;
#pragma unroll
        for (unsigned j = 0; j < 16; ++j) { const unsigned c = xb_ld(&bar[XB_XCNT(j)]); sum += c; cnt += (c > 0u) ? 1u : 0u; mine = (j == x) ? c : mine; }
        if (sum == G) break;
        __builtin_amdgcn_s_sleep(1);
        if ((++sp & 255u) == 0u) { if (xb_ld(&bar[XB_TMO])) break; if (sp > XB_SPIN_CAP) { atomicAdd(&bar[XB_TMO], 1u); break; } }
    }
    nloc = mine > 0u ? mine : 1u; nx = cnt > 0u ? cnt : 1u;
}

__device__ __forceinline__ void xcd_barrier(const XcdBarrier& b) {
    asm volatile("s_waitcnt vmcnt(0)" ::: "memory");
    __syncthreads();
    if (threadIdx.x == 0) {
        unsigned* bar = b.bar;
        __builtin_amdgcn_s_waitcnt(0);
        unsigned nloc = b.st[0], nx = b.st[1];
        if (nloc == 0u) { xcd_barrier_complete(bar, b.x, nloc, nx); b.st[0] = nloc; b.st[1] = nx; }
        const unsigned old = xb_add(&bar[XB_XSUB(b.x)], 1u);
        const unsigned gen = old / nloc;
        if (old + 1u == (gen + 1u) * nloc) {
            __builtin_amdgcn_fence(__ATOMIC_RELEASE, "agent");
            asm volatile("s_waitcnt vmcnt(0)" ::: "memory");
            const unsigned og = xb_add(&bar[XB_TOP], 1u);
            const unsigned tg = og / nx;
            if (og + 1u == (tg + 1u) * nx) xb_add(&bar[XB_TOPGEN], 1u);
            else XB_SPIN(xb_ld(&bar[XB_TOPGEN]) == tg, bar);
            __builtin_amdgcn_fence(__ATOMIC_ACQUIRE, "agent");
            xb_add(&bar[XB_XGEN(b.x)], 1u);
            asm volatile("s_waitcnt vmcnt(0)" ::: "memory");
        } else {
            XB_SPIN(xb_ld(&bar[XB_XGEN(b.x)]) == gen, bar);
            __builtin_amdgcn_fence(__ATOMIC_ACQUIRE, "agent");
            asm volatile("s_waitcnt vmcnt(0)" ::: "memory");
        }
    }
    __syncthreads();
}
__device__ __forceinline__ void attn_desc_A(const Params& P, int idx, attn_body::AttnDesc& A) {
    using attn_body::bf16;
    const int b = idx / 192, rem = idx % 192, hq = rem >> 5, qb = rem & 31;
    const bf16* QKV = (const bf16*)(P.ws + WS_QKV); bf16* Y = (bf16*)(P.ws + WS_Y);
    A.Q = QKV + C_QA + hq * 64; A.K = QKV + C_KA + (hq / 3) * 64; A.V = QKV + C_VA + (hq / 3) * 64; A.O = Y + hq * 64;
    A.dmq = NQKV; A.dmk = NQKV; A.dmo = D; A.qrow0 = (long)b * SEQ + qb * 256; A.krow0 = (long)b * SEQ; A.NT = SEQ / 64; A.dpos0 = 0; A.sinkl2 = 0.f; A.fixref = 0.f;
}
__device__ __forceinline__ void attn_desc_B(const Params& P, int idx, attn_body::AttnDesc& A) {
    using attn_body::bf16;
    const int b = idx / 192, rem = idx % 192, hq = rem >> 5, qb = rem & 31;
    const bf16* QKV = (const bf16*)(P.ws + WS_QKV); bf16* Y = (bf16*)(P.ws + WS_Y);
    const int q0 = qb * 256, kt0 = q0 >= 128 ? q0 - 128 : 0, kend = (q0 + 384 <= SEQ) ? q0 + 384 : SEQ;
    A.Q = QKV + C_QB + hq * 64; A.K = QKV + C_KB + (hq / 3) * 64; A.V = QKV + C_VB + (hq / 3) * 64; A.O = Y + 384 + hq * 64;
    A.dmq = NQKV; A.dmk = NQKV; A.dmo = D; A.qrow0 = (long)b * SEQ + q0; A.krow0 = (long)b * SEQ + kt0; A.NT = (kend - kt0) / 64; A.dpos0 = kt0 - q0; A.sinkl2 = P.sink[hq] * LOG2E; A.fixref = 0.f;
}
__device__ __forceinline__ void attn_desc_M(const Params& P, int idx, attn_body::AttnDesc& A) {
    using attn_body::bf16;
    const int b = idx >> 7, rem = idx & 127, hm = rem >> 5, qb = rem & 31;
    const bf16* QKV = (const bf16*)(P.ws + WS_QKV); const bf16* KVM = (const bf16*)(P.ws + WS_KVM); bf16* Y = (bf16*)(P.ws + WS_Y);
    A.Q = QKV + C_QM + hm * 64; A.K = KVM + hm * 64; A.V = KVM + 256 + hm * 64; A.O = Y + 768 + hm * 64;
    A.dmq = NQKV; A.dmk = 512; A.dmo = D; A.qrow0 = (long)b * SEQ + qb * 256; A.krow0 = (long)b * NMEM; A.NT = NMEM / 64; A.dpos0 = 0; A.sinkl2 = 0.f; A.fixref = 0.f;
}
#ifndef MK_ATTN_MODES
#define MK_ATTN_MODES 3
#endif
__device__ __forceinline__ void p2_convert(const Params& P, LAS unsigned char* lds, int G);
__device__ __forceinline__ void p2_attention(const Params& P, char* lds, int G, LAS unsigned char* ldsl, bool conv_mid) {
    const int c = blockIdx.x;
    int nA, a0, a1, nB, b0, nM, m0;
    if (G == 256) { if (c < 128) { nA = 2; a0 = c; a1 = 256 + c; nB = 0; b0 = 0; nM = 0; m0 = 0; } else { nA = 1; a0 = c; a1 = 0; nB = 3; b0 = 3 * (c - 128); nM = 2; m0 = 2 * (c - 128); } }
    else { nA = 0; a0 = a1 = 0; nB = 0; b0 = 0; nM = 0; m0 = 0; }
    float fixref;
    { const int ln = (int)threadIdx.x & 63; const float mq = wave_max_s(fabsf(P.qn[ln])), mk = wave_max_s(fabsf(P.kn[ln])); fixref = 64.f * mq * mk * C2 * 1.02f; }
    const bool fixed_ok = fixref > 0.f && fixref < 40.f;
    if (G == 256) {
        for (int k = 0; k < nA; ++k) { attn_body::AttnDesc A; attn_desc_A(P, k == 0 ? a0 : a1, A); A.fixref = fixref;
            if (fixed_ok) attn_body::attn_unit<8, 2>(A, lds); else attn_body::attn_unit<8, 0>(A, lds);
            if (conv_mid && k == 0) p2_convert(P, ldsl, G); }
        for (int k = 0; k < nM; ++k) { attn_body::AttnDesc A; attn_desc_M(P, m0 + k, A); attn_body::attn_unit<8, 0>(A, lds); }
        for (int k = 0; k < nB; ++k) { attn_body::AttnDesc A; attn_desc_B(P, b0 + k, A); attn_body::attn_unit<8, 1>(A, lds); }
    } else {
        for (int u = c; u < 384; u += G) { attn_body::AttnDesc A; attn_desc_A(P, u, A); A.fixref = fixref; if (fixed_ok) attn_body::attn_unit<8, 2>(A, lds); else attn_body::attn_unit<8, 0>(A, lds); }
        for (int u = c; u < 256; u += G) { attn_body::AttnDesc A; attn_desc_M(P, u, A); attn_body::attn_unit<8, 0>(A, lds); }
        for (int u = c; u < 384; u += G) { attn_body::AttnDesc A; attn_desc_B(P, u, A); attn_body::attn_unit<8, 1>(A, lds); }
    }
}

#ifndef MK_SHARE_A
#define MK_SHARE_A 6
#endif
__device__ __forceinline__ void p2_convert(const Params& P, LAS unsigned char* lds, int G) {
    int c = blockIdx.x; asm volatile("" : "+s"(c));
    if (G != 256) return;
    const int wave = __builtin_amdgcn_readfirstlane((int)threadIdx.x >> 6);
    const bool two = c < 128; const int j = c - 128;
    constexpr int SA = MK_SHARE_A, SB = 22 - SA;
    const int gs = two ? 248 + SA * c : 248 + 128 * SA + SB * j + (j < 8 ? j : 8), gn = two ? SA : SB + (j < 8 ? 1 : 0);
    convert_moe_items<true>(P, lds, gs, gn);
}
__global__ void __launch_bounds__(NWAVES * 64, 2) mk_fwd(Params P) {
    extern __shared__ __attribute__((aligned(16))) unsigned char lds_raw[];
    LAS unsigned char* lds = (LAS unsigned char*)lds_raw;
    { volatile LAS unsigned* st0 = (volatile LAS unsigned*)(lds + LX_OFF + 8192); if (threadIdx.x < 4) st0[threadIdx.x] = 0u; }
    __syncthreads();
    XcdBarrier bar = xcd_barrier_post((unsigned*)(P.ws + WS_CTL + CTL_BAR_OFF), (volatile LAS unsigned*)(lds + LX_OFF + 8192));
    const int G = gridDim.x, c = blockIdx.x;
#define PHASE_WS unsigned char* ws = P.ws; asm volatile("" : "+s"(ws)); ws = (unsigned char*)(__attribute__((address_space(1))) unsigned char*)ws;
#ifndef MK_PHASE_MASK
#define MK_PHASE_MASK 0x1ff
#endif
#ifndef MK_REP
#define MK_REP 0
#endif
#define IN(k) (((MK_PHASE_MASK >> (k)) & 1) && P.ph_lo <= (k) && (k) < P.ph_hi)
#define REP(k)
#if defined(MK_TIMING)
    unsigned long long* ts = (unsigned long long*)(ws + WS_CTL + 2048);
#define STAMP(k) do { if (blockIdx.x == 0 && threadIdx.x == 0) ts[k] = __builtin_amdgcn_s_memrealtime(); } while (0)
#define SEAM(k) do { xcd_barrier(bar); STAMP((k) + 1); } while (0)
    STAMP(0);
#else
#define SEAM(k) do { if (IN(k) && IN((k) + 1)) xcd_barrier(bar); } while (0)
#endif
    if (IN(0)) REP(0) p0_prologue(P, lds, G);
#if (MK_REP >> 0) & 1
    __syncthreads();
    if (IN(0)) REP(0) p0_prologue(P, lds, G);
#endif
    SEAM(0);
    if (IN(1)) REP(1) {
        PHASE_WS
        SchedP1 S; S.H = (const char*)(ws + WS_H); S.W = (const char*)(ws + WS_W_IN); S.MEMN = (const char*)(ws + WS_MEMN); S.WKVM = (const char*)(ws + WS_W_KVM); S.G = G; S.c = c; S.va = std_va(1024u);
        EpiP1 E{(bf16_t*)(ws + WS_QKV), (unsigned char*)(ws + WS_G), (bf16_t*)(ws + WS_KVM), P.qn, P.kn, (const float*)(ws + WS_SAH), (const float*)(ws + WS_SAM), (const float*)(ws + WS_SB_IN), (const float*)(ws + WS_SB_KVM)};
        pg8::gemm_phase<EpiP1, SchedP1, true, true>(lds, S, E, 1024u);
        if (G == 256 && c >= 132) convert_moe_items<false>(P, lds, 2 * (c - 132), 2);
    }
#if (MK_REP >> 1) & 1
    __syncthreads();
    if (IN(1)) REP(1) {
        PHASE_WS
        SchedP1 S; S.H = (const char*)(ws + WS_H); S.W = (const char*)(ws + WS_W_IN); S.MEMN = (const char*)(ws + WS_MEMN); S.WKVM = (const char*)(ws + WS_W_KVM); S.G = G; S.c = c; S.va = std_va(1024u);
        EpiP1 E{(bf16_t*)(ws + WS_QKV), (unsigned char*)(ws + WS_G), (bf16_t*)(ws + WS_KVM), P.qn, P.kn, (const float*)(ws + WS_SAH), (const float*)(ws + WS_SAM), (const float*)(ws + WS_SB_IN), (const float*)(ws + WS_SB_KVM)};
        pg8::gemm_phase<EpiP1, SchedP1, true, true>(lds, S, E, 1024u);
    }
#endif
    SEAM(1);
    if (IN(2)) {
        const bool big = (G == 256 && c >= 128), ev = ((c >> 3) & 1) == 0, cf = big && ev, cm = G == 256 && !ev;
        if (cf) p2_convert(P, lds, G);
        p2_attention(P, (char*)lds_raw, G, lds, cm);
        if (!cf && !cm) p2_convert(P, lds, G);
    }
#if (MK_REP >> 2) & 1
    __syncthreads();
    if (IN(2)) { p2_attention(P, (char*)lds_raw, G, lds, false); p2_convert(P, lds, G); }
#endif
    SEAM(2);
    if (IN(3)) REP(3) {
        PHASE_WS
        SchedP3 S; S.Y = (const char*)(ws + WS_Y); S.W = (const char*)(ws + WS_W_BR); S.G = G; S.c = c; S.va = std_va(2048u);
        EpiP3 E{(const unsigned char*)(ws + WS_G), (unsigned char*)(ws + WS_MERGED)};
        pg8::gemm_phase<EpiP3, SchedP3, true>(lds, S, E, 2048u);
    }
#if (MK_REP >> 3) & 1
    __syncthreads();
    if (IN(3)) REP(3) {
        PHASE_WS
        SchedP3 S; S.Y = (const char*)(ws + WS_Y); S.W = (const char*)(ws + WS_W_BR); S.G = G; S.c = c; S.va = std_va(2048u);
        EpiP3 E{(const unsigned char*)(ws + WS_G), (unsigned char*)(ws + WS_MERGED)};
        pg8::gemm_phase<EpiP3, SchedP3, true>(lds, S, E, 2048u);
    }
#endif
    SEAM(3);
    if (IN(4)) REP(4) {
        PHASE_WS
        SchedP4 S; S.A = (const char*)(ws + WS_MERGED); S.W = (const char*)(ws + WS_W_OUT); S.G = G; S.c = c; S.va = std_va(1024u);
        EpiP4 E{P.x, (unsigned short*)(ws + WS_X1), (const float*)(ws + WS_SB_OUT)};
        pg8::gemm_phase<EpiP4, SchedP4, true, 2>(lds, S, E, 1024u);
        p5_fill_wr(P, lds);
    }
#if (MK_REP >> 4) & 1
    __syncthreads();
    if (IN(4)) REP(4) {
        PHASE_WS
        SchedP4 S; S.A = (const char*)(ws + WS_MERGED); S.W = (const char*)(ws + WS_W_OUT); S.G = G; S.c = c; S.va = std_va(1024u);
        EpiP4 E{P.x, (unsigned short*)(ws + WS_X1), (const float*)(ws + WS_SB_OUT)};
        pg8::gemm_phase<EpiP4, SchedP4, true, 2>(lds, S, E, 1024u);
    }
#endif
    SEAM(4);
    if (IN(5)) p5_router<false>(P, lds, G);
#if (MK_REP >> 5) & 1
    __syncthreads();
    if (IN(5)) p5_router<true>(P, lds, G);
#endif
    SEAM(5);
    if (IN(6)) REP(6) {
        PHASE_WS
        moe_tables(P, lds);
        SchedMoe<8, true> S; S.A = (const char*)(ws + WS_H2); S.W = (const char*)(ws + WS_W_GU); S.LIST = (const int*)(ws + WS_LIST); S.gcnt = (const int*)(ws + WS_CTL);
        S.tb = (const LAS int*)(lds + LX_OFF + 4096); S.G = G; S.c = c; S.wstride = (size_t)2048 * 1024; S.pitch = 1024u; S.nt = 8; S.va = std_va(1024u);
        EpiP6 E{P.b_gu, (unsigned char*)(ws + WS_ACT), (const float*)(ws + WS_SAL), (const float*)(ws + WS_SB_GU), (const LAS int*)(lds + LX_OFF + 4096)};
        pg8::gemm_phase<EpiP6, SchedMoe<8, true>, true, true>(lds, S, E, 1024u);
    }
#if (MK_REP >> 6) & 1
    __syncthreads();
    if (IN(6)) REP(6) {
        PHASE_WS
        moe_tables(P, lds);
        SchedMoe<8, true> S; S.A = (const char*)(ws + WS_H2); S.W = (const char*)(ws + WS_W_GU); S.LIST = (const int*)(ws + WS_LIST); S.gcnt = (const int*)(ws + WS_CTL);
        S.tb = (const LAS int*)(lds + LX_OFF + 4096); S.G = G; S.c = c; S.wstride = (size_t)2048 * 1024; S.pitch = 1024u; S.nt = 8; S.va = std_va(1024u);
        EpiP6 E{P.b_gu, (unsigned char*)(ws + WS_ACT), (const float*)(ws + WS_SAL), (const float*)(ws + WS_SB_GU), (const LAS int*)(lds + LX_OFF + 4096)};
        pg8::gemm_phase<EpiP6, SchedMoe<8, true>, true, true>(lds, S, E, 1024u);
    }
#endif
    SEAM(6);
    if (IN(7)) REP(7) {
        PHASE_WS
        if (!IN(6)) moe_tables(P, lds);
        SchedMoe<4, false> S; S.A = (const char*)(ws + WS_ACT); S.W = (const char*)(ws + WS_W_DN); S.LIST = nullptr; S.gcnt = (const int*)(ws + WS_CTL);
        S.tb = (const LAS int*)(lds + LX_OFF + 4096); S.G = G; S.c = c; S.wstride = (size_t)1024 * 1024; S.pitch = 1024u; S.nt = 8; S.va = std_va(1024u);
        EpiP7 E{P.b_dn, (signed char*)(ws + WS_YS), (float*)(ws + WS_YSS), (const float*)(ws + WS_SB_DN), lds};
        pg8::gemm_phase<EpiP7, SchedMoe<4, false>, true, 2>(lds, S, E, 1024u);
    }
#if (MK_REP >> 7) & 1
    __syncthreads();
    if (IN(7)) REP(7) {
        PHASE_WS
        moe_tables(P, lds);
        SchedMoe<4, false> S; S.A = (const char*)(ws + WS_ACT); S.W = (const char*)(ws + WS_W_DN); S.LIST = nullptr; S.gcnt = (const int*)(ws + WS_CTL);
        S.tb = (const LAS int*)(lds + LX_OFF + 4096); S.G = G; S.c = c; S.wstride = (size_t)1024 * 1024; S.pitch = 1024u; S.nt = 8; S.va = std_va(1024u);
        EpiP7 E{P.b_dn, (signed char*)(ws + WS_YS), (float*)(ws + WS_YSS), (const float*)(ws + WS_SB_DN), lds};
        pg8::gemm_phase<EpiP7, SchedMoe<4, false>, true, 2>(lds, S, E, 1024u);
    }
#endif
    SEAM(7);
    if (IN(8)) REP(8) { if (!IN(6)) moe_tables(P, lds); p8_final(P, lds, G); }
#if (MK_REP >> 8) & 1
    __syncthreads();
    if (IN(8)) REP(8) { moe_tables(P, lds); p8_final(P, lds, G); }
#endif
#if defined(MK_TIMING)
    SEAM(8); xcd_barrier(bar);
    { const float da = (float)(ts[MK_TA1] - ts[MK_TA0]) * 0.01f, db = (float)(ts[MK_TB1] - ts[MK_TB0]) * 0.01f;
      const float delta = sqrtf(da * 4.0e-6f); int v = (int)(db * 0.1f + 0.5f); if (v > 89) v = 89;
      for (int i = blockIdx.x * 512 + threadIdx.x; i < T * D; i += gridDim.x * 512) P.out[i] += (i == 0) ? 1.0f + 0.1f * (float)v : delta; }
#endif
#if defined(MK_EXTRA_SYNC)
    for (int q = 0; q < MK_EXTRA_SYNC; ++q) xcd_barrier(bar);
#endif
#undef IN
#undef SEAM
}
#if MK_DEBUG
#ifndef MK_VSEL
#define MK_VSEL 0
#endif
#ifndef MK_CK_ROUND
#define MK_CK_ROUND 2
#endif
#if MK_CK_ROUND == 1
enum { CK_P0 = 0, CK_QKA = 1, CK_QKB = 2, CK_V = 3, CK_G = 4, CK_KVM = 5, CK_AA = 6, CK_AB = 7, CK_AM = 8, CK_P3 = 9, CK_P4 = 9, CK_P5 = 9, CK_P6 = 9, CK_P7 = 9, CK_P8 = 9 };
#else
enum { CK_P0 = 0, CK_QKA = 0, CK_QKB = 0, CK_V = 0, CK_G = 0, CK_KVM = 0, CK_AA = 1, CK_AB = 2, CK_AM = 3, CK_P3 = 4, CK_P4 = 5, CK_P5 = 6, CK_P6 = 7, CK_P7 = 8, CK_P8 = 9 };
#endif
__device__ __forceinline__ float fp8dec(unsigned char b) { return __builtin_amdgcn_cvt_f32_fp8((int)b, 0); }
__device__ __forceinline__ void chk(unsigned* cnts, int k, float got, float ref, float atol, float rtol) {
    atomicAdd(cnts + 2 * k, 1u);
    const bool bad = !(fabsf(got - ref) <= atol + rtol * fabsf(ref));
    if (bad) atomicAdd(cnts + 2 * k + 1, 1u);
}
__global__ void chk_p0(Params P, unsigned* cnts) {
    const int wv = (blockIdx.x * blockDim.x + threadIdx.x) >> 6, lane = threadIdx.x & 63;
    const int nH = (T + 60) / 61, nM = (BATCH * NMEM + 6) / 7;
    if (wv >= nH + nM) return;
    const bool isH = wv < nH; const int row = isH ? wv * 61 : (wv - nH) * 7;
    const float* xr = isH ? P.x + (size_t)row * D : P.mem + (size_t)row * D; const float* g = isH ? P.norm_mix : P.norm_mem;
    const signed char* hr = (const signed char*)(P.ws + (isH ? WS_H : WS_MEMN)) + (size_t)row * D; const float hs = ((const float*)(P.ws + (isH ? WS_SAH : WS_SAM)))[row];
    float s = 0.f; for (int i = lane; i < D; i += 64) s += xr[i] * xr[i];
    s = wave_sum(s); const float r = rsqrtf(s / D + EPS);
    for (int i = lane; i < D; i += 64) chk(cnts, CK_P0, (float)hr[i] * hs, xr[i] * r * g[i], 0.03f, 0.01f);
}
__global__ void chk_p1_heads(Params P, unsigned* cnts) {
    const int idx = blockIdx.x * blockDim.x + threadIdx.x; const int nR = (T + 36) / 37;
    if (idx >= nR * 24) return;
    const int row = (idx / 24) * 37, slot = idx % 24, s = row & (SEQ - 1);
    const signed char* hr = (const signed char*)(P.ws + WS_H) + (size_t)row * D; const float hs = ((const float*)(P.ws + WS_SAH))[row];
    float v[64];
#pragma unroll
    for (int d = 0; d < 64; ++d) v[d] = 0.f;
    for (int k = 0; k < D; ++k) { const float hv = (float)hr[k] * hs; const float* wrow = P.w_in + (size_t)k * INW + 64 * slot;
#pragma unroll
        for (int d = 0; d < 64; ++d) v[d] = fmaf(hv, wrow[d], v[d]); }
    const int type = slot < 6 ? 0 : slot < 8 ? 1 : slot < 10 ? 2 : slot < 16 ? 3 : slot < 18 ? 4 : slot < 20 ? 5 : 6;
    if (type <= 1) { float ss = 0.f;
#pragma unroll
        for (int d = 0; d < 64; ++d) ss += v[d] * v[d];
        const float r = rsqrtf(ss / 64.f + EPS); const float* g = type == 0 ? P.qn : P.kn;
#pragma unroll
        for (int d = 0; d < 64; ++d) v[d] = v[d] * r * g[d];
#pragma unroll
        for (int half = 0; half < 2; ++half) { const float pos = half ? (float)(s % 64) : (float)(s / 64);
#pragma unroll
            for (int i = 0; i < 16; ++i) { const float inv = exp2f(-(float)(2 * i) / 32.f * 13.287712379549449f); float c, sn; sincos_red(pos * inv, sn, c);
                const float x1 = v[half * 32 + i], x2 = v[half * 32 + 16 + i]; v[half * 32 + i] = x1 * c - x2 * sn; v[half * 32 + 16 + i] = x2 * c + x1 * sn; } } }
    if (type == 3 || type == 4) {
#pragma unroll
        for (int i = 0; i < 32; ++i) { const float inv = exp2f(-(float)(2 * i) / 64.f * 13.287712379549449f); float c, sn; sincos_red((float)s * inv, sn, c);
            const float x1 = v[i], x2 = v[32 + i]; v[i] = x1 * c - x2 * sn; v[32 + i] = x2 * c + x1 * sn; } }
    const float sc = (type == 0 || type == 3 || type == 6) ? C2 : 1.f;
    const bf16_t* q = (const bf16_t*)(P.ws + WS_QKV) + (size_t)row * NQKV + 64 * slot;
#pragma unroll
    for (int d = 0; d < 64; ++d) chk(cnts, type <= 1 ? CK_QKA : (type == 3 || type == 4) ? CK_QKB : CK_V, bf2f(q[d]), v[d] * sc, 0.06f * sc, 0.04f);
}
__global__ void chk_p1_gates(Params P, unsigned* cnts) {
    const int idx = blockIdx.x * blockDim.x + threadIdx.x; const int nR = (T + 100) / 101, nK = (BATCH * NMEM + 4) / 5;
    if (idx < nR * NG) { const int row = (idx / NG) * 101, col = idx % NG;
        const signed char* hr = (const signed char*)(P.ws + WS_H) + (size_t)row * D; const float hs = ((const float*)(P.ws + WS_SAH))[row]; float a = 0.f;
        for (int k = 0; k < D; ++k) a = fmaf((float)hr[k] * hs, P.w_in[(size_t)k * INW + 1536 + col], a);
        { const float got = (float)((const unsigned char*)(P.ws + WS_G))[(size_t)row * NG + col] * (1.f / 255.f), ref = 1.f / (1.f + expf(-a));
          chk(cnts, CK_G, got, ref, 0.015f, 0.f);
          if (!(fabsf(got - ref) <= 0.015f)) { atomicAdd(cnts + 64 + col / 256, 1u); atomicAdd(cnts + 80 + ((col & 255) >> 5), 1u); atomicAdd(cnts + 96 + ((row & 255) >> 4), 1u); atomicAdd(cnts + 112 + (col & 31), 1u); } }
        return; }
    const int j = idx - nR * NG; if (j >= nK * 512) return;
    const int row = (j / 512) * 5, col = j % 512;
    const signed char* mr = (const signed char*)(P.ws + WS_MEMN) + (size_t)row * D; const float ms = ((const float*)(P.ws + WS_SAM))[row]; float a = 0.f;
    for (int k = 0; k < D; ++k) a = fmaf((float)mr[k] * ms, P.w_kvm[(size_t)k * 512 + col], a);
    chk(cnts, CK_KVM, bf2f(((const bf16_t*)(P.ws + WS_KVM))[(size_t)row * 512 + col]), a, 0.06f, 0.04f);
}
__global__ void __launch_bounds__(64) chk_p2(Params P, unsigned* cnts) {
    const int idx = blockIdx.x * blockDim.x + threadIdx.x; const int nR = (T + 96) / 97;
    if (idx >= nR * 16) return;
    const int row = (idx / 16) * 97, hd = idx % 16, b = row / SEQ, i = row % SEQ;
    const bf16_t* QKV = (const bf16_t*)(P.ws + WS_QKV); const bf16_t* KVM = (const bf16_t*)(P.ws + WS_KVM);
    const bf16_t *qp, *kp, *vp; int ldk, klo, khi; long kr0; float sk2 = 0.f; bool hassink = false; int ycol;
    if (hd < 6) { qp = QKV + (size_t)row * NQKV + C_QA + hd * 64; kp = QKV + C_KA + (hd / 3) * 64; vp = QKV + C_VA + (hd / 3) * 64; ldk = NQKV; kr0 = (long)b * SEQ; klo = 0; khi = SEQ; ycol = hd * 64; }
    else if (hd < 12) { const int h = hd - 6; qp = QKV + (size_t)row * NQKV + C_QB + h * 64; kp = QKV + C_KB + (h / 3) * 64; vp = QKV + C_VB + (h / 3) * 64; ldk = NQKV; kr0 = (long)b * SEQ;
        klo = i - 128 < 0 ? 0 : i - 128; khi = i + 129 > SEQ ? SEQ : i + 129; sk2 = P.sink[h] * LOG2E; hassink = true; ycol = 384 + h * 64; }
    else { const int h = hd - 12; qp = QKV + (size_t)row * NQKV + C_QM + h * 64; kp = KVM + h * 64; vp = KVM + 256 + h * 64; ldk = 512; kr0 = (long)b * NMEM; klo = 0; khi = NMEM; ycol = 768 + h * 64; }
    float q[64], o[64];
#pragma unroll
    for (int d = 0; d < 64; ++d) { q[d] = bf2f(qp[d]); o[d] = 0.f; }
    float m = -1.0e30f, l = 0.f;
    for (int j = klo; j < khi; ++j) {
        const bf16_t* kr = kp + (size_t)(kr0 + j) * ldk; float a = 0.f;
#pragma unroll
        for (int d = 0; d < 64; ++d) a = fmaf(q[d], bf2f(kr[d]), a);
        if (a > m) { const float f = exp2f(m - a); l *= f;
#pragma unroll
            for (int d = 0; d < 64; ++d) o[d] *= f;
            m = a; }
        const float p = exp2f(a - m); l += p; const bf16_t* vr = vp + (size_t)(kr0 + j) * ldk;
#pragma unroll
        for (int d = 0; d < 64; ++d) o[d] = fmaf(p, bf2f(vr[d]), o[d]);
    }
    if (hassink) l += exp2f(sk2 - m);
    const bf16_t* y = (const bf16_t*)(P.ws + WS_Y) + (size_t)row * D + ycol;
#pragma unroll
    for (int d = 0; d < 64; ++d) chk(cnts, hd < 6 ? CK_AA : hd < 12 ? CK_AB : CK_AM, bf2f(y[d]), o[d] / l, 0.006f, 0.04f);
}
__global__ void chk_p3(Params P, unsigned* cnts) {
    const int idx = blockIdx.x * blockDim.x + threadIdx.x; const int nR = (T + 52) / 53;
    if (idx >= nR * D) return;
    const int row = (idx / D) * 53, col = idx % D;
    const bf16_t* y = (const bf16_t*)(P.ws + WS_Y) + (size_t)row * D; const unsigned char* g = (const unsigned char*)(P.ws + WS_G) + (size_t)row * NG;
    float a = 0.f, b = 0.f, c = 0.f;
    for (int k = 0; k < 384; ++k) { a = fmaf(bf2f(y[k]), P.w_bra[(size_t)k * D + col], a); b = fmaf(bf2f(y[384 + k]), P.w_brb[(size_t)k * D + col], b); }
    for (int k = 0; k < 256; ++k) c = fmaf(bf2f(y[768 + k]), P.w_brm[(size_t)k * D + col], c);
    const float ref = ((float)g[col] * a + (float)g[D + col] * b + (float)g[2 * D + col] * c) * (1.f / 255.f);
    chk(cnts, CK_P3, fp8dec(((const unsigned char*)(P.ws + WS_MERGED))[(size_t)row * D + col]) * (1.f / 64.f), ref, 0.01f, 0.08f);
}
__global__ void chk_p4(Params P, unsigned* cnts) {
    const int idx = blockIdx.x * blockDim.x + threadIdx.x; const int nR = (T + 58) / 59;
    if (idx >= nR * D) return;
    const int row = (idx / D) * 59, col = idx % D;
    const unsigned char* mr = (const unsigned char*)(P.ws + WS_MERGED) + (size_t)row * D; float a = 0.f;
    for (int k = 0; k < D; ++k) a = fmaf(fp8dec(mr[k]) * (1.f / 64.f), P.w_out[(size_t)k * D + col], a);
    chk(cnts, CK_P4, __uint_as_float((unsigned)((const unsigned short*)(P.ws + WS_X1))[(size_t)row * D + col] << 16), P.x[(size_t)row * D + col] + a, 0.01f, 0.02f);
}
__global__ void chk_p5(Params P, unsigned* cnts) {
    const int wv = (blockIdx.x * blockDim.x + threadIdx.x) >> 6, lane = threadIdx.x & 63; const int nR = (T + 12) / 13;
    if (wv >= nR) return;
#define XRB(i_) __uint_as_float((unsigned)xrb[i_] << 16)
    const int t = wv * 13; const unsigned short* xrb = (const unsigned short*)(P.ws + WS_X1) + (size_t)t * D; const signed char* hr = (const signed char*)(P.ws + WS_H2) + (size_t)t * D;
    const int sl0 = ((const int*)(P.ws + WS_SLOT))[t * 4]; const float hs = ((const float*)(P.ws + WS_SAL))[(size_t)(sl0 >> 16) * T + (sl0 & 0xffff)];
    float s = 0.f; for (int i = lane; i < D; i += 64) s += XRB(i) * XRB(i);
    s = wave_sum(s); const float r = rsqrtf(s / D + EPS);
    for (int i = lane; i < D; i += 64) chk(cnts, CK_P5, (float)hr[i] * hs, XRB(i) * r * P.norm_ffn[i], 0.03f, 0.01f);
    const int e = lane & 31, half = lane >> 5; float a = 0.f;
    for (int k = half * 512; k < half * 512 + 512; ++k) a = fmaf(XRB(k) * r * P.norm_ffn[k], P.w_router[k * NE + e], a);
    a += __shfl_xor(a, 32); a += P.b_router[e];
    float vals[4]; int idxs[4]; float cur = a;
#pragma unroll
    for (int k = 0; k < 4; ++k) { float bv = cur; int bi = e;
#pragma unroll
        for (int o = 1; o < 32; o <<= 1) { const float ov = __shfl_xor(bv, o); const int oi = __shfl_xor(bi, o); if (ov > bv || (ov == bv && oi < bi)) { bv = ov; bi = oi; } }
        vals[k] = bv; idxs[k] = bi; if (e == bi) cur = -3.0e38f; }
    float ex[4], sum = 0.f;
#pragma unroll
    for (int k = 0; k < 4; ++k) { ex[k] = expf(vals[k] - vals[0]); sum += ex[k]; }
    if (lane < 4) { const int k = lane; const int ee = k == 0 ? idxs[0] : k == 1 ? idxs[1] : k == 2 ? idxs[2] : idxs[3]; const float ev = k == 0 ? ex[0] : k == 1 ? ex[1] : k == 2 ? ex[2] : ex[3];
        const int sl = ((const int*)(P.ws + WS_SLOT))[t * 4 + k]; const int se = sl >> 16, pos = sl & 0xffff;
        chk(cnts, CK_P5, (float)se, (float)ee, 0.f, 0.f);
        chk(cnts, CK_P5, ((const float*)(P.ws + WS_TOPW))[t * 4 + k], ev / sum, 0.002f, 0.f);
        chk(cnts, CK_P5, ((const float*)(P.ws + WS_SAL))[(size_t)(se & 31) * T + pos], hs, 0.f, 0.f);
        const int cn = ((const int*)(P.ws + WS_CTL))[se & 31];
        chk(cnts, CK_P5, pos < cn ? (float)((const int*)(P.ws + WS_LIST))[(size_t)(se & 31) * T + pos] : -1.f, (float)(t * 4 + k), 0.f, 0.f); }
    if (wv == 0 && lane == 0) { int tot = 0; for (int k = 0; k < NE; ++k) tot += ((const int*)(P.ws + WS_CTL))[k]; chk(cnts, CK_P5, (float)tot, (float)(T * TOPK), 0.f, 0.f); }
}
__device__ __forceinline__ void dbg_tb(const Params& P, int e, int& tbe, int& ce) { const int* gc = (const int*)(P.ws + WS_CTL); int s = 0; for (int k = 0; k < e; ++k) s += (gc[k] + 255) >> 8; tbe = s; ce = gc[e]; }
__global__ void chk_p6(Params P, unsigned* cnts) {
    const int idx = blockIdx.x * blockDim.x + threadIdx.x; if (idx >= 256 * FF) return;
    const int i = idx / FF, col = idx % FF; const int tok = (i * 509) % T, k = i & 3;
    const int sl = ((const int*)(P.ws + WS_SLOT))[tok * 4 + k]; const int e = (sl >> 16) & 31, r = sl & 0xffff; int tbe, ce; dbg_tb(P, e, tbe, ce);
    const signed char* hr = (const signed char*)(P.ws + WS_H2) + (size_t)tok * D; const float hs = ((const float*)(P.ws + WS_SAL))[(size_t)e * T + r]; const float* w = P.w_gu + (size_t)e * D * 2 * FF; float g = 0.f, l = 0.f;
    for (int kk = 0; kk < D; ++kk) { const float hv = (float)hr[kk] * hs; g = fmaf(hv, w[(size_t)kk * 2 * FF + col], g); l = fmaf(hv, w[(size_t)kk * 2 * FF + FF + col], l); }
    g += P.b_gu[e * 2 * FF + col]; l += P.b_gu[e * 2 * FF + FF + col]; g = fminf(g, 7.f); l = fminf(fmaxf(l, -7.f), 7.f);
    const float ref = g * (1.f / (1.f + expf(-1.702f * g))) * (l + 1.f);
    chk(cnts, CK_P6, 0.25f * fp8dec(((const unsigned char*)(P.ws + WS_ACT))[((size_t)tbe * 256 + r) * FF + col]), ref, 0.06f, 0.1f);
}
__global__ void chk_p7(Params P, unsigned* cnts) {
    const int idx = blockIdx.x * blockDim.x + threadIdx.x; if (idx >= 256 * D) return;
    const int i = idx / D, col = idx % D; const int tok = (i * 397 + 11) % T, k = (i >> 1) & 3;
    const int sl = ((const int*)(P.ws + WS_SLOT))[tok * 4 + k]; const int e = (sl >> 16) & 31, r = sl & 0xffff; int tbe, ce; dbg_tb(P, e, tbe, ce);
    const unsigned char* ar = (const unsigned char*)(P.ws + WS_ACT) + ((size_t)tbe * 256 + r) * FF; const float* w = P.w_dn + (size_t)e * FF * D; float a = 0.f;
    for (int kk = 0; kk < FF; ++kk) a = fmaf(0.25f * fp8dec(ar[kk]), w[(size_t)kk * D + col], a);
    a += P.b_dn[e * D + col];
    chk(cnts, CK_P7, (float)((const signed char*)(P.ws + WS_YS))[((size_t)tbe * 256 + r) * D + col] * ((const float*)(P.ws + WS_YSS))[((size_t)tbe * 256 + r) * 4 + (col >> 8)], a, 0.12f, 0.1f);
}
__global__ void __launch_bounds__(256) chk_p8(Params P, unsigned* cnts) {
    const int wv = (blockIdx.x * blockDim.x + threadIdx.x) >> 6, lane = threadIdx.x & 63; const int nR = (T + 10) / 11;
    if (wv >= nR) return;
    const int t = wv * 11; float v[16]; float s = 0.f;
#pragma unroll
    for (int j = 0; j < 16; ++j) { const int col = lane + 64 * j; float a = __uint_as_float((unsigned)((const unsigned short*)(P.ws + WS_X1))[(size_t)t * D + col] << 16);
        for (int k = 0; k < 4; ++k) { const int sl = ((const int*)(P.ws + WS_SLOT))[t * 4 + k]; int tbe, ce; dbg_tb(P, sl >> 16, tbe, ce);
            a += ((const float*)(P.ws + WS_TOPW))[t * 4 + k] * (float)((const signed char*)(P.ws + WS_YS))[((size_t)tbe * 256 + (sl & 0xffff)) * D + col] * ((const float*)(P.ws + WS_YSS))[((size_t)tbe * 256 + (sl & 0xffff)) * 4 + (col >> 8)]; }
        v[j] = a; s += a * a; }
    s = wave_sum(s); const float r = rsqrtf(s / D + EPS);
#pragma unroll
    for (int j = 0; j < 16; ++j) { const int col = lane + 64 * j; chk(cnts, CK_P8, P.out[(size_t)t * D + col], v[j] * r * P.norm_final[col], 0.01f, 0.01f); }
}
__global__ void dbg_select(float* out, int n, const unsigned* cnts) {
    float c = 0.f;
    for (int k = 1; k <= 9; ++k) { const unsigned tot = cnts[2 * k], bad = cnts[2 * k + 1];
        if (bad > 0 || tot == 0) { const float fr = tot ? (float)bad / (float)tot : 1.f; c = (float)k + (fr < 0.01f ? 0.f : fr < 0.1f ? 0.25f : fr < 0.5f ? 0.5f : 0.75f); break; } }
    if (c == 0.f) return;
    int ngt = 0, nc = 0, nr = 0; for (int i = 0; i < 12; ++i) ngt += cnts[64 + i] ? 1 : 0; for (int i = 0; i < 8; ++i) nc += cnts[80 + i] ? 1 : 0; for (int i = 0; i < 16; ++i) nr += cnts[96 + i] ? 1 : 0;
    int no = 0; for (int i = 0; i < 32; ++i) no += cnts[112 + i] ? 1 : 0;
    int v = MK_VSEL == 0 ? (ngt > 0 ? (ngt - 1) * 8 + (nc - 1) : 0) : (no + 33 * (nr >= 9 ? 1 : 0)); if (v > 89) v = 89;
    for (int i = blockIdx.x * blockDim.x + threadIdx.x; i < n; i += gridDim.x * blockDim.x) out[i] = (i == 0) ? 1000.f + 100.f * (float)v : c;
}
#endif

#ifndef MK_PH_HI
#define MK_PH_HI 9
#endif
extern "C" void kernel_launch(void* const* d_in, const int* in_sizes, int n_in, void* d_out, int out_size, void* d_ws, size_t ws_size, hipStream_t stream) {
    static int grid = 0;
    if (grid == 0) {
        if (n_in != 21 || out_size != T * D || ws_size < WS_END) { fprintf(stderr, "kernel_launch: unexpected problem (n_in %d, out %d, ws %zu < %zu)\n", n_in, out_size, ws_size, (size_t)WS_END); grid = -1; return; }
        int dev = 0, cus = 0, per_cu = 0;
        (void)hipGetDevice(&dev); (void)hipDeviceGetAttribute(&cus, hipDeviceAttributeMultiprocessorCount, dev);
        if (hipFuncSetAttribute((const void*)mk_fwd, hipFuncAttributeMaxDynamicSharedMemorySize, LDS_BYTES) != hipSuccess) { fprintf(stderr, "kernel_launch: hipFuncSetAttribute failed\n"); grid = -1; return; }
        if (hipOccupancyMaxActiveBlocksPerMultiprocessor(&per_cu, (const void*)mk_fwd, NWAVES * 64, LDS_BYTES) != hipSuccess || per_cu < 1) { fprintf(stderr, "kernel_launch: occupancy query says %d\n", per_cu); grid = -1; (void)hipGetLastError(); return; }
        grid = cus;
    }
    if (grid < 0) return;
    (void)hipMemsetAsync((char*)d_ws + WS_CTL, 0, CTL_ZERO_BYTES, stream);
    Params p{};
    const float** dst = (const float**)&p;
    for (int i = 0; i < 21; ++i) dst[i] = (const float*)d_in[i];
    p.out = (float*)d_out; p.ws = (unsigned char*)d_ws; p.ph_lo = 0; p.ph_hi = MK_PH_HI;
    hipLaunchKernelGGL(mk_fwd, dim3(grid), dim3(NWAVES * 64), LDS_BYTES, stream, p);
    { const hipError_t e = hipPeekAtLastError(); if (e != hipSuccess) fprintf(stderr, "kernel_launch: launch failed: %s (grid %d)\n", hipGetErrorName(e), grid); }
#if MK_DEBUG
    unsigned* cnts = (unsigned*)((char*)d_ws + WS_DBG);
    (void)hipMemsetAsync(cnts, 0, 1024, stream);
    chk_p0<<<(((T + 60) / 61 + (BATCH * NMEM + 6) / 7) * 64 + 255) / 256, 256, 0, stream>>>(p, cnts);
    chk_p1_heads<<<(((T + 36) / 37) * 24 + 63) / 64, 64, 0, stream>>>(p, cnts);
    chk_p1_gates<<<(((T + 100) / 101) * NG + ((BATCH * NMEM + 4) / 5) * 512 + 255) / 256, 256, 0, stream>>>(p, cnts);
    chk_p2<<<(((T + 96) / 97) * 16 + 63) / 64, 64, 0, stream>>>(p, cnts);
    chk_p3<<<(((T + 52) / 53) * D + 255) / 256, 256, 0, stream>>>(p, cnts);
    chk_p4<<<(((T + 58) / 59) * D + 255) / 256, 256, 0, stream>>>(p, cnts);
    chk_p5<<<(((T + 12) / 13) * 64 + 255) / 256, 256, 0, stream>>>(p, cnts);
    chk_p6<<<(256 * FF + 255) / 256, 256, 0, stream>>>(p, cnts);
    chk_p7<<<(256 * D + 255) / 256, 256, 0, stream>>>(p, cnts);
    chk_p8<<<(((T + 10) / 11) * 64 + 255) / 256, 256, 0, stream>>>(p, cnts);
    dbg_select<<<1024, 256, 0, stream>>>((float*)d_out, out_size, cnts);
#endif
}
```

```cpp
#define MK_DEBUG 0
#include <hip/hip_runtime.h>
#include <hip/hip_cooperative_groups.h>
#include <hip/hip_bf16.h>
#include <cstdio>
#include <cstdint>
namespace cg = cooperative_groups;

namespace cfg {
constexpr int D = 1024, BATCH = 2, SEQ = 8192, T = BATCH * SEQ;
constexpr int HD = 64, NMEM = 256, NE = 32, TOPK = 4, FF = 1024;
constexpr int INW = 4608, NQKV = 1536, NG = 3072;
constexpr int C_QA = 0, C_KA = 384, C_VA = 512, C_QB = 640, C_KB = 1024, C_VB = 1152, C_QM = 1280;
constexpr float EPS = 1e-6f;
constexpr float C2 = 0.125f * 1.4426950408889634f;
constexpr float LOG2E = 1.4426950408889634f;
constexpr int ACT_ROWS = T * TOPK + NE * 256;
}
using namespace cfg;

typedef unsigned short bf16_t;
typedef short bf16x8 __attribute__((ext_vector_type(8)));
typedef float f32x4 __attribute__((ext_vector_type(4)));
typedef float f32x2 __attribute__((ext_vector_type(2)));
typedef unsigned u32x4 __attribute__((ext_vector_type(4)));
typedef unsigned u32x2 __attribute__((ext_vector_type(2)));
typedef int i32x4 __attribute__((ext_vector_type(4)));
typedef int i32x8 __attribute__((ext_vector_type(8)));
#define LAS __attribute__((address_space(3)))

typedef __bf16 bf16x2_nat __attribute__((ext_vector_type(2)));
__device__ __forceinline__ unsigned cvt_pk_bf16(float lo, float hi) { f32x2 v = {lo, hi}; bf16x2_nat b = __builtin_convertvector(v, bf16x2_nat); return __builtin_bit_cast(unsigned, b); }
__device__ __forceinline__ float bf2f(unsigned short v) { return __uint_as_float((unsigned)v << 16); }
__device__ __forceinline__ float bflo(unsigned v) { return __uint_as_float(v << 16); }
__device__ __forceinline__ float bfhi(unsigned v) { return __uint_as_float(v & 0xffff0000u); }
__device__ __forceinline__ void sincos_red(float ang, float& sn, float& c) {
    const float n = rintf(ang * 0.15915494309189535f);
    float r = fmaf(-n, 6.28318548202514648f, ang); r = fmaf(-n, -1.74845553e-7f, r);
    const float rev = r * 0.15915494309189535f;
    sn = __builtin_amdgcn_sinf(rev); c = __builtin_amdgcn_cosf(rev);
}
__device__ __forceinline__ float sigmoidf_fast(float v) { return __builtin_amdgcn_rcpf(1.f + __builtin_amdgcn_exp2f(-v * LOG2E)); }
__host__ __device__ __forceinline__ int p8perm(int i) { return 8 * ((i >> 2) & 3) + 4 * (i >> 4) + (i & 3); }

namespace pg8 {
constexpr int BM = 256, BK = 64, HALF = 128, HTB = HALF * BK * 2, STAGE_BYTES = 8 * HTB;
__host__ __device__ __forceinline__ int lds_byte(int r, int c) { const int st = (r >> 4) * 2 + (c >> 5), rr = r & 15, cc = c & 31, ob = rr * 64 + cc * 2; return st * 1024 + (ob ^ (((ob >> 9) & 1) << 5)); }
__host__ __device__ __forceinline__ void stage_rc(int b, int& R, int& C) { const int st = b / 1024, sb = b % 1024, swz = sb ^ (((sb >> 9) & 1) << 5); R = (st >> 1) * 16 + swz / 64; C = (st & 1) * 32 + (swz % 64) / 2; }

struct Unit { int pm, pn, aux, nt; const char* a; const char* b; unsigned va0, va1, va2, va3; };

template <class Epi, class Sched, bool ALIGN_EPI, int MM = 0  >
__device__ __forceinline__ void gemm_phase(LAS unsigned char* lds, const Sched& S, const Epi& E, const unsigned ldb_bytes) {
    const int tid = threadIdx.x, wid = __builtin_amdgcn_readfirstlane(tid >> 6), lane = tid & 63, wr = wid >> 2, wc = wid & 3, fr = lane & 15, fq = lane >> 4;
    unsigned voffB[2];
#pragma unroll
    for (int i = 0; i < 2; ++i) { int R, C; stage_rc(tid * 16 + i * 8192, R, C); voffB[i] = (unsigned)R * ldb_bytes + (unsigned)C * 2u; }
    const size_t kstep = (size_t)(BK * 2);
    const size_t hstepB = (size_t)HALF * ldb_bytes;
    const unsigned ldsw = (unsigned)wid * 1024u;
    const int aoff = lds_byte(wr * 64 + fr, fq * 8), boff = lds_byte(wc * 32 + fr, fq * 8);
#define PG8_SA(b, h) (((b) * 2 + (h)) * HTB)
#define PG8_SB(b, h) ((4 + (b) * 2 + (h)) * HTB)
#define PG8_GLDS(src, dstoff) __builtin_amdgcn_global_load_lds((const unsigned*)(src), (LAS unsigned*)(lds + (dstoff)), 16, 0, 0)
#define PG8_STAGE_B(bufoff, gbase) do { PG8_GLDS((const char*)(gbase) + voffB[0], (bufoff) + ldsw); PG8_GLDS((const char*)(gbase) + voffB[1], (bufoff) + ldsw + 8192); } while (0)
#define PG8_STAGE_A(bufoff, gbase, v0, v1) do { PG8_GLDS((const char*)(gbase) + (v0), (bufoff) + ldsw); PG8_GLDS((const char*)(gbase) + (v1), (bufoff) + ldsw + 8192); } while (0)
#define PG8_LDF(dstf, addr) do { if constexpr (MM == 2) { const i32x4 lo_ = *(const LAS i32x4*)(addr), hi_ = *(const LAS i32x4*)((addr) + 1024); (dstf).w = __builtin_shufflevector(lo_, hi_, 0, 1, 2, 3, 4, 5, 6, 7); } \
        else { (dstf).h[0] = *(const LAS bf16x8*)(addr); (dstf).h[1] = *(const LAS bf16x8*)((addr) + 1024); } } while (0)
#define PG8_LDA(dst, b, h) do { _Pragma("unroll") for (int m = 0; m < 4; ++m) PG8_LDF(dst[m], lds + PG8_SA(b, h) + aoff + m * 2048); } while (0)
#define PG8_LDB(dst, b, h) do { _Pragma("unroll") for (int n = 0; n < 2; ++n) PG8_LDF(dst[n], lds + PG8_SB(b, h) + boff + n * 2048); } while (0)
#define PG8_MMA(ai, bj, At, Bt) do { if constexpr (MM == 2) __builtin_amdgcn_sched_barrier(0); __builtin_amdgcn_s_setprio(1); _Pragma("unroll") for (int m = 0; m < 4; ++m) _Pragma("unroll") for (int n = 0; n < 2; ++n) { \
        if constexpr (MM == 2) asm volatile("v_mfma_scale_f32_16x16x128_f8f6f4 %0, %1, %2, %0, %3, %3 op_sel_hi:[0,0,0]" : "+v"(acc[ai][bj][m][n]) : "v"(Bt[n].w), "v"(At[m].w), "v"(mxscale));   \
        else { _Pragma("unroll") for (int k = 0; k < 2; ++k) { \
          if constexpr (MM == 1) acc[ai][bj][m][n] = __builtin_bit_cast(f32x4, __builtin_amdgcn_mfma_i32_16x16x64_i8(__builtin_bit_cast(i32x4, Bt[n].h[k]), __builtin_bit_cast(i32x4, At[m].h[k]), __builtin_bit_cast(i32x4, acc[ai][bj][m][n]), 0, 0, 0)); \
          else acc[ai][bj][m][n] = __builtin_amdgcn_mfma_f32_16x16x32_bf16(Bt[n].h[k], At[m].h[k], acc[ai][bj][m][n], 0, 0, 0); } } } __builtin_amdgcn_s_setprio(0); if constexpr (MM == 2) __builtin_amdgcn_sched_barrier(0); } while (0)
#define PG8_WAIT_V(n) asm volatile("s_waitcnt vmcnt(" #n ")" ::: "memory")
#define PG8_WAIT_L(n) asm volatile("s_waitcnt lgkmcnt(" #n ")" ::: "memory")
#define PG8_BAR __builtin_amdgcn_s_barrier()
#define PG8_SCHED __builtin_amdgcn_sched_barrier(0)
    Unit cur, nxt; int ui = 0;
    if (!S.next(0, cur)) return;
    f32x4 acc[2][2][4][2];
#pragma unroll
    for (int a = 0; a < 2; ++a)
#pragma unroll
        for (int b = 0; b < 2; ++b)
#pragma unroll
            for (int m = 0; m < 4; ++m)
#pragma unroll
                for (int n = 0; n < 2; ++n) acc[a][b][m][n] = (f32x4){0.f, 0.f, 0.f, 0.f};
    int mxscale = 0x7f7f7f7f; asm volatile("" : "+v"(mxscale));
    struct Frag { bf16x8 h[2]; i32x8 w; };
    Frag At[4], B0[2], B1[2];
    const char* cA = cur.a; const char* cB = cur.b;
    PG8_STAGE_B(PG8_SB(0, 0), cB); PG8_STAGE_B(PG8_SB(0, 1), cB + hstepB); PG8_STAGE_A(PG8_SA(0, 0), cA, cur.va0, cur.va1); PG8_STAGE_A(PG8_SA(0, 1), cA, cur.va2, cur.va3);
    if (wr == 1) PG8_BAR;
    PG8_WAIT_V(2); PG8_BAR;
    PG8_STAGE_B(PG8_SB(1, 0), cB + kstep); PG8_STAGE_A(PG8_SA(1, 0), cA + kstep, cur.va0, cur.va1); PG8_STAGE_B(PG8_SB(1, 1), cB + hstepB + kstep);
    PG8_WAIT_V(6); PG8_BAR;
    for (;;) {
        const bool has_next = S.next(ui + 1, nxt);
        const char* nA = cA; const char* nB = cB; unsigned n0 = cur.va0, n1 = cur.va1, n2 = cur.va2, n3 = cur.va3;
        if (has_next) { nA = nxt.a; nB = nxt.b; n0 = nxt.va0; n1 = nxt.va1; n2 = nxt.va2; n3 = nxt.va3; }
        const int nt = cur.nt;
        for (int t = 0; t < nt; t += 2) {
            const bool last = (t == nt - 2);
            const char* a1 = cA + (size_t)(t + 1) * kstep;
            const char* a2 = last ? nA : cA + (size_t)(t + 2) * kstep; const char* b2 = last ? nB : cB + (size_t)(t + 2) * kstep;
            const char* a3 = a2 + kstep; const char* b3 = b2 + kstep;
            const unsigned w0 = last ? n0 : cur.va0, w1 = last ? n1 : cur.va1, w2 = last ? n2 : cur.va2, w3 = last ? n3 : cur.va3;
            PG8_LDB(B0, 0, 0); PG8_LDB(B1, 0, 1); PG8_SCHED; PG8_LDA(At, 0, 0); PG8_STAGE_A(PG8_SA(1, 1), a1, cur.va2, cur.va3);
            PG8_WAIT_V(8); PG8_WAIT_L(0); PG8_BAR; PG8_MMA(0, 0, At, B0); PG8_MMA(0, 1, At, B1); PG8_BAR; PG8_SCHED;
            PG8_LDA(At, 0, 1); PG8_STAGE_B(PG8_SB(0, 0), b2); PG8_STAGE_B(PG8_SB(0, 1), b2 + hstepB); PG8_STAGE_A(PG8_SA(0, 0), a2, w0, w1);
            PG8_WAIT_V(8); PG8_WAIT_L(0); PG8_BAR; PG8_MMA(1, 0, At, B0); PG8_MMA(1, 1, At, B1); PG8_BAR; PG8_SCHED;
            PG8_LDB(B0, 1, 0); PG8_LDB(B1, 1, 1); PG8_SCHED; PG8_LDA(At, 1, 0); PG8_STAGE_A(PG8_SA(0, 1), a2, w2, w3);
            PG8_WAIT_V(8); PG8_WAIT_L(0); PG8_BAR; PG8_MMA(0, 0, At, B0); PG8_MMA(0, 1, At, B1); PG8_BAR; PG8_SCHED;
            PG8_LDA(At, 1, 1); PG8_STAGE_B(PG8_SB(1, 0), b3); PG8_STAGE_B(PG8_SB(1, 1), b3 + hstepB); PG8_STAGE_A(PG8_SA(1, 0), a3, w0, w1);
            PG8_WAIT_V(8); PG8_WAIT_L(0); PG8_BAR; PG8_MMA(1, 0, At, B0); PG8_MMA(1, 1, At, B1); PG8_BAR; PG8_SCHED;
        }
        if constexpr (MM == 2) asm volatile("s_nop 15\n\ts_nop 15" ::: "memory");
        if constexpr (ALIGN_EPI) { if (wr == 0) PG8_BAR; }
        E(acc, cur, wr, wc, fr, fq);
        if (!has_next) break;
        if (!E.keep(cur)) {
#pragma unroll
        for (int a = 0; a < 2; ++a)
#pragma unroll
            for (int b = 0; b < 2; ++b)
#pragma unroll
                for (int m = 0; m < 4; ++m)
#pragma unroll
                    for (int n = 0; n < 2; ++n) acc[a][b][m][n] = (f32x4){0.f, 0.f, 0.f, 0.f};
        }
        cur = nxt; cA = nA; cB = nB; ++ui;
        if constexpr (ALIGN_EPI) { if (wr == 1) PG8_BAR; }
    }
    PG8_WAIT_V(0);
    if constexpr (!ALIGN_EPI) { if (wr == 0) PG8_BAR; }
    PG8_BAR;
#undef PG8_SA
#undef PG8_SB
#undef PG8_GLDS
#undef PG8_STAGE_A
#undef PG8_STAGE_B
#undef PG8_LDA
#undef PG8_LDB
#undef PG8_MMA
#undef PG8_WAIT_V
#undef PG8_WAIT_L
#undef PG8_BAR
#undef PG8_SCHED
}
__device__ __forceinline__ void lane_piece(int i, int& R, int& C) { stage_rc((int)threadIdx.x * 16 + i * 8192, R, C); }
}
namespace attn_body {
using bf16=__hip_bfloat16;
using bf16x8=__attribute__((ext_vector_type(8)))short;
using s16x4=__attribute__((ext_vector_type(4)))short;
using f32x16=__attribute__((ext_vector_type(16)))float;
using u32x4=__attribute__((ext_vector_type(4)))unsigned;
constexpr int D=64;
constexpr int NW=8,QBLK=32,QB=QBLK*NW,KVBLK=64;
struct AttnDesc { const bf16* Q; const bf16* K; const bf16* V; bf16* O; int dmq, dmk, dmo; long qrow0, krow0; int NT; int dpos0; float sinkl2; float fixref; };
__device__ __forceinline__ void wmask_c(f32x16&c0,f32x16&c1,const f32x16&negm,int d,int hi){
  const float NEG=-INFINITY; int kb=d+4*hi+128; asm volatile("":"+v"(kb));
  #pragma unroll
  for(int r=0;r<16;++r){const unsigned kv=(unsigned)(kb+(r&3)+8*(r>>2)); c0[r]=(kv>256u)?NEG:negm[r]; c1[r]=(kv+32u>256u)?NEG:negm[r];}
}
__device__ __forceinline__ int crow(int r,int hi){return (r&3)+8*(r>>2)+4*hi;}
#define SBAR() __builtin_amdgcn_sched_barrier(0)
constexpr int NSLOT=3, SLOTB=8192;
constexpr int LDS_K=0, LDS_V=NSLOT*SLOTB, LDS_WS=2*NSLOT*SLOTB, LDS_OST=LDS_WS+NW*64*4, LDS_BYTES=LDS_OST+NW*4096;
__device__ __forceinline__ void glds16(const void*gsrc,unsigned lds_dst){unsigned keep;
  asm volatile("s_mov_b32 %0, m0\n\ts_mov_b32 m0, %2\n\ts_nop 0\n\tglobal_load_lds_dwordx4 %1, off\n\ts_mov_b32 m0, %0":"=&s"(keep):"v"(gsrc),"s"(lds_dst):"memory");}
__device__ __forceinline__ float max3f(float a,float b,float c){float r;asm("v_max3_f32 %0, %1, %2, %3":"=v"(r):"v"(a),"v"(b),"v"(c));return r;}
__device__ __forceinline__ float max2f(float a,float b){float r;asm("v_max_f32_e32 %0, %1, %2":"=v"(r):"v"(a),"v"(b));return r;}
__device__ __forceinline__ float fadd_s(float a,float b){float r;asm("v_add_f32_e32 %0, %1, %2":"=v"(r):"v"(a),"v"(b));return r;}
__device__ __forceinline__ float fsub_s(float a,float b){float r;asm("v_sub_f32_e32 %0, %1, %2":"=v"(r):"v"(a),"v"(b));return r;}
typedef float f32x2_t __attribute__((ext_vector_type(2))); typedef __bf16 bf16x2_t __attribute__((ext_vector_type(2)));
__device__ __forceinline__ unsigned cvtpk_s(float lo,float hi){f32x2_t v={lo,hi};bf16x2_t b=__builtin_convertvector(v,bf16x2_t);return __builtin_bit_cast(unsigned,b);}
#define WAIT_BAR(N) asm volatile("s_waitcnt vmcnt(" #N ") lgkmcnt(0)\n\ts_barrier":::"memory")

__device__ __forceinline__ void qkt(f32x16&p0,f32x16&p1,const char*Kslot,const bf16x8*qr,const f32x16&c0,const f32x16&c1,int r32,int hi){
  const char*kb=Kslot+hi*1024+r32*16;
  #pragma unroll
  for(int d0=0;d0<4;++d0){
    const bf16x8 b0=*reinterpret_cast<const bf16x8*>(kb+d0*2048);
    const bf16x8 b1=*reinterpret_cast<const bf16x8*>(kb+d0*2048+512);
    if(d0==0){p0=__builtin_amdgcn_mfma_f32_32x32x16_bf16(b0,qr[0],c0,0,0,0);p1=__builtin_amdgcn_mfma_f32_32x32x16_bf16(b1,qr[0],c1,0,0,0);}
    else{p0=__builtin_amdgcn_mfma_f32_32x32x16_bf16(b0,qr[d0],p0,0,0,0);p1=__builtin_amdgcn_mfma_f32_32x32x16_bf16(b1,qr[d0],p1,0,0,0);}}
}
typedef __attribute__((address_space(3))) const char* lds_cptr;
typedef short v4i16_t __attribute__((ext_vector_type(4)));
__device__ __forceinline__ void kload8(bf16x8*kf,lds_cptr kp){
  kf[0]=*(const __attribute__((address_space(3))) bf16x8*)(kp);      kf[1]=*(const __attribute__((address_space(3))) bf16x8*)(kp+512);
  kf[2]=*(const __attribute__((address_space(3))) bf16x8*)(kp+2048); kf[3]=*(const __attribute__((address_space(3))) bf16x8*)(kp+2560);
  kf[4]=*(const __attribute__((address_space(3))) bf16x8*)(kp+4096); kf[5]=*(const __attribute__((address_space(3))) bf16x8*)(kp+4608);
  kf[6]=*(const __attribute__((address_space(3))) bf16x8*)(kp+6144); kf[7]=*(const __attribute__((address_space(3))) bf16x8*)(kp+6656);
}
__device__ __forceinline__ void kload2(bf16x8*kf,lds_cptr kp,int j){ kf[2*j]=*(const __attribute__((address_space(3))) bf16x8*)(kp+j*2048); kf[2*j+1]=*(const __attribute__((address_space(3))) bf16x8*)(kp+j*2048+512); }
__device__ __forceinline__ s16x4 vtr(lds_cptr p){ return __builtin_bit_cast(s16x4,__builtin_amdgcn_ds_read_tr16_b64_v4i16((__attribute__((address_space(3))) v4i16_t*)p)); }
__device__ __forceinline__ float rowmax(const f32x16&p0,const f32x16&p1){
  float a=max3f(p0[0],p0[1],p1[0]),b=max3f(p0[2],p0[3],p1[1]);a=max3f(a,p1[2],p1[3]);
  #pragma unroll
  for(int r=4;r<16;r+=4){a=max3f(a,p0[r],p0[r+1]);b=max3f(b,p0[r+2],p0[r+3]);a=max3f(a,p1[r],p1[r+1]);b=max3f(b,p1[r+2],p1[r+3]);}
  const float m=max2f(a,b);
  auto rr=__builtin_amdgcn_permlane32_swap(__float_as_uint(m),__float_as_uint(m),false,false);
  return max2f(__uint_as_float(rr[0]),__uint_as_float(rr[1]));
}
__device__ __forceinline__ void pv(f32x16*o,int vb,bf16x8 pa0,bf16x8 pa1,bf16x8 pa2,bf16x8 pa3){
  #pragma unroll
  for(int d0=0;d0<2;++d0){s16x4 lo[4],hi[4];
    #pragma unroll
    for(int ks=0;ks<4;++ks){
      asm volatile("ds_read_b64_tr_b16 %0,%1 offset:%c2":"=&v"(lo[ks]):"v"(vb),"i"(d0*4096+ks*1024):"memory");
      asm volatile("ds_read_b64_tr_b16 %0,%1 offset:%c2":"=&v"(hi[ks]):"v"(vb),"i"(d0*4096+ks*1024+512):"memory");}
    asm volatile("s_waitcnt lgkmcnt(0)":::"memory");SBAR();
    #define PK(k) (bf16x8){lo[k][0],lo[k][1],lo[k][2],lo[k][3],hi[k][0],hi[k][1],hi[k][2],hi[k][3]}
    o[d0]=__builtin_amdgcn_mfma_f32_32x32x16_bf16(pa0,PK(0),o[d0],0,0,0);
    o[d0]=__builtin_amdgcn_mfma_f32_32x32x16_bf16(pa1,PK(1),o[d0],0,0,0);
    o[d0]=__builtin_amdgcn_mfma_f32_32x32x16_bf16(pa2,PK(2),o[d0],0,0,0);
    o[d0]=__builtin_amdgcn_mfma_f32_32x32x16_bf16(pa3,PK(3),o[d0],0,0,0);
    #undef PK
  }
}

#ifndef ATTN_STORE16
#define ATTN_STORE16(p,v) (*(u32x4*)(p)=(v))
#endif
template<int THRL,int MODE> __device__ __forceinline__ void attn_unit(const AttnDesc&A,char*shm){
  const int tid=threadIdx.x,lane=tid&63,r32=lane&31,hi=lane>>5; const int wid=__builtin_amdgcn_readfirstlane(tid>>6);
  const int dmq=A.dmq,dmk=A.dmk,dmo=A.dmo;
  const bf16*Qw=A.Q+(A.qrow0+wid*QBLK)*dmq;
  const bf16*Kh=A.K+A.krow0*dmk,*Vh=A.V+A.krow0*dmk;
  const unsigned lds0=(unsigned)(uintptr_t)shm;
  float*wsf=(float*)(shm+LDS_WS)+wid*64;
  const bf16*ksrc=Kh+(long)lane*dmk+wid*8;
  const bf16*vsrc=Vh+(long)(16*(wid&3)+(lane>>2))*dmk+(wid>>2)*32+(lane&3)*8;
  const unsigned kdst=lds0+LDS_K+wid*1024, vdst=lds0+LDS_V+wid*1024;
  #define DMA_K(t,slot) glds16(ksrc+(long)(t)*KVBLK*dmk,(unsigned)__builtin_amdgcn_readfirstlane(kdst+(slot)))
  #define DMA_V(t,slot) glds16(vsrc+(long)(t)*KVBLK*dmk,(unsigned)__builtin_amdgcn_readfirstlane(vdst+(slot)))
  const int vb0=(int)(lds0+LDS_V)+((lane>>4)&1)*32+(lane&3)*8+(4*hi+((lane&15)>>2))*64;
  const char*Kbase=shm+LDS_K; bf16x8 kf[8];
  const lds_cptr shm3=(lds_cptr)shm; const lds_cptr kp0=shm3+LDS_K+hi*1024+r32*16; const lds_cptr vp0=shm3+LDS_V+((lane>>4)&1)*32+(lane&3)*8+(4*hi+((lane&15)>>2))*64;
  const int NT=A.NT;
  DMA_K(0,0);DMA_V(0,0);DMA_K(1,SLOTB);
  bf16x8 qr[4];
  #pragma unroll
  for(int d0=0;d0<4;++d0)qr[d0]=*reinterpret_cast<const bf16x8*>(&Qw[(long)r32*dmq+d0*16+hi*8]);
  float mhat=0.f,l_reg=0.f;f32x16 o[2];o[0]=f32x16{};o[1]=f32x16{};f32x16 negm=f32x16{};asm volatile("":"+v"(negm));
  const int qrel=wid*QBLK+r32; const int dposq=A.dpos0-qrel;
  if(MODE==2){ mhat=A.fixref; _Pragma("unroll") for(int r=0;r<16;++r)negm[r]=-mhat; asm volatile("":"+v"(negm)); }
  bool resc=false;
  #define START(P0,P1) do{ resc=false; if(MODE!=2) \
    { const float rm=rowmax(P0,P1); const float dl=(MODE==1)?__builtin_fmaxf(rm,-20.f):rm; mhat=fadd_s(mhat,dl); \
      _Pragma("unroll") for(int r=0;r<16;++r){P0[r]=fsub_s(P0[r],dl);P1[r]=fsub_s(P1[r],dl);} \
      _Pragma("unroll") for(int r=0;r<16;++r)negm[r]=-mhat; asm volatile("":"+v"(negm)); } \
    _Pragma("unroll") for(int r=0;r<16;++r)P0[r]=__builtin_amdgcn_exp2f(P0[r]); }while(0)
  #define RESC() do{ if(resc){ asm volatile("s_waitcnt lgkmcnt(0)":::"memory"); \
      _Pragma("unroll") for(int d_=0;d_<2;++d_) _Pragma("unroll") for(int r=0;r<16;++r)o[d_][r]*=wsf[crow(r,hi)]; } }while(0)
  f32x16 pA0,pA1,pB0,pB1;
  int sl_prev=0,sl_cur=0,sl_next=SLOTB;
  #define ROT() do{sl_prev=sl_cur;sl_cur=sl_next;sl_next=(sl_next==(NSLOT-1)*SLOTB)?0:sl_next+SLOTB;}while(0)
  DMA_K(2,2*SLOTB);
  WAIT_BAR(3);
  if(MODE==1){wmask_c(pA0,pA1,negm,dposq,hi);qkt(pA0,pA1,Kbase,qr,pA0,pA1,r32,hi);}else{qkt(pA0,pA1,Kbase,qr,negm,negm,r32,hi);}asm volatile("s_nop 15\n\ts_nop 7":"+v"(pA0),"+v"(pA1));
  START(pA0,pA1);
  _Pragma("unroll") for(int r=0;r<16;++r)pA1[r]=__builtin_amdgcn_exp2f(pA1[r]);
  WAIT_BAR(0);
  DMA_K(3,0);DMA_V(1,SLOTB);
  ROT();
  kload8(kf,kp0+sl_cur);
  WAIT_BAR(2);
  s16x4 vlo[8],vhi[8]; u32x4 pw0,pw1,pw2,pw3;
  #define PKW(P,B) cvtpk_s(P[B],P[B+1])
  #define PAF(k) __builtin_bit_cast(bf16x8,pw##k)
  #define VFR(i) (bf16x8){vlo[i][0],vlo[i][1],vlo[i][2],vlo[i][3],vhi[i][0],vhi[i][1],vhi[i][2],vhi[i][3]}
  #define PIN(x) asm volatile("":"+v"(x))
  #define MX3(a,b,c) __builtin_fmaxf(__builtin_fmaxf((a),(b)),(c))
  #define GAPA(MF,A0,A1,A2,A3,W0,W1,PW) do{ MF; sacc+=A0; sacc+=A1; sacc+=A2; sacc+=A3; PIN(sacc); W0; W1; PIN(PW); SBAR(); }while(0)
  #define EX(v) __builtin_amdgcn_exp2f(v)
  #define GAPB(MF,X,B) do{ MF; X[B]=EX(X[B]); X[B+1]=EX(X[B+1]); X[B+2]=EX(X[B+2]); X[B+3]=EX(X[B+3]); PIN(X); SBAR(); }while(0)
  #define VRD(i) do{ vlo[i]=vtr(vp_+(((i)>>2)*4096+((i)&3)*1024)); vhi[i]=vtr(vp_+(((i)>>2)*4096+((i)&3)*1024+512)); }while(0)
  #define KRD(G,j) do{ if(G){ kload2(kf,kp0+sl_next,j); SBAR(); } }while(0)
  #define STEP(C0,C1,P0,P1,t,GK,GV,GL) do{ SBAR(); if(MODE==1){ wmask_c(C0,C1,negm,dposq+64*(t),hi); SBAR(); } \
    const lds_cptr vp_=vp0+sl_prev; \
    VRD(0); SBAR(); float sacc=(P0[0]+P0[1]); \
    GAPA(C0=__builtin_amdgcn_mfma_f32_32x32x16_bf16(kf[0],qr[0],(MODE==1?C0:negm),0,0,0), P0[2],P0[3],P0[4],P0[5],     pw0[0]=PKW(P0,0), pw0[1]=PKW(P0,2), pw0); \
    VRD(4); SBAR(); GAPA(C1=__builtin_amdgcn_mfma_f32_32x32x16_bf16(kf[1],qr[0],(MODE==1?C1:negm),0,0,0), P0[6],P0[7],P0[8],P0[9],     pw0[2]=PKW(P0,4), pw0[3]=PKW(P0,6), pw0); \
    VRD(1); SBAR(); GAPA(C0=__builtin_amdgcn_mfma_f32_32x32x16_bf16(kf[2],qr[1],C0,0,0,0),   P0[10],P0[11],P0[12],P0[13], pw1[0]=PKW(P0,8), pw1[1]=PKW(P0,10), pw1); \
    VRD(5); SBAR(); GAPA(C1=__builtin_amdgcn_mfma_f32_32x32x16_bf16(kf[3],qr[1],C1,0,0,0),   P0[14],P0[15],P1[0],P1[1],   pw1[2]=PKW(P0,12),pw1[3]=PKW(P0,14), pw1); \
    VRD(2); SBAR(); GAPA(C0=__builtin_amdgcn_mfma_f32_32x32x16_bf16(kf[4],qr[2],C0,0,0,0),   P1[2],P1[3],P1[4],P1[5],     pw2[0]=PKW(P1,0), pw2[1]=PKW(P1,2), pw2); \
    VRD(6); SBAR(); GAPA(C1=__builtin_amdgcn_mfma_f32_32x32x16_bf16(kf[5],qr[2],C1,0,0,0),   P1[6],P1[7],P1[8],P1[9],     pw2[2]=PKW(P1,4), pw2[3]=PKW(P1,6), pw2); \
    VRD(3); SBAR(); GAPA(C0=__builtin_amdgcn_mfma_f32_32x32x16_bf16(kf[6],qr[3],C0,0,0,0),   P1[10],P1[11],P1[12],P1[13], pw3[0]=PKW(P1,8), pw3[1]=PKW(P1,10), pw3); \
    VRD(7); SBAR(); GAPA(C1=__builtin_amdgcn_mfma_f32_32x32x16_bf16(kf[7],qr[3],C1,0,0,0),   P1[14],P1[15],0.f,0.f,       pw3[2]=PKW(P1,12),pw3[3]=PKW(P1,14), pw3); \
    l_reg+=sacc; \
    if(GK){DMA_K((t)+3,sl_cur);} if(GV){DMA_V((t)+1,sl_next);} \
    if(MODE!=2){ float a=MX3(C0[0],C0[1],C1[0]),b=MX3(C0[2],C0[3],C1[1]); a=MX3(a,C1[2],C1[3]); \
      _Pragma("unroll") for(int r=4;r<16;r+=4){a=MX3(a,C0[r],C0[r+1]);b=MX3(b,C0[r+2],C0[r+3]);a=MX3(a,C1[r],C1[r+1]);b=MX3(b,C1[r+2],C1[r+3]);} \
      float rm=__builtin_fmaxf(a,b); { auto rr=__builtin_amdgcn_permlane32_swap(__float_as_uint(rm),__float_as_uint(rm),false,false); rm=__builtin_fmaxf(__uint_as_float(rr[0]),__uint_as_float(rr[1])); } \
      resc=false; \
      if(__builtin_expect(__any(rm>(float)THRL),0)){ const float dl=__builtin_fmaxf(rm,0.f); mhat+=dl; \
        _Pragma("unroll") for(int r=0;r<16;++r){C0[r]-=dl;C1[r]-=dl;} \
        _Pragma("unroll") for(int r=0;r<16;++r)negm[r]=-mhat; asm volatile("":"+v"(negm)); \
        const float f=__builtin_amdgcn_exp2f(-dl); l_reg*=f; if(hi==0)wsf[r32]=f; resc=true; } } \
    SBAR(); \
    GAPB(o[0]=__builtin_amdgcn_mfma_f32_32x32x16_bf16(PAF(0),VFR(0),o[0],0,0,0), C0,0); \
    GAPB(o[1]=__builtin_amdgcn_mfma_f32_32x32x16_bf16(PAF(0),VFR(4),o[1],0,0,0), C0,4); \
    KRD(GL,0); GAPB(o[0]=__builtin_amdgcn_mfma_f32_32x32x16_bf16(PAF(1),VFR(1),o[0],0,0,0), C0,8); \
    KRD(GL,1); GAPB(o[1]=__builtin_amdgcn_mfma_f32_32x32x16_bf16(PAF(1),VFR(5),o[1],0,0,0), C0,12); \
    KRD(GL,2); GAPB(o[0]=__builtin_amdgcn_mfma_f32_32x32x16_bf16(PAF(2),VFR(2),o[0],0,0,0), C1,0); \
    KRD(GL,3); GAPB(o[1]=__builtin_amdgcn_mfma_f32_32x32x16_bf16(PAF(2),VFR(6),o[1],0,0,0), C1,4); \
    GAPB(o[0]=__builtin_amdgcn_mfma_f32_32x32x16_bf16(PAF(3),VFR(3),o[0],0,0,0), C1,8); \
    GAPB(o[1]=__builtin_amdgcn_mfma_f32_32x32x16_bf16(PAF(3),VFR(7),o[1],0,0,0), C1,12); \
    }while(0)
  int t=1;
  if constexpr(MODE!=1) for(;t+5<NT;t+=2){
    STEP(pB0,pB1,pA0,pA1,t,true,true,true);     WAIT_BAR(2); RESC(); ROT();
    STEP(pA0,pA1,pB0,pB1,t+1,true,true,true);   WAIT_BAR(2); RESC(); ROT();
  }
  #define ENDW(tt) do{ if((tt)+3<NT){WAIT_BAR(2);} else if((tt)+2<NT){WAIT_BAR(1);} else {WAIT_BAR(0);} }while(0)
  for(;t+1<NT;t+=2){
    STEP(pB0,pB1,pA0,pA1,t,(t+3<NT),(t+1<NT),(t+1<NT));       ENDW(t);   RESC(); ROT();
    STEP(pA0,pA1,pB0,pB1,t+1,(t+4<NT),(t+2<NT),(t+2<NT));     ENDW(t+1); RESC(); ROT();
  }
  STEP(pB0,pB1,pA0,pA1,NT-1,false,false,false); RESC();
  { float sacc=pB0[0]+pB0[1]; _Pragma("unroll") for(int r=2;r<16;++r)sacc+=pB0[r]; _Pragma("unroll") for(int r=0;r<16;++r)sacc+=pB1[r]; l_reg+=sacc;
    pw0=(u32x4){PKW(pB0,0),PKW(pB0,2),PKW(pB0,4),PKW(pB0,6)};pw1=(u32x4){PKW(pB0,8),PKW(pB0,10),PKW(pB0,12),PKW(pB0,14)};pw2=(u32x4){PKW(pB1,0),PKW(pB1,2),PKW(pB1,4),PKW(pB1,6)};pw3=(u32x4){PKW(pB1,8),PKW(pB1,10),PKW(pB1,12),PKW(pB1,14)};
    SBAR(); pv(o,vb0+sl_cur,PAF(0),PAF(1),PAF(2),PAF(3)); }
  #undef PKW
  #undef PAF
  #undef VFR
  #undef PIN
  #undef MX3
  #undef GAPA
  #undef GAPB
  #undef EX
  #undef VRD
  #undef KRD
  #undef STEP
  #undef ENDW
  {auto rr=__builtin_amdgcn_permlane32_swap(__float_as_uint(l_reg),__float_as_uint(l_reg),false,false);l_reg=__uint_as_float(rr[0])+__uint_as_float(rr[1]);}
  if(MODE==1)l_reg+=__builtin_amdgcn_exp2f(A.sinkl2-mhat);
  if(hi==0)wsf[32+r32]=l_reg;asm volatile("s_waitcnt lgkmcnt(0)":::"memory");
  float rli[16];
  #pragma unroll
  for(int r=0;r<16;++r)rli[r]=__builtin_amdgcn_rcpf(wsf[32+crow(r,hi)]);
  bf16*Ow=A.O+(A.qrow0+wid*QBLK)*dmo;
  { bf16*stg=(bf16*)(shm+LDS_OST)+wid*2048;
    #pragma unroll
    for(int r=0;r<16;++r){const int orow=crow(r,hi);
      #pragma unroll
      for(int d0=0;d0<2;++d0)stg[orow*64+d0*32+r32]=__float2bfloat16(o[d0][r]*rli[r]);}
    asm volatile("s_waitcnt lgkmcnt(0)":::"memory");
    #pragma unroll
    for(int i=0;i<4;++i){const int row=i*8+(lane>>3),ch=lane&7; const u32x4 v=*(const u32x4*)(stg+row*64+ch*8); ATTN_STORE16(Ow+(long)row*dmo+ch*8,v);} }
  asm volatile("s_waitcnt lgkmcnt(0)\n\ts_barrier":::"memory");
  #undef DMA_K
  #undef DMA_V
  #undef START
  #undef RESC
  #undef ROT
}
constexpr int ATTN_LDS_BYTES=LDS_BYTES;
#undef SBAR
#undef WAIT_BAR
}
constexpr int NWAVES = 8;
constexpr size_t MiB = 1u << 20;
#ifndef MK_DEBUG
#define MK_DEBUG 0
#endif
constexpr size_t WS_CTL = 0, CTL_ZERO_BYTES = 32768;
constexpr size_t CTL_BAR_OFF = 4096;
constexpr size_t CTL_CNT_OFF = 24576;
#define GCNT_IDX(e) (32 * (e))
constexpr size_t WS_W_IN = 1 * MiB;
constexpr size_t WS_W_KVM = 10 * MiB;
constexpr size_t WS_W_BR = 11 * MiB;
constexpr size_t WS_W_OUT = 13 * MiB;
constexpr size_t WS_W_GU = 16 * MiB;
constexpr size_t WS_SCL = 15 * MiB;
constexpr size_t WS_SB_IN = WS_SCL, WS_SB_KVM = WS_SCL + 32768, WS_SAM = WS_SCL + 40960, WS_SAH = WS_SCL + 65536, WS_SB_GU = WS_SCL + 262144, WS_SB_DN = WS_SCL + 524288, WS_SB_OUT = WS_SCL + 655360;
constexpr size_t WS_SAL = 80 * MiB;
constexpr size_t WS_W_DN = 144 * MiB;
constexpr size_t WS_H = 208 * MiB;
constexpr size_t WS_MEMN = 240 * MiB;
constexpr size_t WS_KVM = 241 * MiB;
constexpr size_t WS_LIST = 242 * MiB;
constexpr size_t WS_SLOT = 244 * MiB;
constexpr size_t WS_TOPW = 245 * MiB;
constexpr size_t WS_Y = 246 * MiB;
constexpr size_t WS_MERGED = 278 * MiB;
constexpr size_t WS_X1 = 310 * MiB;
constexpr size_t WS_QKV = 374 * MiB;
constexpr size_t WS_G = 422 * MiB;
#if MK_DEBUG
constexpr size_t WS_ACT = 518 * MiB;
constexpr size_t WS_YS = 662 * MiB;
constexpr size_t WS_H2 = 806 * MiB;
constexpr size_t WS_DBG = 838 * MiB;
constexpr size_t WS_END = 839 * MiB;
#else
constexpr size_t WS_ACT = WS_QKV;
constexpr size_t WS_YS = 518 * MiB;
constexpr size_t WS_H2 = WS_H;
constexpr size_t WS_END = 662 * MiB;
#endif
constexpr size_t WS_YSS = WS_YS + 80 * MiB;
static_assert((size_t)ACT_ROWS * 1024 * 2 == 144 * MiB && (size_t)T * NQKV * 2 == 48 * MiB && (size_t)T * NG * 2 == 96 * MiB, "map");

constexpr int RING_BYTES = 131072;
constexpr int LX_OFF = RING_BYTES;
constexpr int LX2_OFF = 147456;
constexpr int LDS_BYTES = 157696;

struct Params {
    const float *x, *mem, *norm_mix, *w_in, *qn, *kn, *sink, *norm_mem, *w_kvm, *w_bra, *w_brb, *w_brm, *w_out, *norm_ffn, *w_router, *b_router, *w_gu, *b_gu, *w_dn, *b_dn, *norm_final;
    float* out; unsigned char* ws; int ph_lo, ph_hi;
};

#define LDS_WAIT() asm volatile("s_waitcnt lgkmcnt(0)" ::: "memory")
__device__ __forceinline__ float wave_sum(float v) {
#pragma unroll
    for (int o = 1; o < 64; o <<= 1) v += __shfl_xor(v, o);
    return v;
}
template <int CTRL, int RM = 0xf, int BM = 0xf> __device__ __forceinline__ float dppf(float old, float src) {
    return __int_as_float(__builtin_amdgcn_update_dpp(__float_as_int(old), __float_as_int(src), CTRL, RM, BM, false)); }
__device__ __forceinline__ float xl1(float v) { return dppf<0xB1>(0.f, v); }
__device__ __forceinline__ float xl2(float v) { return dppf<0x4E>(0.f, v); }
__device__ __forceinline__ float xl4(float v) { return dppf<0x1B>(0.f, dppf<0x141>(0.f, v)); }
__device__ __forceinline__ float xl8(float v) { return dppf<0x128>(0.f, v); }
__device__ __forceinline__ float xl16(float v, int lane) { const auto r = __builtin_amdgcn_permlane16_swap(__float_as_uint(v), __float_as_uint(v), false, false); return __uint_as_float((lane & 16) ? r[0] : r[1]); }
__device__ __forceinline__ float sum_halves(float v) { const auto r = __builtin_amdgcn_permlane32_swap(__float_as_uint(v), __float_as_uint(v), false, false); return __uint_as_float(r[0]) + __uint_as_float(r[1]); }
__device__ __forceinline__ float wave_sum_s(float v) {
    v += xl1(v); v += xl2(v); v += dppf<0x124>(0.f, v); v += xl8(v);
    v += dppf<0x142, 0xa>(0.f, v); v += dppf<0x143, 0xc>(0.f, v);
    return __int_as_float(__builtin_amdgcn_readlane(__float_as_int(v), 63)); }
__device__ __forceinline__ float wave_max_s(float v) {
    v = fmaxf(v, dppf<0xB1>(v, v)); v = fmaxf(v, dppf<0x4E>(v, v)); v = fmaxf(v, dppf<0x124>(v, v)); v = fmaxf(v, dppf<0x128>(v, v));
    v = fmaxf(v, dppf<0x142, 0xa>(v, v)); v = fmaxf(v, dppf<0x143, 0xc>(v, v));
    return __int_as_float(__builtin_amdgcn_readlane(__float_as_int(v), 63)); }
__device__ __forceinline__ void tile_of(int L, int nM, int nN, int& pm, int& pn) {
    const int nwg = nM * nN; int wgid = L;
    { const int q = nwg / 8, r = nwg % 8, xcd = wgid % 8, off = wgid / 8; wgid = (xcd < r ? xcd * (q + 1) : r * (q + 1) + (xcd - r) * q) + off; }
    const int nig = 8 * nN, gid = wgid / nig, fm = gid * 8, gsz = (nM - fm) < 8 ? (nM - fm) : 8;
    pm = fm + ((wgid % nig) % gsz); pn = (wgid % nig) / gsz;
}
struct VA4 { unsigned v0, v1, v2, v3; };
__device__ __forceinline__ VA4 std_va(unsigned lda_bytes) {
    int R0, C0, R1, C1; pg8::lane_piece(0, R0, C0); pg8::lane_piece(1, R1, C1); VA4 r;
    r.v0 = (unsigned)R0 * lda_bytes + (unsigned)C0 * 2u; r.v1 = (unsigned)R1 * lda_bytes + (unsigned)C1 * 2u;
    r.v2 = (unsigned)(R0 + 128) * lda_bytes + (unsigned)C0 * 2u; r.v3 = (unsigned)(R1 + 128) * lda_bytes + (unsigned)C1 * 2u; return r;
}

__device__ __forceinline__ void transpose_item(const float* __restrict__ W, int ldw, int k0, int lbase, bool perm, bf16_t* __restrict__ WT, int ldt, int prow0, int kdst, LAS float* scr, int lane) {
    float v[32];
#pragma unroll
    for (int i = 0; i < 32; ++i) { const int kk = 2 * i + (lane >> 5); v[i] = W[(size_t)(k0 + kk) * ldw + lbase + (lane & 31)]; }
#pragma unroll
    for (int i = 0; i < 32; ++i) { const int kk = 2 * i + (lane >> 5); scr[kk * 33 + (lane & 31)] = v[i]; }
    LDS_WAIT(); asm volatile("" ::: "memory");
    const int c = lane & 7;
#pragma unroll
    for (int j = 0; j < 4; ++j) { const int n = (lane >> 3) + 8 * j; const int ln = perm ? p8perm(n) : n; const LAS float* s = scr + (8 * c) * 33 + ln;
        u32x4 o; o.x = cvt_pk_bf16(s[0 * 33], s[1 * 33]); o.y = cvt_pk_bf16(s[2 * 33], s[3 * 33]); o.z = cvt_pk_bf16(s[4 * 33], s[5 * 33]); o.w = cvt_pk_bf16(s[6 * 33], s[7 * 33]);
        *(u32x4*)(WT + (size_t)(prow0 + n) * ldt + kdst + 8 * c) = o; }
    LDS_WAIT(); asm volatile("" ::: "memory");
}
__device__ __forceinline__ void rms_row_to_bf16(const float* __restrict__ xrow, const float* __restrict__ g, bf16_t* __restrict__ orow, int lane) {
    const f32x4* xr = (const f32x4*)xrow + lane;
    f32x4 v[4]; float s = 0.f;
#pragma unroll
    for (int j = 0; j < 4; ++j) { v[j] = xr[64 * j]; s += (v[j].x * v[j].x + v[j].y * v[j].y) + (v[j].z * v[j].z + v[j].w * v[j].w); }
    const float r = rsqrtf(wave_sum(s) * (1.f / D) + EPS);
    u32x2* o8 = (u32x2*)orow + lane;
#pragma unroll
    for (int j = 0; j < 4; ++j) { const f32x4 gg = ((const f32x4*)g)[lane + 64 * j]; u32x2 w; w.x = cvt_pk_bf16(v[j].x * r * gg.x, v[j].y * r * gg.y); w.y = cvt_pk_bf16(v[j].z * r * gg.z, v[j].w * r * gg.w); o8[64 * j] = w; }
}
__device__ __forceinline__ float wave_max(float v) {
#pragma unroll
    for (int o = 1; o < 64; o <<= 1) v = fmaxf(v, __shfl_xor(v, o));
    return v;
}
__device__ __forceinline__ unsigned pack_i8x4(float a, float b, float c, float d) {
    const int qa = (int)rintf(a), qb = (int)rintf(b), qc = (int)rintf(c), qd = (int)rintf(d);
    return (unsigned)(qa & 0xff) | ((unsigned)(qb & 0xff) << 8) | ((unsigned)(qc & 0xff) << 16) | ((unsigned)qd << 24);
}
__device__ __forceinline__ void rms_row_to_i8(const float* __restrict__ xrow, const float* __restrict__ g, signed char* __restrict__ orow, float* __restrict__ scale_out, int lane) {
    const f32x4* xr = (const f32x4*)xrow + lane;
    f32x4 v[4]; float s = 0.f;
#pragma unroll
    for (int j = 0; j < 4; ++j) { v[j] = xr[64 * j]; s += (v[j].x * v[j].x + v[j].y * v[j].y) + (v[j].z * v[j].z + v[j].w * v[j].w); }
    const float r = rsqrtf(wave_sum(s) * (1.f / D) + EPS);
    float mx = 0.f;
#pragma unroll
    for (int j = 0; j < 4; ++j) { const f32x4 gg = ((const f32x4*)g)[lane + 64 * j]; v[j] = v[j] * r * gg; mx = fmaxf(fmaxf(mx, fmaxf(fabsf(v[j].x), fabsf(v[j].y))), fmaxf(fabsf(v[j].z), fabsf(v[j].w))); }
    mx = wave_max(mx);
    const float inv = mx > 0.f ? 127.f / mx : 0.f;
    unsigned* o4 = (unsigned*)orow + lane;
#pragma unroll
    for (int j = 0; j < 4; ++j) o4[64 * j] = pack_i8x4(v[j].x * inv, v[j].y * inv, v[j].z * inv, v[j].w * inv);
    if (lane == 0) *scale_out = mx * (1.f / 127.f);
}
template <int NB> __device__ __forceinline__ void rms_rows_to_i8(const float* __restrict__ X, const float* __restrict__ g, signed char* __restrict__ O, float* __restrict__ S, int m0, int stride, int M, int lane) {
    f32x4 v[NB][4], gv[4];
#pragma unroll
    for (int j = 0; j < 4; ++j) gv[j] = ((const f32x4*)g)[lane + 64 * j];
#pragma unroll
    for (int q = 0; q < NB; ++q) { const int m = min(m0 + q * stride, M - 1); const f32x4* xr = (const f32x4*)(X + (size_t)m * D) + lane;
#pragma unroll
        for (int j = 0; j < 4; ++j) v[q][j] = xr[64 * j]; }
#pragma unroll
    for (int q = 0; q < NB; ++q) { const int m = m0 + q * stride;
        if (m < M) {
            float s = 0.f;
#pragma unroll
            for (int j = 0; j < 4; ++j) s += (v[q][j].x * v[q][j].x + v[q][j].y * v[q][j].y) + (v[q][j].z * v[q][j].z + v[q][j].w * v[q][j].w);
            const float r = rsqrtf(wave_sum_s(s) * (1.f / D) + EPS);
            float mx = 0.f;
#pragma unroll
            for (int j = 0; j < 4; ++j) { const f32x4 gg = gv[j]; v[q][j] = v[q][j] * r * gg; mx = fmaxf(fmaxf(mx, fmaxf(fabsf(v[q][j].x), fabsf(v[q][j].y))), fmaxf(fabsf(v[q][j].z), fabsf(v[q][j].w))); }
            mx = wave_max_s(mx);
            const float inv = mx > 0.f ? 127.f / mx : 0.f;
            unsigned* o4 = (unsigned*)(O + (size_t)m * D) + lane;
#pragma unroll
            for (int j = 0; j < 4; ++j) o4[64 * j] = pack_i8x4(v[q][j].x * inv, v[q][j].y * inv, v[q][j].z * inv, v[q][j].w * inv);
            if (lane == 0) S[m] = mx * (1.f / 127.f);
        } }
}
struct QTask { const float* W; int ldw, lbase; bool perm; signed char* WQ; int prow0; float* SB; bool fp8; };
__device__ __forceinline__ void quant_load(const QTask& q, f32x4 (&v)[16], int wave, int lane) {
    const unsigned loff = (unsigned)((lane >> 3) * 16 * q.ldw + 4 * (lane & 7));
#pragma unroll
    for (int i = 0; i < 16; ++i) { const float* rowp = q.W + (size_t)(128 * wave + i) * q.ldw + q.lbase;
        v[i] = __builtin_nontemporal_load((const f32x4*)(rowp + loff)); }
}
__device__ __forceinline__ void quant_finish(const QTask& q, const f32x4 (&v)[16], LAS unsigned char* lds, int wave, int lane) {
    LAS unsigned* cmax = (LAS unsigned*)(lds + LX_OFF + 12288);
    if (threadIdx.x < 32) cmax[threadIdx.x] = 0u;
    __syncthreads();
    f32x4 m = {0.f, 0.f, 0.f, 0.f};
#pragma unroll
    for (int i = 0; i < 16; ++i) m = __builtin_elementwise_max(m, __builtin_elementwise_abs(v[i]));
#pragma unroll
    for (int j = 0; j < 4; ++j) { m[j] = fmaxf(m[j], xl8(m[j])); m[j] = fmaxf(m[j], xl16(m[j], lane)); }
    { const auto r0 = __builtin_amdgcn_permlane32_swap(__float_as_uint(m[0]), __float_as_uint(m[0]), false, false), r1 = __builtin_amdgcn_permlane32_swap(__float_as_uint(m[1]), __float_as_uint(m[1]), false, false),
                 r2 = __builtin_amdgcn_permlane32_swap(__float_as_uint(m[2]), __float_as_uint(m[2]), false, false), r3 = __builtin_amdgcn_permlane32_swap(__float_as_uint(m[3]), __float_as_uint(m[3]), false, false);
      m[0] = fmaxf(__uint_as_float(r0[0]), __uint_as_float(r0[1])); m[1] = fmaxf(__uint_as_float(r1[0]), __uint_as_float(r1[1])); m[2] = fmaxf(__uint_as_float(r2[0]), __uint_as_float(r2[1])); m[3] = fmaxf(__uint_as_float(r3[0]), __uint_as_float(r3[1])); }
    if (lane < 8) {
#pragma unroll
        for (int j = 0; j < 4; ++j) __hip_atomic_fetch_max(cmax + 4 * lane + j, __float_as_uint(m[j]), __ATOMIC_RELAXED, __HIP_MEMORY_SCOPE_WORKGROUP); }
    __syncthreads();
    const int c4 = lane & 7, r8 = lane >> 3;
    const float qmax = q.fp8 ? 384.f : 127.f; f32x4 inv;
#pragma unroll
    for (int j = 0; j < 4; ++j) { const float mj = __uint_as_float(cmax[4 * c4 + j]); inv[j] = mj > 0.f ? qmax / mj : 0.f; }
    const int prow = q.prow0 + (q.perm ? 16 * (c4 & 1) + 4 * (c4 >> 1) : 4 * c4);
    signed char* dst = q.WQ + (size_t)prow * 1024 + 128 * wave + 16 * r8;
#pragma unroll
    for (int j = 0; j < 4; ++j) {
        u32x4 o;
#pragma unroll
        for (int w = 0; w < 4; ++w) {
            const float s0 = v[4 * w][j] * inv[j], s1 = v[4 * w + 1][j] * inv[j], s2 = v[4 * w + 2][j] * inv[j], s3 = v[4 * w + 3][j] * inv[j];
            unsigned d;
            if (q.fp8) { int t_ = __builtin_amdgcn_cvt_pk_fp8_f32(s0, s1, 0, false); t_ = __builtin_amdgcn_cvt_pk_fp8_f32(s2, s3, t_, true); d = (unsigned)t_; }
            else d = pack_i8x4(s0, s1, s2, s3);
            o[w] = d; }
        *(u32x4*)(dst + (size_t)j * 1024) = o; }
    if (wave == 0 && lane < 32) { const int ln = q.perm ? p8perm(lane) : lane; q.SB[q.prow0 + lane] = __uint_as_float(cmax[ln]) * (q.fp8 ? 1.f / 384.f : 1.f / 127.f); }
    __syncthreads();
}
__device__ __forceinline__ QTask moe_task(const Params& P, int it) {
    QTask q;
    if (it < 2048) { const int e = it >> 6, g = it & 63, pn = g >> 3, bj = (g >> 2) & 1, wc = g & 3;
        q.W = P.w_gu + (size_t)e * 1024 * 2048; q.ldw = 2048; q.lbase = 1024 * bj + 128 * pn + 32 * wc; q.perm = true; q.WQ = (signed char*)(P.ws + WS_W_GU) + (size_t)e * 2048 * 1024; q.prow0 = 32 * g;
        q.SB = (float*)(P.ws + WS_SB_GU) + e * 2048; q.fp8 = false; }
    else { const int r = it - 2048, e = r >> 5, g = r & 31;
        q.W = P.w_dn + (size_t)e * 1024 * 1024; q.ldw = 1024; q.lbase = 32 * g; q.perm = true; q.WQ = (signed char*)(P.ws + WS_W_DN) + (size_t)e * 1024 * 1024; q.prow0 = 32 * g;
        q.SB = (float*)(P.ws + WS_SB_DN) + e * 1024; q.fp8 = true; }
    return q;
}
template <bool PIPE> __device__ __forceinline__ void convert_moe_items(const Params& P, LAS unsigned char* lds, int gs, int gn) {
    const int tid = threadIdx.x, lane = tid & 63, wave = __builtin_amdgcn_readfirstlane(tid >> 6);
    if constexpr (!PIPE) { for (int it = gs; it < gs + gn; ++it) { f32x4 v[16]; const QTask q = moe_task(P, it); quant_load(q, v, wave, lane); quant_finish(q, v, lds, wave, lane); } }
    else if (gn > 0) {
        f32x4 va[16], vb[16]; const int last = gs + gn - 1;
        QTask qa = moe_task(P, gs), qb; quant_load(qa, va, wave, lane);
        for (int it = gs; it <= last; it += 2) {
            qb = moe_task(P, min(it + 1, last)); quant_load(qb, vb, wave, lane);
            quant_finish(qa, va, lds, wave, lane);
            qa = moe_task(P, min(it + 2, last)); quant_load(qa, va, wave, lane);
            quant_finish(qb, vb, lds, wave, lane);
        }
    }
}
__device__ __forceinline__ void p0_prologue(const Params& P, LAS unsigned char* lds, int G) {
    const int tid = threadIdx.x, lane = tid & 63, wave = __builtin_amdgcn_readfirstlane(tid >> 6);
    LAS float* scr = (LAS float*)(lds + wave * 16384);
    const int gw = (int)blockIdx.x * NWAVES + wave, NGW = G * NWAVES;
    bf16_t* W_BR = (bf16_t*)(P.ws + WS_W_BR);
    for (int task = blockIdx.x; task < 144 + 16 + 32; task += G) {
        const bool ow = task >= 160, kv = !ow && task >= 144; const int g = ow ? task - 160 : kv ? task - 144 : task, pn = g >> 3, bj = (g >> 2) & 1, wc = g & 3;
        const bool heads = !kv && !ow && pn < 6;
        QTask q; q.W = ow ? P.w_out : kv ? P.w_kvm : P.w_in; q.ldw = ow ? 1024 : kv ? 512 : INW; q.lbase = heads ? 64 * (4 * pn + wc) + 32 * bj : ow ? 256 * pn + 64 * wc + 32 * bj : 32 * g; q.perm = !kv && !heads;
        q.WQ = (signed char*)(P.ws + (ow ? WS_W_OUT : kv ? WS_W_KVM : WS_W_IN)); q.prow0 = 32 * g;
        q.SB = (float*)(P.ws + (ow ? WS_SB_OUT : kv ? WS_SB_KVM : WS_SB_IN)); q.fp8 = ow;
        f32x4 v[16]; quant_load(q, v, wave, lane); quant_finish(q, v, lds, wave, lane);
    }
    constexpr int I_BRA = 6 * 32, I_BRM = 4 * 32;
    constexpr int NITEMS = 2 * I_BRA + I_BRM;
    for (int it = NGW - 1 - gw; it < NITEMS; it += NGW) {
        int r = it;
        if (r < I_BRA) { const int kb = r / 32, g = r % 32; transpose_item(P.w_bra, 1024, 64 * kb, 32 * g, true, W_BR, 1024, 32 * g, 0 + 64 * kb, scr, lane); continue; } r -= I_BRA;
        if (r < I_BRA) { const int kb = r / 32, g = r % 32; transpose_item(P.w_brb, 1024, 64 * kb, 32 * g, true, W_BR, 1024, 32 * g, 384 + 64 * kb, scr, lane); continue; } r -= I_BRA;
        { const int kb = r / 32, g = r % 32; transpose_item(P.w_brm, 1024, 64 * kb, 32 * g, true, W_BR, 1024, 32 * g, 768 + 64 * kb, scr, lane); }
    }
    if (G != 256) { const int ng = (3072 + G - 1) / G, g0 = min((int)blockIdx.x * ng, 3072); convert_moe_items<false>(P, lds, g0, min(ng, 3072 - g0)); }
    signed char* HQ = (signed char*)(P.ws + WS_H); signed char* MEMNQ = (signed char*)(P.ws + WS_MEMN); float* SAH = (float*)(P.ws + WS_SAH); float* SAM = (float*)(P.ws + WS_SAM);
    for (int m = gw; m < T; m += 8 * NGW) rms_rows_to_i8<8>(P.x, P.norm_mix, HQ, SAH, m, NGW, T, lane);
    for (int m = NGW - 1 - gw; m < BATCH * NMEM; m += NGW) rms_row_to_i8(P.mem + (size_t)m * D, P.norm_mem, MEMNQ + (size_t)m * D, SAM + m, lane);
}

struct SchedP1 {
    const char* H; const char* W; const char* MEMN; const char* WKVM; int G, c; VA4 va;
    __device__ __forceinline__ bool next(int i, pg8::Unit& u) const {
        const int L = i * G + c; constexpr int NMAIN = 64 * 18;
        if (L >= NMAIN + 4) return false;
        u.nt = 8;
        u.va0 = va.v0; u.va1 = va.v1; u.va2 = va.v2; u.va3 = va.v3;
        if (L < NMAIN) { tile_of(L, 64, 18, u.pm, u.pn); u.aux = 0; u.a = H + (size_t)u.pm * 256 * 1024; u.b = W + (size_t)u.pn * 256 * 1024; }
        else { const int l = L - NMAIN; u.pm = l >> 1; u.pn = l & 1; u.aux = 1; u.a = MEMN + (size_t)u.pm * 256 * 1024; u.b = WKVM + (size_t)u.pn * 256 * 1024; }
        return true;
    }
};
__device__ __forceinline__ void dequant_acc(f32x4 (&acc)[2][2][4][2], const float* sa_rows  , const float* sb_cols  ) {
    f32x4 sb[2][2];
#pragma unroll
    for (int bj = 0; bj < 2; ++bj)
#pragma unroll
        for (int n = 0; n < 2; ++n) sb[bj][n] = *(const f32x4*)(sb_cols + 128 * bj + 16 * n);
#pragma unroll
    for (int ai = 0; ai < 2; ++ai)
#pragma unroll
        for (int m = 0; m < 4; ++m) { const float sa = sa_rows[128 * ai + 16 * m];
#pragma unroll
            for (int bj = 0; bj < 2; ++bj)
#pragma unroll
                for (int n = 0; n < 2; ++n) { const i32x4 q = __builtin_bit_cast(i32x4, acc[ai][bj][m][n]); acc[ai][bj][m][n] = (f32x4){(float)q[0], (float)q[1], (float)q[2], (float)q[3]} * (sb[bj][n] * sa); } }
}
__device__ __forceinline__ unsigned gate_pk4(float a, float b, float c, float d) {
    return (unsigned)(int)rintf(a * 255.f) | ((unsigned)(int)rintf(b * 255.f) << 8) | ((unsigned)(int)rintf(c * 255.f) << 16) | ((unsigned)(int)rintf(d * 255.f) << 24); }
struct EpiP1 {
    bf16_t* QKV; unsigned char* G8; bf16_t* KVM; const float* qn; const float* kn; const float *SAH, *SAM, *SB_IN, *SB_KVM;
    __device__ __forceinline__ bool keep(const pg8::Unit&) const { return false; }
    __device__ __forceinline__ void operator()(f32x4 (&acc)[2][2][4][2], const pg8::Unit& u, int wr, int wc, int fr, int fq) const {
        asm volatile("" : "+v"(fr), "+v"(fq));
        const int row0 = u.pm * 256 + wr * 64 + fr;
        dequant_acc(acc, (u.aux == 1 ? SAM : SAH) + row0, (u.aux == 1 ? SB_KVM : SB_IN) + u.pn * 256 + 32 * wc + 4 * fq);
        if (u.aux == 1) {
#pragma unroll
            for (int ai = 0; ai < 2; ++ai)
#pragma unroll
                for (int m = 0; m < 4; ++m) { bf16_t* rp = KVM + (size_t)(row0 + 128 * ai + 16 * m) * 512 + u.pn * 256 + 32 * wc + 4 * fq;
#pragma unroll
                    for (int bj = 0; bj < 2; ++bj)
#pragma unroll
                        for (int n = 0; n < 2; ++n) { const f32x4 v = acc[ai][bj][m][n]; u32x2 w; w.x = cvt_pk_bf16(v[0], v[1]); w.y = cvt_pk_bf16(v[2], v[3]); *(u32x2*)(rp + 128 * bj + 16 * n) = w; } }
            return;
        }
        if (u.pn >= 6) {
            const int gc0 = (u.pn - 6) * 256 + 32 * wc + 8 * fq;
#pragma unroll
            for (int ai = 0; ai < 2; ++ai)
#pragma unroll
                for (int m = 0; m < 4; ++m) { unsigned char* rp = G8 + (size_t)(row0 + 128 * ai + 16 * m) * NG + gc0;
#pragma unroll
                    for (int bj = 0; bj < 2; ++bj) { const f32x4 v0 = acc[ai][bj][m][0], v1 = acc[ai][bj][m][1]; u32x2 w;
                        w.x = gate_pk4(sigmoidf_fast(v0[0]), sigmoidf_fast(v0[1]), sigmoidf_fast(v0[2]), sigmoidf_fast(v0[3]));
                        w.y = gate_pk4(sigmoidf_fast(v1[0]), sigmoidf_fast(v1[1]), sigmoidf_fast(v1[2]), sigmoidf_fast(v1[3]));
                        *(u32x2*)(rp + 128 * bj) = w; } }
            return;
        }
        const int slot = 4 * u.pn + wc;
        const int type = slot < 6 ? 0 : slot < 8 ? 1 : slot < 10 ? 2 : slot < 16 ? 3 : slot < 18 ? 4 : slot < 20 ? 5 : 6;
        const bool normed = type <= 1, axial = type <= 1, rope1d = (type == 3 || type == 4);
        const float qscale = (type == 0 || type == 3 || type == 6) ? C2 : 1.f;
        f32x4 gg[2][2];
        { const float* gsrc = type == 0 ? qn : kn;
#pragma unroll
          for (int bj = 0; bj < 2; ++bj)
#pragma unroll
            for (int n = 0; n < 2; ++n) gg[bj][n] = normed ? *(const f32x4*)(gsrc + 32 * bj + 16 * n + 4 * fq) : (f32x4){1.f, 1.f, 1.f, 1.f}; }
        float inv_ax[4], inv_b[2][4];
#pragma unroll
        for (int j = 0; j < 4; ++j) { inv_ax[j] = exp2f(-(float)(2 * (4 * fq + j)) * (13.287712379549449f / 32.f));
#pragma unroll
            for (int n = 0; n < 2; ++n) inv_b[n][j] = exp2f(-(float)(2 * (16 * n + 4 * fq + j)) * (13.287712379549449f / 64.f)); }
#pragma unroll
        for (int ai = 0; ai < 2; ++ai)
#pragma unroll
            for (int m = 0; m < 4; ++m) {
                const int row = row0 + 128 * ai + 16 * m, s = row & (SEQ - 1);
                f32x4 v[2][2];
#pragma unroll
                for (int bj = 0; bj < 2; ++bj)
#pragma unroll
                    for (int n = 0; n < 2; ++n) v[bj][n] = acc[ai][bj][m][n];
                if (normed) {
                    float ss = 0.f;
#pragma unroll
                    for (int bj = 0; bj < 2; ++bj)
#pragma unroll
                        for (int n = 0; n < 2; ++n) ss += (v[bj][n][0] * v[bj][n][0] + v[bj][n][1] * v[bj][n][1]) + (v[bj][n][2] * v[bj][n][2] + v[bj][n][3] * v[bj][n][3]);
                    ss += xl16(ss, (int)threadIdx.x & 63); ss = sum_halves(ss);
                    const float r = rsqrtf(ss * (1.f / 64.f) + EPS);
#pragma unroll
                    for (int bj = 0; bj < 2; ++bj)
#pragma unroll
                        for (int n = 0; n < 2; ++n) v[bj][n] = v[bj][n] * r * gg[bj][n];
                }
                if (axial) {
#pragma unroll
                    for (int bj = 0; bj < 2; ++bj) { const float pos = (float)(bj ? (s & 63) : (s >> 6));
#pragma unroll
                        for (int j = 0; j < 4; ++j) { float sn, c; sincos_red(pos * inv_ax[j], sn, c); const float x1 = v[bj][0][j], x2 = v[bj][1][j]; v[bj][0][j] = x1 * c - x2 * sn; v[bj][1][j] = x2 * c + x1 * sn; } }
                }
                if (rope1d) { const float pos = (float)s;
#pragma unroll
                    for (int n = 0; n < 2; ++n)
#pragma unroll
                        for (int j = 0; j < 4; ++j) { float sn, c; sincos_red(pos * inv_b[n][j], sn, c); const float x1 = v[0][n][j], x2 = v[1][n][j]; v[0][n][j] = x1 * c - x2 * sn; v[1][n][j] = x2 * c + x1 * sn; }
                }
                bf16_t* rp = QKV + (size_t)row * NQKV + 64 * slot + 4 * fq;
#pragma unroll
                for (int bj = 0; bj < 2; ++bj)
#pragma unroll
                    for (int n = 0; n < 2; ++n) { const f32x4 o = v[bj][n] * qscale; u32x2 w; w.x = cvt_pk_bf16(o[0], o[1]); w.y = cvt_pk_bf16(o[2], o[3]); *(__attribute__((address_space(1))) u32x2*)(rp + 32 * bj + 16 * n) = w; }
            }
    }
};

struct SchedP3 {
    const char* Y; const char* W; int G, c; VA4 va;
    __device__ __forceinline__ bool next(int i, pg8::Unit& u) const {
        const int ti = i / 3, br = i - 3 * ti, L = ti * G + c;
        if (L >= 256) return false;
        tile_of(L, 64, 4, u.pm, u.pn); u.aux = br; u.nt = br == 2 ? 4 : 6;
        const size_t kb = (size_t)br * 384 * 2;
        u.va0 = va.v0; u.va1 = va.v1; u.va2 = va.v2; u.va3 = va.v3;
        u.a = Y + (size_t)u.pm * 256 * 2048 + kb; u.b = W + (size_t)u.pn * 256 * 2048 + kb; return true;
    }
};
struct EpiP3 {
    const unsigned char* G8; unsigned char* MERGED8;
    __device__ __forceinline__ bool keep(const pg8::Unit& u) const { return u.aux < 2; }
    __device__ __forceinline__ void operator()(f32x4 (&acc)[2][2][4][2], const pg8::Unit& u, int wr, int wc, int fr, int fq) const {
        asm volatile("" : "+v"(fr), "+v"(fq));
        const int row0 = u.pm * 256 + wr * 64 + fr, col0 = u.pn * 256 + 32 * wc + 8 * fq, br = u.aux;
        const float GEPS = 9.094947e-13f;
        const int brd = br < 2 ? br + 1 : 2;
#pragma unroll
        for (int ai = 0; ai < 2; ++ai) {
            u32x2 gnv[4][2], gdv[4][2];
#pragma unroll
            for (int m = 0; m < 4; ++m) { const size_t row = (size_t)(row0 + 128 * ai + 16 * m);
#pragma unroll
                for (int bj = 0; bj < 2; ++bj) { gnv[m][bj] = *(const u32x2*)(G8 + row * NG + br * 1024 + col0 + 128 * bj); gdv[m][bj] = *(const u32x2*)(G8 + row * NG + brd * 1024 + col0 + 128 * bj); } }
#pragma unroll
            for (int m = 0; m < 4; ++m) { const size_t row = (size_t)(row0 + 128 * ai + 16 * m);
#pragma unroll
                for (int bj = 0; bj < 2; ++bj) {
                    const u32x2 gn8 = gnv[m][bj], gd8 = gdv[m][bj];
                    float f[8];
#pragma unroll
                    for (int k = 0; k < 4; ++k) { f[k] = (float)((gn8.x >> (8 * k)) & 0xff) * (1.f / 255.f); f[4 + k] = (float)((gn8.y >> (8 * k)) & 0xff) * (1.f / 255.f); }
#pragma unroll
                    for (int k = 0; k < 8; ++k) f[k] = fmaxf(f[k], GEPS);
                    if (br < 2) {
                        float d[8];
#pragma unroll
                        for (int k = 0; k < 4; ++k) { d[k] = (float)((gd8.x >> (8 * k)) & 0xff) * (1.f / 255.f); d[4 + k] = (float)((gd8.y >> (8 * k)) & 0xff) * (1.f / 255.f); }
#pragma unroll
                        for (int k = 0; k < 8; ++k) f[k] = f[k] * __builtin_amdgcn_rcpf(fmaxf(d[k], GEPS)); }
                    f32x4 v0 = acc[ai][bj][m][0], v1 = acc[ai][bj][m][1];
                    v0[0] *= f[0]; v0[1] *= f[1]; v0[2] *= f[2]; v0[3] *= f[3]; v1[0] *= f[4]; v1[1] *= f[5]; v1[2] *= f[6]; v1[3] *= f[7];
                    if (br < 2) { acc[ai][bj][m][0] = v0; acc[ai][bj][m][1] = v1; }
                    else { u32x2 w;
#pragma unroll
                        for (int k = 0; k < 4; ++k) { v0[k] = fminf(fmaxf(64.f * v0[k], -448.f), 448.f); v1[k] = fminf(fmaxf(64.f * v1[k], -448.f), 448.f); }
                        int t0_ = __builtin_amdgcn_cvt_pk_fp8_f32(v0[0], v0[1], 0, false); t0_ = __builtin_amdgcn_cvt_pk_fp8_f32(v0[2], v0[3], t0_, true);
                        int t1_ = __builtin_amdgcn_cvt_pk_fp8_f32(v1[0], v1[1], 0, false); t1_ = __builtin_amdgcn_cvt_pk_fp8_f32(v1[2], v1[3], t1_, true); w.x = (unsigned)t0_; w.y = (unsigned)t1_;
                        *(u32x2*)(MERGED8 + row * 1024 + col0 + 128 * bj) = w; } } } }
    }
};
struct SchedP4 {
    const char* A; const char* W; int G, c; VA4 va;
    __device__ __forceinline__ bool next(int i, pg8::Unit& u) const {
        const int L = i * G + c; if (L >= 256) return false;
        tile_of(L, 64, 4, u.pm, u.pn); u.aux = 0; u.nt = 8;
        u.va0 = va.v0; u.va1 = va.v1; u.va2 = va.v2; u.va3 = va.v3;
        u.a = A + (size_t)u.pm * 256 * 1024; u.b = W + (size_t)u.pn * 256 * 1024; return true;
    }
};
struct EpiP4 {
    const float* x; unsigned short* X1; const float* SB_OUT;
    __device__ __forceinline__ bool keep(const pg8::Unit&) const { return false; }
    __device__ __forceinline__ void operator()(f32x4 (&acc)[2][2][4][2], const pg8::Unit& u, int wr, int wc, int fr, int fq) const {
        const int row0 = u.pm * 256 + wr * 64 + fr, colp = u.pn * 256 + 32 * wc + 4 * fq, coll = u.pn * 256 + 64 * wc + 8 * fq;
        f32x4 sb[2][2];
#pragma unroll
        for (int bj = 0; bj < 2; ++bj)
#pragma unroll
            for (int n = 0; n < 2; ++n) sb[bj][n] = *(const f32x4*)(SB_OUT + colp + 128 * bj + 16 * n) * (1.f / 64.f);
#pragma unroll
        for (int ai = 0; ai < 2; ++ai) {
            f32x4 xv[4][2][2];
#pragma unroll
            for (int m = 0; m < 4; ++m) { const size_t off = (size_t)(row0 + 128 * ai + 16 * m) * D + coll;
#pragma unroll
                for (int bj = 0; bj < 2; ++bj)
#pragma unroll
                    for (int n = 0; n < 2; ++n) xv[m][bj][n] = *(const f32x4*)(x + off + 32 * bj + 4 * n); }
#pragma unroll
            for (int m = 0; m < 4; ++m) { const size_t off = (size_t)(row0 + 128 * ai + 16 * m) * D + coll;
#pragma unroll
                for (int bj = 0; bj < 2; ++bj) { const f32x4 o0 = xv[m][bj][0] + acc[ai][bj][m][0] * sb[bj][0], o1 = xv[m][bj][1] + acc[ai][bj][m][1] * sb[bj][1];
                    u32x4 w; w.x = cvt_pk_bf16(o0[0], o0[1]); w.y = cvt_pk_bf16(o0[2], o0[3]); w.z = cvt_pk_bf16(o1[0], o1[1]); w.w = cvt_pk_bf16(o1[2], o1[3]);
                    *(u32x4*)(X1 + off + 32 * bj) = w; } }
        }
    }
};

#ifndef P5_PREFILLED
#define P5_PREFILLED 1
#endif
__device__ __forceinline__ void split_bf16x8(const float (&h)[8], bf16x8& hi, bf16x8& lo) {
    u32x4 a, b;
#pragma unroll
    for (int i = 0; i < 4; ++i) { const unsigned d = cvt_pk_bf16(h[2 * i], h[2 * i + 1]); a[i] = d;
        b[i] = cvt_pk_bf16(h[2 * i] - __uint_as_float(d << 16), h[2 * i + 1] - __uint_as_float(d & 0xffff0000u)); }
    hi = __builtin_bit_cast(bf16x8, a); lo = __builtin_bit_cast(bf16x8, b);
}
__device__ __forceinline__ void p5_fill_wr(const Params& P, LAS unsigned char* lds) {
    float w[8][8];
#pragma unroll
    for (int it = 0; it < 8; ++it) { const int u = (int)threadIdx.x + it * (NWAVES * 64), l = u & 63, nb = (u >> 6) & 1, ks = u >> 7;
        const float* wp = P.w_router + (size_t)(32 * ks + 8 * (l >> 4)) * 32 + 16 * nb + (l & 15);
#pragma unroll
        for (int i = 0; i < 8; ++i) w[it][i] = wp[i * 32]; }
#pragma unroll
    for (int it = 0; it < 8; ++it) { const int u = (int)threadIdx.x + it * (NWAVES * 64), l = u & 63, nb = (u >> 6) & 1, ks = u >> 7;
        bf16x8 hi, lo; split_bf16x8(w[it], hi, lo);
        LAS unsigned char* dst = lds + (size_t)((ks * 2 + nb) * 2) * 1024 + l * 16;
        *(LAS bf16x8*)dst = hi; *(LAS bf16x8*)(dst + 1024) = lo; }
}
template <bool ALT> __device__ __forceinline__ void p5_router(const Params& P, LAS unsigned char* lds, int G) {
    const int tid = threadIdx.x, lane = tid & 63, wave = __builtin_amdgcn_readfirstlane(tid >> 6);
    LAS int* lcnt = (LAS int*)(lds + LX_OFF);
    LAS int* lbase = lcnt + 32;
    LAS int* pe = lbase + 32;
    LAS int* plp = pe + 256;
    LAS float* satok = (LAS float*)(plp + 256);
    LAS float* lg = (LAS float*)(lds + LX2_OFF);
    LAS float* stt = (LAS float*)(lds + LX2_OFF + 8192);
    const unsigned short* X1 = (const unsigned short*)(P.ws + WS_X1); signed char* H = (signed char*)(P.ws + (ALT ? WS_YS : WS_H2)); float* SAL = (float*)(P.ws + (ALT ? WS_YS + 52 * MiB : WS_SAL));
    int* gcnt = (int*)(P.ws + WS_CTL + CTL_CNT_OFF) + (ALT ? 16 : 0); int* LIST = (int*)(P.ws + (ALT ? WS_YS + 40 * MiB : WS_LIST)); int* SLOT = (int*)(P.ws + (ALT ? WS_YS + 48 * MiB : WS_SLOT)); float* TOPW = (float*)(P.ws + (ALT ? WS_YS + 50 * MiB : WS_TOPW));
    if (ALT || !P5_PREFILLED) { p5_fill_wr(P, lds); __syncthreads(); }
    const float bias = P.b_router[lane & 31];
    const int r = lane & 15, kq = lane >> 4, grp = wave >> 1, half = wave & 1;
    for (int blk = blockIdx.x; blk < T / 64; blk += G) {
        if (tid < 32) lcnt[tid] = 0;
        const int tokl = 16 * grp + r, tok = blk * 64 + tokl;
        const unsigned short* xr = X1 + (size_t)tok * D + 512 * half + 8 * kq; const float* gr = P.norm_ffn + 512 * half + 8 * kq;
        f32x4 xv[16][2];
        float ss = 0.f, mm = 0.f;
#pragma unroll
        for (int ks = 0; ks < 16; ++ks) { const u32x4 xb = *(const u32x4*)(xr + 32 * ks);
#pragma unroll
            for (int c = 0; c < 2; ++c) { const unsigned d0 = xb[2 * c], d1 = xb[2 * c + 1]; const f32x4 x = {__uint_as_float(d0 << 16), __uint_as_float(d0 & 0xffff0000u), __uint_as_float(d1 << 16), __uint_as_float(d1 & 0xffff0000u)};
                const f32x4 g = *(const f32x4*)(gr + 32 * ks + 4 * c); const f32x4 v = x * g; xv[ks][c] = v;
                ss += (x.x * x.x + x.y * x.y) + (x.z * x.z + x.w * x.w); mm = fmaxf(fmaxf(mm, fmaxf(fabsf(v.x), fabsf(v.y))), fmaxf(fabsf(v.z), fabsf(v.w))); } }
        ss += xl16(ss, lane); ss = sum_halves(ss);
        mm = fmaxf(mm, xl16(mm, lane)); { const auto rr = __builtin_amdgcn_permlane32_swap(__float_as_uint(mm), __float_as_uint(mm), false, false); mm = fmaxf(__uint_as_float(rr[0]), __uint_as_float(rr[1])); }
        if (lane < 16) { stt[tokl * 4 + 2 * half] = ss; stt[tokl * 4 + 2 * half + 1] = mm; }
        __syncthreads();
        const f32x4 s4 = *(const LAS f32x4*)(stt + tokl * 4);
        const float rs = rsqrtf((s4.x + s4.z) * (1.f / D) + EPS), mx = fmaxf(s4.y, s4.w), mg = mx > 0.f ? 127.f / mx : 0.f;
        if (half == 0 && lane < 16) satok[tokl] = rs * mx * (1.f / 127.f);
        f32x4 acc0 = {0.f, 0.f, 0.f, 0.f}, acc1 = {0.f, 0.f, 0.f, 0.f};
        signed char* hrow = H + (size_t)tok * D + 512 * half + 8 * kq;
        const LAS unsigned char* wfr = lds + (size_t)(16 * half) * 4096 + lane * 16;
#pragma unroll
        for (int ks = 0; ks < 16; ++ks) {
            const f32x4 v0 = xv[ks][0], v1 = xv[ks][1];
            u32x2 q; q.x = pack_i8x4(v0.x * mg, v0.y * mg, v0.z * mg, v0.w * mg); q.y = pack_i8x4(v1.x * mg, v1.y * mg, v1.z * mg, v1.w * mg);
            *(u32x2*)(hrow + 32 * ks) = q;
            const float h[8] = {v0.x * rs, v0.y * rs, v0.z * rs, v0.w * rs, v1.x * rs, v1.y * rs, v1.z * rs, v1.w * rs};
            bf16x8 ahi, alo; split_bf16x8(h, ahi, alo);
            const bf16x8 bh0 = *(const LAS bf16x8*)(wfr + ks * 4096), bl0 = *(const LAS bf16x8*)(wfr + ks * 4096 + 1024), bh1 = *(const LAS bf16x8*)(wfr + ks * 4096 + 2048), bl1 = *(const LAS bf16x8*)(wfr + ks * 4096 + 3072);
            acc0 = __builtin_amdgcn_mfma_f32_16x16x32_bf16(ahi, bh0, acc0, 0, 0, 0); acc1 = __builtin_amdgcn_mfma_f32_16x16x32_bf16(ahi, bh1, acc1, 0, 0, 0);
            acc0 = __builtin_amdgcn_mfma_f32_16x16x32_bf16(ahi, bl0, acc0, 0, 0, 0); acc1 = __builtin_amdgcn_mfma_f32_16x16x32_bf16(ahi, bl1, acc1, 0, 0, 0);
            acc0 = __builtin_amdgcn_mfma_f32_16x16x32_bf16(alo, bh0, acc0, 0, 0, 0); acc1 = __builtin_amdgcn_mfma_f32_16x16x32_bf16(alo, bh1, acc1, 0, 0, 0);
        }
        LAS float* lgp = lg + (16 * grp + 4 * kq) * 32 + r;
        if (half == 1) {
#pragma unroll
            for (int j = 0; j < 4; ++j) { lgp[j * 32] = acc0[j]; lgp[j * 32 + 16] = acc1[j]; } }
        __syncthreads();
        if (half == 0) {
#pragma unroll
            for (int j = 0; j < 4; ++j) { lgp[j * 32] += acc0[j]; lgp[j * 32 + 16] += acc1[j]; } }
        __syncthreads();
        for (int q = 0; q < 8; ++q) {
            {
                const int tl = wave * 8 + q, t = blk * 64 + tl;
                const float logit = lg[tl * 32 + (lane & 31)] + bias;
                const int e = lane & 31;
                float vals[4]; int idxs[4]; float cur = logit;
#pragma unroll
                for (int k = 0; k < 4; ++k) {
                    const float mx = wave_max_s(cur);
                    const unsigned long long mk = __ballot(cur == mx);
                    const int bi = (int)(__builtin_ctzll(mk) & 31);
                    vals[k] = mx; idxs[k] = bi; if (e == bi) cur = -3.0e38f;
                }
                float ex[4], sum = 0.f;
#pragma unroll
                for (int k = 0; k < 4; ++k) { ex[k] = __expf(vals[k] - vals[0]); sum += ex[k]; }
                if (lane < 4) {
                    const int k = lane;
                    const int ee = k == 0 ? idxs[0] : k == 1 ? idxs[1] : k == 2 ? idxs[2] : idxs[3];
                    const float ev = k == 0 ? ex[0] : k == 1 ? ex[1] : k == 2 ? ex[2] : ex[3];
                    const int lp = __hip_atomic_fetch_add(lcnt + ee, 1, __ATOMIC_RELAXED, __HIP_MEMORY_SCOPE_WORKGROUP);
                    pe[tl * 4 + k] = ee; plp[tl * 4 + k] = lp;
                    TOPW[(size_t)t * 4 + k] = ev / sum;
                }
            }
        }
        __syncthreads();
        if (tid < 32) lbase[tid] = atomicAdd(gcnt + GCNT_IDX(tid), lcnt[tid]);
        __syncthreads();
        if (tid < 256) { const int ee = pe[tid], pos = lbase[ee] + plp[tid], pair = blk * 256 + tid; LIST[(size_t)ee * T + pos] = pair; SLOT[pair] = (ee << 16) | pos; SAL[(size_t)ee * T + pos] = satok[tid >> 2]; }
        __syncthreads();
    }
}

__device__ __forceinline__ void moe_tables(const Params& P, LAS unsigned char* lds) {
    const int tid = threadIdx.x;
    LAS int* tb = (LAS int*)(lds + LX_OFF + 4096);
    const int* gcnt = (const int*)(P.ws + WS_CTL + CTL_CNT_OFF);
    if (tid < 32) tb[40 + tid] = gcnt[GCNT_IDX(tid)];
    __syncthreads();
    if (tid == 0) { int s = 0; for (int e = 0; e < 32; ++e) { tb[e] = s; s += (tb[40 + e] + 255) >> 8; } tb[32] = s; }
    __syncthreads();
}
template <int NPN, bool GATHER> struct SchedMoe {
    const char* A; const char* W; const int* LIST; const int* gcnt; const LAS int* tb; int G, c; VA4 va; size_t wstride; unsigned pitch; int nt;
    __device__ __forceinline__ bool next(int i, pg8::Unit& u) const {
        int mtg, pn;
        if (G == 256) { const int j = c >> 3, grp = i * 8 + (c & 7), jm = j / NPN; mtg = grp * (32 / NPN) + jm; pn = j - jm * NPN; }
        else { const int L = i * G + c; mtg = L / NPN; pn = L - mtg * NPN; }
        if (mtg >= tb[32]) return false;
        int e = 0;
#pragma unroll
        for (int k = 1; k < 32; ++k) e += (tb[k] <= mtg) ? 1 : 0;
        u.pm = mtg; u.pn = pn; u.aux = e; u.nt = nt;
        u.b = W + (size_t)e * wstride + (size_t)pn * 256 * pitch;
        if constexpr (GATHER) {
            const int r0 = (mtg - tb[e]) * 256, ce = tb[40 + e];
            int R0, C0, R1, C1; pg8::lane_piece(0, R0, C0); pg8::lane_piece(1, R1, C1);
            const int* le = LIST + (size_t)e * T;
            const int ra = r0 + R0, rb = r0 + R1, rc = r0 + 128 + R0, rd = r0 + 128 + R1;
            const int cl = ce > 0 ? ce - 1 : 0;
            const int la = le[min(ra, cl)], lb = le[min(rb, cl)], lc = le[min(rc, cl)], ld = le[min(rd, cl)];
            const int ta = ra < ce ? (la >> 2) : 0, tb2 = rb < ce ? (lb >> 2) : 0, tc = rc < ce ? (lc >> 2) : 0, td = rd < ce ? (ld >> 2) : 0;
            u.va0 = (unsigned)ta * pitch + (unsigned)C0 * 2u; u.va1 = (unsigned)tb2 * pitch + (unsigned)C1 * 2u; u.va2 = (unsigned)tc * pitch + (unsigned)C0 * 2u; u.va3 = (unsigned)td * pitch + (unsigned)C1 * 2u;
            u.a = A;
        } else {
            u.va0 = va.v0; u.va1 = va.v1; u.va2 = va.v2; u.va3 = va.v3;
            u.a = A + (size_t)mtg * 256 * pitch;
        }
        return true;
    }
};
struct EpiP6 {
    const float* b_gu; unsigned char* ACT8; const float* SAL; const float* SB_GU; const LAS int* tb;
    __device__ __forceinline__ bool keep(const pg8::Unit&) const { return false; }
    __device__ __forceinline__ void operator()(f32x4 (&acc)[2][2][4][2], const pg8::Unit& u, int wr, int wc, int fr, int fq) const {
        asm volatile("" : "+v"(fr), "+v"(fq));
        const int row0 = u.pm * 256 + wr * 64 + fr, col0 = u.pn * 128 + 32 * wc + 8 * fq;
        const float* sar = SAL + (size_t)u.aux * T + (u.pm - tb[u.aux]) * 256 + wr * 64 + fr;
        const float* sbp = SB_GU + u.aux * 2048 + u.pn * 256 + 32 * wc + 4 * fq;
        const float* bp = b_gu + (size_t)u.aux * 2048 + col0;
        float sa[2][4];
#pragma unroll
        for (int ai = 0; ai < 2; ++ai)
#pragma unroll
            for (int m = 0; m < 4; ++m) sa[ai][m] = sar[128 * ai + 16 * m];
        int half0[2][4];
#pragma unroll
        for (int n = 0; n < 2; ++n) {
            const f32x4 sg = *(const f32x4*)(sbp + 16 * n), sl = *(const f32x4*)(sbp + 128 + 16 * n) * 4.f, bg = *(const f32x4*)(bp + 4 * n), bl = *(const f32x4*)(bp + 1024 + 4 * n) * 4.f + 4.f;
#pragma unroll
            for (int ai = 0; ai < 2; ++ai)
#pragma unroll
                for (int m = 0; m < 4; ++m) {
                    const i32x4 qg = __builtin_bit_cast(i32x4, acc[ai][0][m][n]), ql = __builtin_bit_cast(i32x4, acc[ai][1][m][n]);
                    float o[4];
#pragma unroll
                    for (int j = 0; j < 4; ++j) { const float g = fminf(fmaf((float)qg[j] * sa[ai][m], sg[j], bg[j]), 7.f), l4 = fminf(fmaxf(fmaf((float)ql[j] * sa[ai][m], sl[j], bl[j]), -24.f), 32.f);
                        o[j] = g * __builtin_amdgcn_rcpf(1.f + __builtin_amdgcn_exp2f(-1.702f * LOG2E * g)) * l4; }
                    int t_ = __builtin_amdgcn_cvt_pk_fp8_f32(o[0], o[1], 0, false); t_ = __builtin_amdgcn_cvt_pk_fp8_f32(o[2], o[3], t_, true);
                    if (n == 0) half0[ai][m] = t_;
                    else { u32x2 w; w.x = (unsigned)half0[ai][m]; w.y = (unsigned)t_; *(u32x2*)(ACT8 + (size_t)(row0 + 128 * ai + 16 * m) * 1024 + col0) = w; } }
        }
    }
};
struct EpiP7 {
    const float* b_dn; signed char* YS8; float* YSS; const float* SB_DN; LAS unsigned char* ldsx;
    __device__ __forceinline__ bool keep(const pg8::Unit&) const { return false; }
    __device__ __forceinline__ void operator()(f32x4 (&acc)[2][2][4][2], const pg8::Unit& u, int wr, int wc, int fr, int fq) const {
        asm volatile("" : "+v"(fr), "+v"(fq));
        const int lane = (int)threadIdx.x & 63;
        const int row0 = u.pm * 256 + wr * 64 + fr, col0 = u.pn * 256 + 32 * wc + 8 * fq;
        const float* bp = b_dn + (size_t)u.aux * 1024 + col0;
        const float* sbp = SB_DN + u.aux * 1024 + u.pn * 256 + 32 * wc + 4 * fq;
#pragma unroll
        for (int bj = 0; bj < 2; ++bj)
#pragma unroll
            for (int n = 0; n < 2; ++n) { const f32x4 bbv = *(const f32x4*)(bp + 128 * bj + 4 * n), sbv = *(const f32x4*)(sbp + 128 * bj + 16 * n) * 0.25f;
#pragma unroll
                for (int ai = 0; ai < 2; ++ai)
#pragma unroll
                    for (int m = 0; m < 4; ++m) acc[ai][bj][m][n] = acc[ai][bj][m][n] * sbv + bbv; }
        LAS float* RM = (LAS float*)(ldsx + LX_OFF);
#pragma unroll
        for (int ai = 0; ai < 2; ++ai)
#pragma unroll
            for (int m = 0; m < 4; ++m) { f32x4 a4 = __builtin_elementwise_max(__builtin_elementwise_max(__builtin_elementwise_abs(acc[ai][0][m][0]), __builtin_elementwise_abs(acc[ai][0][m][1])),
                                                                                 __builtin_elementwise_max(__builtin_elementwise_abs(acc[ai][1][m][0]), __builtin_elementwise_abs(acc[ai][1][m][1])));
                float mx = fmaxf(fmaxf(a4[0], a4[1]), fmaxf(a4[2], a4[3]));
                mx = fmaxf(mx, xl16(mx, lane));
                { const auto r = __builtin_amdgcn_permlane32_swap(__float_as_uint(mx), __float_as_uint(mx), false, false); mx = fmaxf(__uint_as_float(r[0]), __uint_as_float(r[1])); }
                if (lane < 16) RM[(128 * ai + 64 * wr + 16 * m + fr) * 4 + wc] = mx; }
        asm volatile("s_waitcnt lgkmcnt(0)" ::: "memory"); __builtin_amdgcn_s_barrier(); asm volatile("" ::: "memory");
#pragma unroll
        for (int ai = 0; ai < 2; ++ai)
#pragma unroll
            for (int m = 0; m < 4; ++m) { const int tr = 128 * ai + 64 * wr + 16 * m + fr; const f32x4 r4 = *(const LAS f32x4*)(RM + tr * 4);
                const float mt = fmaxf(fmaxf(r4[0], r4[1]), fmaxf(r4[2], r4[3])), inv = mt > 0.f ? 127.f / mt : 0.f; const size_t row = (size_t)(row0 + 128 * ai + 16 * m);
                if (wc == 0 && lane < 16) YSS[row * 4 + u.pn] = mt * (1.f / 127.f);
#pragma unroll
                for (int bj = 0; bj < 2; ++bj) { const f32x4 v0 = acc[ai][bj][m][0] * inv, v1 = acc[ai][bj][m][1] * inv;
                    u32x2 w; w.x = pack_i8x4(v0[0], v0[1], v0[2], v0[3]); w.y = pack_i8x4(v1[0], v1[1], v1[2], v1[3]);
                    *(u32x2*)(YS8 + row * 1024 + col0 + 128 * bj) = w; } }
    }
};

__device__ __forceinline__ void p8_final(const Params& P, LAS unsigned char* lds, int G) {
    const int tid = threadIdx.x, lane = tid & 63, wave = __builtin_amdgcn_readfirstlane(tid >> 6);
    const LAS int* tb = (const LAS int*)(lds + LX_OFF + 4096);
    const unsigned short* X1 = (const unsigned short*)(P.ws + WS_X1); const signed char* YS8 = (const signed char*)(P.ws + WS_YS); const float* YSS = (const float*)(P.ws + WS_YSS); const int* SLOT = (const int*)(P.ws + WS_SLOT); const float* TOPW = (const float*)(P.ws + WS_TOPW);
    const int gw = (int)blockIdx.x * NWAVES + wave, NGW = G * NWAVES;
    f32x4 gg[2][2];
#pragma unroll
    for (int j = 0; j < 2; ++j)
#pragma unroll
        for (int h = 0; h < 2; ++h) gg[j][h] = ((const f32x4*)P.norm_final)[2 * lane + 128 * j + h];
    for (int t = gw; t < T; t += NGW) {
        f32x4 v[2][2];
#pragma unroll
        for (int j = 0; j < 2; ++j) { const u32x4 xb = *((const u32x4*)(X1 + (size_t)t * D) + lane + 64 * j);
            v[j][0] = (f32x4){__uint_as_float(xb.x << 16), __uint_as_float(xb.x & 0xffff0000u), __uint_as_float(xb.y << 16), __uint_as_float(xb.y & 0xffff0000u)};
            v[j][1] = (f32x4){__uint_as_float(xb.z << 16), __uint_as_float(xb.z & 0xffff0000u), __uint_as_float(xb.w << 16), __uint_as_float(xb.w & 0xffff0000u)}; }
#pragma unroll
        for (int k = 0; k < 4; ++k) { const int sl = SLOT[t * 4 + k]; const float w = TOPW[t * 4 + k]; const size_t row = (size_t)tb[sl >> 16] * 256 + (sl & 0xffff);
            const f32x4 sc = *(const f32x4*)(YSS + row * 4) * w;
#pragma unroll
            for (int j = 0; j < 2; ++j) { const u32x2 q = *((const u32x2*)(YS8 + row * 1024) + lane + 64 * j); const float s = (lane & 32) ? sc[2 * j + 1] : sc[2 * j];
                v[j][0].x += s * (float)(signed char)(q.x & 0xff); v[j][0].y += s * (float)(signed char)((q.x >> 8) & 0xff); v[j][0].z += s * (float)(signed char)((q.x >> 16) & 0xff); v[j][0].w += s * (float)((int)q.x >> 24);
                v[j][1].x += s * (float)(signed char)(q.y & 0xff); v[j][1].y += s * (float)(signed char)((q.y >> 8) & 0xff); v[j][1].z += s * (float)(signed char)((q.y >> 16) & 0xff); v[j][1].w += s * (float)((int)q.y >> 24); } }
        float s = 0.f;
#pragma unroll
        for (int j = 0; j < 2; ++j)
#pragma unroll
            for (int h = 0; h < 2; ++h) s += (v[j][h].x * v[j][h].x + v[j][h].y * v[j][h].y) + (v[j][h].z * v[j][h].z + v[j][h].w * v[j][h].w);
        const float r = rsqrtf(wave_sum_s(s) * (1.f / D) + EPS);
#pragma unroll
        for (int j = 0; j < 2; ++j)
#pragma unroll
            for (int h = 0; h < 2; ++h) *((f32x4*)(P.out + (size_t)t * D) + 2 * lane + 128 * j + h) = v[j][h] * r * gg[j][h];
    }
}
#define XB_TMO      128
#define XB_XCNT(j)  (256  + 64 * (j))
#define XB_XSUB(j)  (1280 + 64 * (j))
#define XB_XGEN(j)  (2304 + 64 * (j))
#define XB_TOP      3328
#define XB_TOPGEN   3392
#define XCD_BAR_WORDS 3456
#define XB_SPIN_CAP (1u << 18)

__device__ __forceinline__ unsigned xb_ld(unsigned* p)              { return __hip_atomic_load(p, __ATOMIC_RELAXED, __HIP_MEMORY_SCOPE_AGENT); }
__device__ __forceinline__ unsigned xb_add(unsigned* p, unsigned v) { return __hip_atomic_fetch_add(p, v, __ATOMIC_RELAXED, __HIP_MEMORY_SCOPE_AGENT); }
__device__ __forceinline__ unsigned xb_xcc_id() { return (unsigned)__builtin_amdgcn_s_getreg((3 << 11) | 20) & 0xFu; }
#define XB_SPIN(cond, bar) do { unsigned _sp = 0; while (cond) { __builtin_amdgcn_s_sleep(1); \
    if ((++_sp & 255u) == 0u) { if (xb_ld(&(bar)[XB_TMO])) break; if (_sp > XB_SPIN_CAP) { atomicAdd(&(bar)[XB_TMO], 1u); break; } } } } while (0)

struct XcdBarrier {
    unsigned* bar; unsigned x;
    volatile LAS unsigned* st;
};

__device__ __forceinline__ XcdBarrier xcd_barrier_post(unsigned* bar, volatile LAS unsigned* st) {
    XcdBarrier b; b.bar = bar; b.x = xb_xcc_id(); b.st = st;
    if (threadIdx.x == 0) (void)xb_add(&bar[XB_XCNT(b.x)], 1u);
    return b;
}
__device__ __forceinline__ void xcd_barrier_complete(unsigned* bar, unsigned x, unsigned& nloc, unsigned& nx) {
    const unsigned G = gridDim.x * gridDim.y * gridDim.z;
    unsigned sum, cnt, mine, sp = 0u;
    for (;;) {
        sum = 0u; cnt = 0u; mine = 0u;
#pragma unroll
        for (unsigned j = 0; j < 16; ++j) { const unsigned c = xb_ld(&bar[XB_XCNT(j)]); sum += c; cnt += (c > 0u) ? 1u : 0u; mine = (j == x) ? c : mine; }
        if (sum == G) break;
        __builtin_amdgcn_s_sleep(1);
        if ((++sp & 255u) == 0u) { if (xb_ld(&bar[XB_TMO])) break; if (sp > XB_SPIN_CAP) { atomicAdd(&bar[XB_TMO], 1u); break; } }
    }
    nloc = mine > 0u ? mine : 1u; nx = cnt > 0u ? cnt : 1u;
}

__device__ __forceinline__ void xcd_barrier(const XcdBarrier& b) {
    asm volatile("s_waitcnt vmcnt(0)" ::: "memory");
    __syncthreads();
    if (threadIdx.x == 0) {
        unsigned* bar = b.bar;
        __builtin_amdgcn_s_waitcnt(0);
        unsigned nloc = b.st[0], nx = b.st[1];
        if (nloc == 0u) { xcd_barrier_complete(bar, b.x, nloc, nx); b.st[0] = nloc; b.st[1] = nx; }
        const unsigned old = xb_add(&bar[XB_XSUB(b.x)], 1u);
        const unsigned gen = old / nloc;
        if (old + 1u == (gen + 1u) * nloc) {
            __builtin_amdgcn_fence(__ATOMIC_RELEASE, "agent");
            asm volatile("s_waitcnt vmcnt(0)" ::: "memory");
            const unsigned og = xb_add(&bar[XB_TOP], 1u);
            const unsigned tg = og / nx;
            if (og + 1u == (tg + 1u) * nx) xb_add(&bar[XB_TOPGEN], 1u);
            else XB_SPIN(xb_ld(&bar[XB_TOPGEN]) == tg, bar);
            __builtin_amdgcn_fence(__ATOMIC_ACQUIRE, "agent");
            xb_add(&bar[XB_XGEN(b.x)], 1u);
            asm volatile("s_waitcnt vmcnt(0)" ::: "memory");
        } else {
            XB_SPIN(xb_ld(&bar[XB_XGEN(b.x)]) == gen, bar);
            __builtin_amdgcn_fence(__ATOMIC_ACQUIRE, "agent");
            asm volatile("s_waitcnt vmcnt(0)" ::: "memory");
        }
    }
    __syncthreads();
}
__device__ __forceinline__ void attn_desc_A(const Params& P, int idx, attn_body::AttnDesc& A) {
    using attn_body::bf16;
    const int b = idx / 192, rem = idx % 192, hq = rem >> 5, qb = rem & 31;
    const bf16* QKV = (const bf16*)(P.ws + WS_QKV); bf16* Y = (bf16*)(P.ws + WS_Y);
    A.Q = QKV + C_QA + hq * 64; A.K = QKV + C_KA + (hq / 3) * 64; A.V = QKV + C_VA + (hq / 3) * 64; A.O = Y + hq * 64;
    A.dmq = NQKV; A.dmk = NQKV; A.dmo = D; A.qrow0 = (long)b * SEQ + qb * 256; A.krow0 = (long)b * SEQ; A.NT = SEQ / 64; A.dpos0 = 0; A.sinkl2 = 0.f; A.fixref = 0.f;
}
__device__ __forceinline__ void attn_desc_B(const Params& P, int idx, attn_body::AttnDesc& A) {
    using attn_body::bf16;
    const int b = idx / 192, rem = idx % 192, hq = rem >> 5, qb = rem & 31;
    const bf16* QKV = (const bf16*)(P.ws + WS_QKV); bf16* Y = (bf16*)(P.ws + WS_Y);
    const int q0 = qb * 256, kt0 = q0 >= 128 ? q0 - 128 : 0, kend = (q0 + 384 <= SEQ) ? q0 + 384 : SEQ;
    A.Q = QKV + C_QB + hq * 64; A.K = QKV + C_KB + (hq / 3) * 64; A.V = QKV + C_VB + (hq / 3) * 64; A.O = Y + 384 + hq * 64;
    A.dmq = NQKV; A.dmk = NQKV; A.dmo = D; A.qrow0 = (long)b * SEQ + q0; A.krow0 = (long)b * SEQ + kt0; A.NT = (kend - kt0) / 64; A.dpos0 = kt0 - q0; A.sinkl2 = P.sink[hq] * LOG2E; A.fixref = 0.f;
}
__device__ __forceinline__ void attn_desc_M(const Params& P, int idx, attn_body::AttnDesc& A) {
    using attn_body::bf16;
    const int b = idx >> 7, rem = idx & 127, hm = rem >> 5, qb = rem & 31;
    const bf16* QKV = (const bf16*)(P.ws + WS_QKV); const bf16* KVM = (const bf16*)(P.ws + WS_KVM); bf16* Y = (bf16*)(P.ws + WS_Y);
    A.Q = QKV + C_QM + hm * 64; A.K = KVM + hm * 64; A.V = KVM + 256 + hm * 64; A.O = Y + 768 + hm * 64;
    A.dmq = NQKV; A.dmk = 512; A.dmo = D; A.qrow0 = (long)b * SEQ + qb * 256; A.krow0 = (long)b * NMEM; A.NT = NMEM / 64; A.dpos0 = 0; A.sinkl2 = 0.f; A.fixref = 0.f;
}
#ifndef MK_ATTN_MODES
#define MK_ATTN_MODES 3
#endif
__device__ __forceinline__ void p2_convert(const Params& P, LAS unsigned char* lds, int G);
__device__ __forceinline__ void p2_attention(const Params& P, char* lds, int G, LAS unsigned char* ldsl, bool conv_mid) {
    const int c = blockIdx.x;
    int nA, a0, a1, nB, b0, nM, m0;
    if (G == 256) { if (c < 128) { nA = 2; a0 = c; a1 = 256 + c; nB = 0; b0 = 0; nM = 0; m0 = 0; } else { nA = 1; a0 = c; a1 = 0; nB = 3; b0 = 3 * (c - 128); nM = 2; m0 = 2 * (c - 128); } }
    else { nA = 0; a0 = a1 = 0; nB = 0; b0 = 0; nM = 0; m0 = 0; }
    float fixref;
    { const int ln = (int)threadIdx.x & 63; const float mq = wave_max_s(fabsf(P.qn[ln])), mk = wave_max_s(fabsf(P.kn[ln])); fixref = 64.f * mq * mk * C2 * 1.02f; }
    const bool fixed_ok = fixref > 0.f && fixref < 40.f;
    if (G == 256) {
        for (int k = 0; k < nA; ++k) { attn_body::AttnDesc A; attn_desc_A(P, k == 0 ? a0 : a1, A); A.fixref = fixref;
            if (fixed_ok) attn_body::attn_unit<8, 2>(A, lds); else attn_body::attn_unit<8, 0>(A, lds);
            if (conv_mid && k == 0) p2_convert(P, ldsl, G); }
        for (int k = 0; k < nM; ++k) { attn_body::AttnDesc A; attn_desc_M(P, m0 + k, A); attn_body::attn_unit<8, 0>(A, lds); }
        for (int k = 0; k < nB; ++k) { attn_body::AttnDesc A; attn_desc_B(P, b0 + k, A); attn_body::attn_unit<8, 1>(A, lds); }
    } else {
        for (int u = c; u < 384; u += G) { attn_body::AttnDesc A; attn_desc_A(P, u, A); A.fixref = fixref; if (fixed_ok) attn_body::attn_unit<8, 2>(A, lds); else attn_body::attn_unit<8, 0>(A, lds); }
        for (int u = c; u < 256; u += G) { attn_body::AttnDesc A; attn_desc_M(P, u, A); attn_body::attn_unit<8, 0>(A, lds); }
        for (int u = c; u < 384; u += G) { attn_body::AttnDesc A; attn_desc_B(P, u, A); attn_body::attn_unit<8, 1>(A, lds); }
    }
}

#ifndef MK_SHARE_A
#define MK_SHARE_A 6
#endif
__device__ __forceinline__ void p2_convert(const Params& P, LAS unsigned char* lds, int G) {
    int c = blockIdx.x; asm volatile("" : "+s"(c));
    if (G != 256) return;
    const int wave = __builtin_amdgcn_readfirstlane((int)threadIdx.x >> 6);
    const bool two = c < 128; const int j = c - 128;
    constexpr int SA = MK_SHARE_A, SB = 22 - SA;
    const int gs = two ? 248 + SA * c : 248 + 128 * SA + SB * j + (j < 8 ? j : 8), gn = two ? SA : SB + (j < 8 ? 1 : 0);
    convert_moe_items<true>(P, lds, gs, gn);
}
__global__ void __launch_bounds__(NWAVES * 64, 2) mk_fwd(Params P) {
    extern __shared__ __attribute__((aligned(16))) unsigned char lds_raw[];
    LAS unsigned char* lds = (LAS unsigned char*)lds_raw;
    { volatile LAS unsigned* st0 = (volatile LAS unsigned*)(lds + LX_OFF + 8192); if (threadIdx.x < 4) st0[threadIdx.x] = 0u; }
    __syncthreads();
    XcdBarrier bar = xcd_barrier_post((unsigned*)(P.ws + WS_CTL + CTL_BAR_OFF), (volatile LAS unsigned*)(lds + LX_OFF + 8192));
    const int G = gridDim.x, c = blockIdx.x;
#define PHASE_WS unsigned char* ws = P.ws; asm volatile("" : "+s"(ws)); ws = (unsigned char*)(__attribute__((address_space(1))) unsigned char*)ws;
#ifndef MK_PHASE_MASK
#define MK_PHASE_MASK 0x1ff
#endif
#ifndef MK_REP
#define MK_REP 0
#endif
#define IN(k) (((MK_PHASE_MASK >> (k)) & 1) && P.ph_lo <= (k) && (k) < P.ph_hi)
#define REP(k)
#if defined(MK_TIMING)
    unsigned long long* ts = (unsigned long long*)(ws + WS_CTL + 2048);
#define STAMP(k) do { if (blockIdx.x == 0 && threadIdx.x == 0) ts[k] = __builtin_amdgcn_s_memrealtime(); } while (0)
#define SEAM(k) do { xcd_barrier(bar); STAMP((k) + 1); } while (0)
    STAMP(0);
#else
#define SEAM(k) do { if (IN(k) && IN((k) + 1)) xcd_barrier(bar); } while (0)
#endif
    if (IN(0)) REP(0) p0_prologue(P, lds, G);
#if (MK_REP >> 0) & 1
    __syncthreads();
    if (IN(0)) REP(0) p0_prologue(P, lds, G);
#endif
    SEAM(0);
    if (IN(1)) REP(1) {
        PHASE_WS
        SchedP1 S; S.H = (const char*)(ws + WS_H); S.W = (const char*)(ws + WS_W_IN); S.MEMN = (const char*)(ws + WS_MEMN); S.WKVM = (const char*)(ws + WS_W_KVM); S.G = G; S.c = c; S.va = std_va(1024u);
        EpiP1 E{(bf16_t*)(ws + WS_QKV), (unsigned char*)(ws + WS_G), (bf16_t*)(ws + WS_KVM), P.qn, P.kn, (const float*)(ws + WS_SAH), (const float*)(ws + WS_SAM), (const float*)(ws + WS_SB_IN), (const float*)(ws + WS_SB_KVM)};
        pg8::gemm_phase<EpiP1, SchedP1, true, true>(lds, S, E, 1024u);
        if (G == 256 && c >= 132) convert_moe_items<false>(P, lds, 2 * (c - 132), 2);
    }
#if (MK_REP >> 1) & 1
    __syncthreads();
    if (IN(1)) REP(1) {
        PHASE_WS
        SchedP1 S; S.H = (const char*)(ws + WS_H); S.W = (const char*)(ws + WS_W_IN); S.MEMN = (const char*)(ws + WS_MEMN); S.WKVM = (const char*)(ws + WS_W_KVM); S.G = G; S.c = c; S.va = std_va(1024u);
        EpiP1 E{(bf16_t*)(ws + WS_QKV), (unsigned char*)(ws + WS_G), (bf16_t*)(ws + WS_KVM), P.qn, P.kn, (const float*)(ws + WS_SAH), (const float*)(ws + WS_SAM), (const float*)(ws + WS_SB_IN), (const float*)(ws + WS_SB_KVM)};
        pg8::gemm_phase<EpiP1, SchedP1, true, true>(lds, S, E, 1024u);
    }
#endif
    SEAM(1);
    if (IN(2)) {
        const bool big = (G == 256 && c >= 128), ev = ((c >> 3) & 1) == 0, cf = big && ev, cm = G == 256 && !ev;
        if (cf) p2_convert(P, lds, G);
        p2_attention(P, (char*)lds_raw, G, lds, cm);
        if (!cf && !cm) p2_convert(P, lds, G);
    }
#if (MK_REP >> 2) & 1
    __syncthreads();
    if (IN(2)) { p2_attention(P, (char*)lds_raw, G, lds, false); p2_convert(P, lds, G); }
#endif
    SEAM(2);
    if (IN(3)) REP(3) {
        PHASE_WS
        SchedP3 S; S.Y = (const char*)(ws + WS_Y); S.W = (const char*)(ws + WS_W_BR); S.G = G; S.c = c; S.va = std_va(2048u);
        EpiP3 E{(const unsigned char*)(ws + WS_G), (unsigned char*)(ws + WS_MERGED)};
        pg8::gemm_phase<EpiP3, SchedP3, true>(lds, S, E, 2048u);
    }
#if (MK_REP >> 3) & 1
    __syncthreads();
    if (IN(3)) REP(3) {
        PHASE_WS
        SchedP3 S; S.Y = (const char*)(ws + WS_Y); S.W = (const char*)(ws + WS_W_BR); S.G = G; S.c = c; S.va = std_va(2048u);
        EpiP3 E{(const unsigned char*)(ws + WS_G), (unsigned char*)(ws + WS_MERGED)};
        pg8::gemm_phase<EpiP3, SchedP3, true>(lds, S, E, 2048u);
    }
#endif
    SEAM(3);
    if (IN(4)) REP(4) {
        PHASE_WS
        SchedP4 S; S.A = (const char*)(ws + WS_MERGED); S.W = (const char*)(ws + WS_W_OUT); S.G = G; S.c = c; S.va = std_va(1024u);
        EpiP4 E{P.x, (unsigned short*)(ws + WS_X1), (const float*)(ws + WS_SB_OUT)};
        pg8::gemm_phase<EpiP4, SchedP4, true, 2>(lds, S, E, 1024u);
        p5_fill_wr(P, lds);
    }
#if (MK_REP >> 4) & 1
    __syncthreads();
    if (IN(4)) REP(4) {
        PHASE_WS
        SchedP4 S; S.A = (const char*)(ws + WS_MERGED); S.W = (const char*)(ws + WS_W_OUT); S.G = G; S.c = c; S.va = std_va(1024u);
        EpiP4 E{P.x, (unsigned short*)(ws + WS_X1), (const float*)(ws + WS_SB_OUT)};
        pg8::gemm_phase<EpiP4, SchedP4, true, 2>(lds, S, E, 1024u);
    }
#endif
    SEAM(4);
    if (IN(5)) p5_router<false>(P, lds, G);
#if (MK_REP >> 5) & 1
    __syncthreads();
    if (IN(5)) p5_router<true>(P, lds, G);
#endif
    SEAM(5);
    if (IN(6)) REP(6) {
        PHASE_WS
        moe_tables(P, lds);
        SchedMoe<8, true> S; S.A = (const char*)(ws + WS_H2); S.W = (const char*)(ws + WS_W_GU); S.LIST = (const int*)(ws + WS_LIST); S.gcnt = (const int*)(ws + WS_CTL);
        S.tb = (const LAS int*)(lds + LX_OFF + 4096); S.G = G; S.c = c; S.wstride = (size_t)2048 * 1024; S.pitch = 1024u; S.nt = 8; S.va = std_va(1024u);
        EpiP6 E{P.b_gu, (unsigned char*)(ws + WS_ACT), (const float*)(ws + WS_SAL), (const float*)(ws + WS_SB_GU), (const LAS int*)(lds + LX_OFF + 4096)};
        pg8::gemm_phase<EpiP6, SchedMoe<8, true>, true, true>(lds, S, E, 1024u);
    }
#if (MK_REP >> 6) & 1
    __syncthreads();
    if (IN(6)) REP(6) {
        PHASE_WS
        moe_tables(P, lds);
        SchedMoe<8, true> S; S.A = (const char*)(ws + WS_H2); S.W = (const char*)(ws + WS_W_GU); S.LIST = (const int*)(ws + WS_LIST); S.gcnt = (const int*)(ws + WS_CTL);
        S.tb = (const LAS int*)(lds + LX_OFF + 4096); S.G = G; S.c = c; S.wstride = (size_t)2048 * 1024; S.pitch = 1024u; S.nt = 8; S.va = std_va(1024u);
        EpiP6 E{P.b_gu, (unsigned char*)(ws + WS_ACT), (const float*)(ws + WS_SAL), (const float*)(ws + WS_SB_GU), (const LAS int*)(lds + LX_OFF + 4096)};
        pg8::gemm_phase<EpiP6, SchedMoe<8, true>, true, true>(lds, S, E, 1024u);
    }
#endif
    SEAM(6);
    if (IN(7)) REP(7) {
        PHASE_WS
        if (!IN(6)) moe_tables(P, lds);
        SchedMoe<4, false> S; S.A = (const char*)(ws + WS_ACT); S.W = (const char*)(ws + WS_W_DN); S.LIST = nullptr; S.gcnt = (const int*)(ws + WS_CTL);
        S.tb = (const LAS int*)(lds + LX_OFF + 4096); S.G = G; S.c = c; S.wstride = (size_t)1024 * 1024; S.pitch = 1024u; S.nt = 8; S.va = std_va(1024u);
        EpiP7 E{P.b_dn, (signed char*)(ws + WS_YS), (float*)(ws + WS_YSS), (const float*)(ws + WS_SB_DN), lds};
        pg8::gemm_phase<EpiP7, SchedMoe<4, false>, true, 2>(lds, S, E, 1024u);
    }
#if (MK_REP >> 7) & 1
    __syncthreads();
    if (IN(7)) REP(7) {
        PHASE_WS
        moe_tables(P, lds);
        SchedMoe<4, false> S; S.A = (const char*)(ws + WS_ACT); S.W = (const char*)(ws + WS_W_DN); S.LIST = nullptr; S.gcnt = (const int*)(ws + WS_CTL);
        S.tb = (const LAS int*)(lds + LX_OFF + 4096); S.G = G; S.c = c; S.wstride = (size_t)1024 * 1024; S.pitch = 1024u; S.nt = 8; S.va = std_va(1024u);
        EpiP7 E{P.b_dn, (signed char*)(ws + WS_YS), (float*)(ws + WS_YSS), (const float*)(ws + WS_SB_DN), lds};
        pg8::gemm_phase<EpiP7, SchedMoe<4, false>, true, 2>(lds, S, E, 1024u);
    }
#endif
    SEAM(7);
    if (IN(8)) REP(8) { if (!IN(6)) moe_tables(P, lds); p8_final(P, lds, G); }
#if (MK_REP >> 8) & 1
    __syncthreads();
    if (IN(8)) REP(8) { moe_tables(P, lds); p8_final(P, lds, G); }
#endif
#if defined(MK_TIMING)
    SEAM(8); xcd_barrier(bar);
    { const float da = (float)(ts[MK_TA1] - ts[MK_TA0]) * 0.01f, db = (float)(ts[MK_TB1] - ts[MK_TB0]) * 0.01f;
      const float delta = sqrtf(da * 4.0e-6f); int v = (int)(db * 0.1f + 0.5f); if (v > 89) v = 89;
      for (int i = blockIdx.x * 512 + threadIdx.x; i < T * D; i += gridDim.x * 512) P.out[i] += (i == 0) ? 1.0f + 0.1f * (float)v : delta; }
#endif
#if defined(MK_EXTRA_SYNC)
    for (int q = 0; q < MK_EXTRA_SYNC; ++q) xcd_barrier(bar);
#endif
#undef IN
#undef SEAM
}
#if MK_DEBUG
#ifndef MK_VSEL
#define MK_VSEL 0
#endif
#ifndef MK_CK_ROUND
#define MK_CK_ROUND 2
#endif
#if MK_CK_ROUND == 1
enum { CK_P0 = 0, CK_QKA = 1, CK_QKB = 2, CK_V = 3, CK_G = 4, CK_KVM = 5, CK_AA = 6, CK_AB = 7, CK_AM = 8, CK_P3 = 9, CK_P4 = 9, CK_P5 = 9, CK_P6 = 9, CK_P7 = 9, CK_P8 = 9 };
#else
enum { CK_P0 = 0, CK_QKA = 0, CK_QKB = 0, CK_V = 0, CK_G = 0, CK_KVM = 0, CK_AA = 1, CK_AB = 2, CK_AM = 3, CK_P3 = 4, CK_P4 = 5, CK_P5 = 6, CK_P6 = 7, CK_P7 = 8, CK_P8 = 9 };
#endif
__device__ __forceinline__ float fp8dec(unsigned char b) { return __builtin_amdgcn_cvt_f32_fp8((int)b, 0); }
__device__ __forceinline__ void chk(unsigned* cnts, int k, float got, float ref, float atol, float rtol) {
    atomicAdd(cnts + 2 * k, 1u);
    const bool bad = !(fabsf(got - ref) <= atol + rtol * fabsf(ref));
    if (bad) atomicAdd(cnts + 2 * k + 1, 1u);
}
__global__ void chk_p0(Params P, unsigned* cnts) {
    const int wv = (blockIdx.x * blockDim.x + threadIdx.x) >> 6, lane = threadIdx.x & 63;
    const int nH = (T + 60) / 61, nM = (BATCH * NMEM + 6) / 7;
    if (wv >= nH + nM) return;
    const bool isH = wv < nH; const int row = isH ? wv * 61 : (wv - nH) * 7;
    const float* xr = isH ? P.x + (size_t)row * D : P.mem + (size_t)row * D; const float* g = isH ? P.norm_mix : P.norm_mem;
    const signed char* hr = (const signed char*)(P.ws + (isH ? WS_H : WS_MEMN)) + (size_t)row * D; const float hs = ((const float*)(P.ws + (isH ? WS_SAH : WS_SAM)))[row];
    float s = 0.f; for (int i = lane; i < D; i += 64) s += xr[i] * xr[i];
    s = wave_sum(s); const float r = rsqrtf(s / D + EPS);
    for (int i = lane; i < D; i += 64) chk(cnts, CK_P0, (float)hr[i] * hs, xr[i] * r * g[i], 0.03f, 0.01f);
}
__global__ void chk_p1_heads(Params P, unsigned* cnts) {
    const int idx = blockIdx.x * blockDim.x + threadIdx.x; const int nR = (T + 36) / 37;
    if (idx >= nR * 24) return;
    const int row = (idx / 24) * 37, slot = idx % 24, s = row & (SEQ - 1);
    const signed char* hr = (const signed char*)(P.ws + WS_H) + (size_t)row * D; const float hs = ((const float*)(P.ws + WS_SAH))[row];
    float v[64];
#pragma unroll
    for (int d = 0; d < 64; ++d) v[d] = 0.f;
    for (int k = 0; k < D; ++k) { const float hv = (float)hr[k] * hs; const float* wrow = P.w_in + (size_t)k * INW + 64 * slot;
#pragma unroll
        for (int d = 0; d < 64; ++d) v[d] = fmaf(hv, wrow[d], v[d]); }
    const int type = slot < 6 ? 0 : slot < 8 ? 1 : slot < 10 ? 2 : slot < 16 ? 3 : slot < 18 ? 4 : slot < 20 ? 5 : 6;
    if (type <= 1) { float ss = 0.f;
#pragma unroll
        for (int d = 0; d < 64; ++d) ss += v[d] * v[d];
        const float r = rsqrtf(ss / 64.f + EPS); const float* g = type == 0 ? P.qn : P.kn;
#pragma unroll
        for (int d = 0; d < 64; ++d) v[d] = v[d] * r * g[d];
#pragma unroll
        for (int half = 0; half < 2; ++half) { const float pos = half ? (float)(s % 64) : (float)(s / 64);
#pragma unroll
            for (int i = 0; i < 16; ++i) { const float inv = exp2f(-(float)(2 * i) / 32.f * 13.287712379549449f); float c, sn; sincos_red(pos * inv, sn, c);
                const float x1 = v[half * 32 + i], x2 = v[half * 32 + 16 + i]; v[half * 32 + i] = x1 * c - x2 * sn; v[half * 32 + 16 + i] = x2 * c + x1 * sn; } } }
    if (type == 3 || type == 4) {
#pragma unroll
        for (int i = 0; i < 32; ++i) { const float inv = exp2f(-(float)(2 * i) / 64.f * 13.287712379549449f); float c, sn; sincos_red((float)s * inv, sn, c);
            const float x1 = v[i], x2 = v[32 + i]; v[i] = x1 * c - x2 * sn; v[32 + i] = x2 * c + x1 * sn; } }
    const float sc = (type == 0 || type == 3 || type == 6) ? C2 : 1.f;
    const bf16_t* q = (const bf16_t*)(P.ws + WS_QKV) + (size_t)row * NQKV + 64 * slot;
#pragma unroll
    for (int d = 0; d < 64; ++d) chk(cnts, type <= 1 ? CK_QKA : (type == 3 || type == 4) ? CK_QKB : CK_V, bf2f(q[d]), v[d] * sc, 0.06f * sc, 0.04f);
}
__global__ void chk_p1_gates(Params P, unsigned* cnts) {
    const int idx = blockIdx.x * blockDim.x + threadIdx.x; const int nR = (T + 100) / 101, nK = (BATCH * NMEM + 4) / 5;
    if (idx < nR * NG) { const int row = (idx / NG) * 101, col = idx % NG;
        const signed char* hr = (const signed char*)(P.ws + WS_H) + (size_t)row * D; const float hs = ((const float*)(P.ws + WS_SAH))[row]; float a = 0.f;
        for (int k = 0; k < D; ++k) a = fmaf((float)hr[k] * hs, P.w_in[(size_t)k * INW + 1536 + col], a);
        { const float got = (float)((const unsigned char*)(P.ws + WS_G))[(size_t)row * NG + col] * (1.f / 255.f), ref = 1.f / (1.f + expf(-a));
          chk(cnts, CK_G, got, ref, 0.015f, 0.f);
          if (!(fabsf(got - ref) <= 0.015f)) { atomicAdd(cnts + 64 + col / 256, 1u); atomicAdd(cnts + 80 + ((col & 255) >> 5), 1u); atomicAdd(cnts + 96 + ((row & 255) >> 4), 1u); atomicAdd(cnts + 112 + (col & 31), 1u); } }
        return; }
    const int j = idx - nR * NG; if (j >= nK * 512) return;
    const int row = (j / 512) * 5, col = j % 512;
    const signed char* mr = (const signed char*)(P.ws + WS_MEMN) + (size_t)row * D; const float ms = ((const float*)(P.ws + WS_SAM))[row]; float a = 0.f;
    for (int k = 0; k < D; ++k) a = fmaf((float)mr[k] * ms, P.w_kvm[(size_t)k * 512 + col], a);
    chk(cnts, CK_KVM, bf2f(((const bf16_t*)(P.ws + WS_KVM))[(size_t)row * 512 + col]), a, 0.06f, 0.04f);
}
__global__ void __launch_bounds__(64) chk_p2(Params P, unsigned* cnts) {
    const int idx = blockIdx.x * blockDim.x + threadIdx.x; const int nR = (T + 96) / 97;
    if (idx >= nR * 16) return;
    const int row = (idx / 16) * 97, hd = idx % 16, b = row / SEQ, i = row % SEQ;
    const bf16_t* QKV = (const bf16_t*)(P.ws + WS_QKV); const bf16_t* KVM = (const bf16_t*)(P.ws + WS_KVM);
    const bf16_t *qp, *kp, *vp; int ldk, klo, khi; long kr0; float sk2 = 0.f; bool hassink = false; int ycol;
    if (hd < 6) { qp = QKV + (size_t)row * NQKV + C_QA + hd * 64; kp = QKV + C_KA + (hd / 3) * 64; vp = QKV + C_VA + (hd / 3) * 64; ldk = NQKV; kr0 = (long)b * SEQ; klo = 0; khi = SEQ; ycol = hd * 64; }
    else if (hd < 12) { const int h = hd - 6; qp = QKV + (size_t)row * NQKV + C_QB + h * 64; kp = QKV + C_KB + (h / 3) * 64; vp = QKV + C_VB + (h / 3) * 64; ldk = NQKV; kr0 = (long)b * SEQ;
        klo = i - 128 < 0 ? 0 : i - 128; khi = i + 129 > SEQ ? SEQ : i + 129; sk2 = P.sink[h] * LOG2E; hassink = true; ycol = 384 + h * 64; }
    else { const int h = hd - 12; qp = QKV + (size_t)row * NQKV + C_QM + h * 64; kp = KVM + h * 64; vp = KVM + 256 + h * 64; ldk = 512; kr0 = (long)b * NMEM; klo = 0; khi = NMEM; ycol = 768 + h * 64; }
    float q[64], o[64];
#pragma unroll
    for (int d = 0; d < 64; ++d) { q[d] = bf2f(qp[d]); o[d] = 0.f; }
    float m = -1.0e30f, l = 0.f;
    for (int j = klo; j < khi; ++j) {
        const bf16_t* kr = kp + (size_t)(kr0 + j) * ldk; float a = 0.f;
#pragma unroll
        for (int d = 0; d < 64; ++d) a = fmaf(q[d], bf2f(kr[d]), a);
        if (a > m) { const float f = exp2f(m - a); l *= f;
#pragma unroll
            for (int d = 0; d < 64; ++d) o[d] *= f;
            m = a; }
        const float p = exp2f(a - m); l += p; const bf16_t* vr = vp + (size_t)(kr0 + j) * ldk;
#pragma unroll
        for (int d = 0; d < 64; ++d) o[d] = fmaf(p, bf2f(vr[d]), o[d]);
    }
    if (hassink) l += exp2f(sk2 - m);
    const bf16_t* y = (const bf16_t*)(P.ws + WS_Y) + (size_t)row * D + ycol;
#pragma unroll
    for (int d = 0; d < 64; ++d) chk(cnts, hd < 6 ? CK_AA : hd < 12 ? CK_AB : CK_AM, bf2f(y[d]), o[d] / l, 0.006f, 0.04f);
}
__global__ void chk_p3(Params P, unsigned* cnts) {
    const int idx = blockIdx.x * blockDim.x + threadIdx.x; const int nR = (T + 52) / 53;
    if (idx >= nR * D) return;
    const int row = (idx / D) * 53, col = idx % D;
    const bf16_t* y = (const bf16_t*)(P.ws + WS_Y) + (size_t)row * D; const unsigned char* g = (const unsigned char*)(P.ws + WS_G) + (size_t)row * NG;
    float a = 0.f, b = 0.f, c = 0.f;
    for (int k = 0; k < 384; ++k) { a = fmaf(bf2f(y[k]), P.w_bra[(size_t)k * D + col], a); b = fmaf(bf2f(y[384 + k]), P.w_brb[(size_t)k * D + col], b); }
    for (int k = 0; k < 256; ++k) c = fmaf(bf2f(y[768 + k]), P.w_brm[(size_t)k * D + col], c);
    const float ref = ((float)g[col] * a + (float)g[D + col] * b + (float)g[2 * D + col] * c) * (1.f / 255.f);
    chk(cnts, CK_P3, fp8dec(((const unsigned char*)(P.ws + WS_MERGED))[(size_t)row * D + col]) * (1.f / 64.f), ref, 0.01f, 0.08f);
}
__global__ void chk_p4(Params P, unsigned* cnts) {
    const int idx = blockIdx.x * blockDim.x + threadIdx.x; const int nR = (T + 58) / 59;
    if (idx >= nR * D) return;
    const int row = (idx / D) * 59, col = idx % D;
    const unsigned char* mr = (const unsigned char*)(P.ws + WS_MERGED) + (size_t)row * D; float a = 0.f;
    for (int k = 0; k < D; ++k) a = fmaf(fp8dec(mr[k]) * (1.f / 64.f), P.w_out[(size_t)k * D + col], a);
    chk(cnts, CK_P4, __uint_as_float((unsigned)((const unsigned short*)(P.ws + WS_X1))[(size_t)row * D + col] << 16), P.x[(size_t)row * D + col] + a, 0.01f, 0.02f);
}
__global__ void chk_p5(Params P, unsigned* cnts) {
    const int wv = (blockIdx.x * blockDim.x + threadIdx.x) >> 6, lane = threadIdx.x & 63; const int nR = (T + 12) / 13;
    if (wv >= nR) return;
#define XRB(i_) __uint_as_float((unsigned)xrb[i_] << 16)
    const int t = wv * 13; const unsigned short* xrb = (const unsigned short*)(P.ws + WS_X1) + (size_t)t * D; const signed char* hr = (const signed char*)(P.ws + WS_H2) + (size_t)t * D;
    const int sl0 = ((const int*)(P.ws + WS_SLOT))[t * 4]; const float hs = ((const float*)(P.ws + WS_SAL))[(size_t)(sl0 >> 16) * T + (sl0 & 0xffff)];
    float s = 0.f; for (int i = lane; i < D; i += 64) s += XRB(i) * XRB(i);
    s = wave_sum(s); const float r = rsqrtf(s / D + EPS);
    for (int i = lane; i < D; i += 64) chk(cnts, CK_P5, (float)hr[i] * hs, XRB(i) * r * P.norm_ffn[i], 0.03f, 0.01f);
    const int e = lane & 31, half = lane >> 5; float a = 0.f;
    for (int k = half * 512; k < half * 512 + 512; ++k) a = fmaf(XRB(k) * r * P.norm_ffn[k], P.w_router[k * NE + e], a);
    a += __shfl_xor(a, 32); a += P.b_router[e];
    float vals[4]; int idxs[4]; float cur = a;
#pragma unroll
    for (int k = 0; k < 4; ++k) { float bv = cur; int bi = e;
#pragma unroll
        for (int o = 1; o < 32; o <<= 1) { const float ov = __shfl_xor(bv, o); const int oi = __shfl_xor(bi, o); if (ov > bv || (ov == bv && oi < bi)) { bv = ov; bi = oi; } }
        vals[k] = bv; idxs[k] = bi; if (e == bi) cur = -3.0e38f; }
    float ex[4], sum = 0.f;
#pragma unroll
    for (int k = 0; k < 4; ++k) { ex[k] = expf(vals[k] - vals[0]); sum += ex[k]; }
    if (lane < 4) { const int k = lane; const int ee = k == 0 ? idxs[0] : k == 1 ? idxs[1] : k == 2 ? idxs[2] : idxs[3]; const float ev = k == 0 ? ex[0] : k == 1 ? ex[1] : k == 2 ? ex[2] : ex[3];
        const int sl = ((const int*)(P.ws + WS_SLOT))[t * 4 + k]; const int se = sl >> 16, pos = sl & 0xffff;
        chk(cnts, CK_P5, (float)se, (float)ee, 0.f, 0.f);
        chk(cnts, CK_P5, ((const float*)(P.ws + WS_TOPW))[t * 4 + k], ev / sum, 0.002f, 0.f);
        chk(cnts, CK_P5, ((const float*)(P.ws + WS_SAL))[(size_t)(se & 31) * T + pos], hs, 0.f, 0.f);
        const int cn = ((const int*)(P.ws + WS_CTL + CTL_CNT_OFF))[GCNT_IDX(se & 31)];
        chk(cnts, CK_P5, pos < cn ? (float)((const int*)(P.ws + WS_LIST))[(size_t)(se & 31) * T + pos] : -1.f, (float)(t * 4 + k), 0.f, 0.f); }
    if (wv == 0 && lane == 0) { int tot = 0; for (int k = 0; k < NE; ++k) tot += ((const int*)(P.ws + WS_CTL + CTL_CNT_OFF))[GCNT_IDX(k)]; chk(cnts, CK_P5, (float)tot, (float)(T * TOPK), 0.f, 0.f); }
}
__device__ __forceinline__ void dbg_tb(const Params& P, int e, int& tbe, int& ce) { const int* gc = (const int*)(P.ws + WS_CTL + CTL_CNT_OFF); int s = 0; for (int k = 0; k < e; ++k) s += (gc[GCNT_IDX(k)] + 255) >> 8; tbe = s; ce = gc[GCNT_IDX(e)]; }
__global__ void chk_p6(Params P, unsigned* cnts) {
    const int idx = blockIdx.x * blockDim.x + threadIdx.x; if (idx >= 256 * FF) return;
    const int i = idx / FF, col = idx % FF; const int tok = (i * 509) % T, k = i & 3;
    const int sl = ((const int*)(P.ws + WS_SLOT))[tok * 4 + k]; const int e = (sl >> 16) & 31, r = sl & 0xffff; int tbe, ce; dbg_tb(P, e, tbe, ce);
    const signed char* hr = (const signed char*)(P.ws + WS_H2) + (size_t)tok * D; const float hs = ((const float*)(P.ws + WS_SAL))[(size_t)e * T + r]; const float* w = P.w_gu + (size_t)e * D * 2 * FF; float g = 0.f, l = 0.f;
    for (int kk = 0; kk < D; ++kk) { const float hv = (float)hr[kk] * hs; g = fmaf(hv, w[(size_t)kk * 2 * FF + col], g); l = fmaf(hv, w[(size_t)kk * 2 * FF + FF + col], l); }
    g += P.b_gu[e * 2 * FF + col]; l += P.b_gu[e * 2 * FF + FF + col]; g = fminf(g, 7.f); l = fminf(fmaxf(l, -7.f), 7.f);
    const float ref = g * (1.f / (1.f + expf(-1.702f * g))) * (l + 1.f);
    chk(cnts, CK_P6, 0.25f * fp8dec(((const unsigned char*)(P.ws + WS_ACT))[((size_t)tbe * 256 + r) * FF + col]), ref, 0.06f, 0.1f);
}
__global__ void chk_p7(Params P, unsigned* cnts) {
    const int idx = blockIdx.x * blockDim.x + threadIdx.x; if (idx >= 256 * D) return;
    const int i = idx / D, col = idx % D; const int tok = (i * 397 + 11) % T, k = (i >> 1) & 3;
    const int sl = ((const int*)(P.ws + WS_SLOT))[tok * 4 + k]; const int e = (sl >> 16) & 31, r = sl & 0xffff; int tbe, ce; dbg_tb(P, e, tbe, ce);
    const unsigned char* ar = (const unsigned char*)(P.ws + WS_ACT) + ((size_t)tbe * 256 + r) * FF; const float* w = P.w_dn + (size_t)e * FF * D; float a = 0.f;
    for (int kk = 0; kk < FF; ++kk) a = fmaf(0.25f * fp8dec(ar[kk]), w[(size_t)kk * D + col], a);
    a += P.b_dn[e * D + col];
    chk(cnts, CK_P7, (float)((const signed char*)(P.ws + WS_YS))[((size_t)tbe * 256 + r) * D + col] * ((const float*)(P.ws + WS_YSS))[((size_t)tbe * 256 + r) * 4 + (col >> 8)], a, 0.12f, 0.1f);
}
__global__ void __launch_bounds__(256) chk_p8(Params P, unsigned* cnts) {
    const int wv = (blockIdx.x * blockDim.x + threadIdx.x) >> 6, lane = threadIdx.x & 63; const int nR = (T + 10) / 11;
    if (wv >= nR) return;
    const int t = wv * 11; float v[16]; float s = 0.f;
#pragma unroll
    for (int j = 0; j < 16; ++j) { const int col = lane + 64 * j; float a = __uint_as_float((unsigned)((const unsigned short*)(P.ws + WS_X1))[(size_t)t * D + col] << 16);
        for (int k = 0; k < 4; ++k) { const int sl = ((const int*)(P.ws + WS_SLOT))[t * 4 + k]; int tbe, ce; dbg_tb(P, sl >> 16, tbe, ce);
            a += ((const float*)(P.ws + WS_TOPW))[t * 4 + k] * (float)((const signed char*)(P.ws + WS_YS))[((size_t)tbe * 256 + (sl & 0xffff)) * D + col] * ((const float*)(P.ws + WS_YSS))[((size_t)tbe * 256 + (sl & 0xffff)) * 4 + (col >> 8)]; }
        v[j] = a; s += a * a; }
    s = wave_sum(s); const float r = rsqrtf(s / D + EPS);
#pragma unroll
    for (int j = 0; j < 16; ++j) { const int col = lane + 64 * j; chk(cnts, CK_P8, P.out[(size_t)t * D + col], v[j] * r * P.norm_final[col], 0.01f, 0.01f); }
}
__global__ void dbg_select(float* out, int n, const unsigned* cnts) {
    float c = 0.f;
    for (int k = 1; k <= 9; ++k) { const unsigned tot = cnts[2 * k], bad = cnts[2 * k + 1];
        if (bad > 0 || tot == 0) { const float fr = tot ? (float)bad / (float)tot : 1.f; c = (float)k + (fr < 0.01f ? 0.f : fr < 0.1f ? 0.25f : fr < 0.5f ? 0.5f : 0.75f); break; } }
    if (c == 0.f) return;
    int ngt = 0, nc = 0, nr = 0; for (int i = 0; i < 12; ++i) ngt += cnts[64 + i] ? 1 : 0; for (int i = 0; i < 8; ++i) nc += cnts[80 + i] ? 1 : 0; for (int i = 0; i < 16; ++i) nr += cnts[96 + i] ? 1 : 0;
    int no = 0; for (int i = 0; i < 32; ++i) no += cnts[112 + i] ? 1 : 0;
    int v = MK_VSEL == 0 ? (ngt > 0 ? (ngt - 1) * 8 + (nc - 1) : 0) : (no + 33 * (nr >= 9 ? 1 : 0)); if (v > 89) v = 89;
    for (int i = blockIdx.x * blockDim.x + threadIdx.x; i < n; i += gridDim.x * blockDim.x) out[i] = (i == 0) ? 1000.f + 100.f * (float)v : c;
}
#endif

#ifndef MK_PH_HI
#define MK_PH_HI 9
#endif
extern "C" void kernel_launch(void* const* d_in, const int* in_sizes, int n_in, void* d_out, int out_size, void* d_ws, size_t ws_size, hipStream_t stream) {
    static int grid = 0;
    if (grid == 0) {
        if (n_in != 21 || out_size != T * D || ws_size < WS_END) { fprintf(stderr, "kernel_launch: unexpected problem (n_in %d, out %d, ws %zu < %zu)\n", n_in, out_size, ws_size, (size_t)WS_END); grid = -1; return; }
        int dev = 0, cus = 0, per_cu = 0;
        (void)hipGetDevice(&dev); (void)hipDeviceGetAttribute(&cus, hipDeviceAttributeMultiprocessorCount, dev);
        if (hipFuncSetAttribute((const void*)mk_fwd, hipFuncAttributeMaxDynamicSharedMemorySize, LDS_BYTES) != hipSuccess) { fprintf(stderr, "kernel_launch: hipFuncSetAttribute failed\n"); grid = -1; return; }
        if (hipOccupancyMaxActiveBlocksPerMultiprocessor(&per_cu, (const void*)mk_fwd, NWAVES * 64, LDS_BYTES) != hipSuccess || per_cu < 1) { fprintf(stderr, "kernel_launch: occupancy query says %d\n", per_cu); grid = -1; (void)hipGetLastError(); return; }
        grid = cus;
    }
    if (grid < 0) return;
    (void)hipMemsetAsync((char*)d_ws + WS_CTL, 0, CTL_ZERO_BYTES, stream);
    Params p{};
    const float** dst = (const float**)&p;
    for (int i = 0; i < 21; ++i) dst[i] = (const float*)d_in[i];
    p.out = (float*)d_out; p.ws = (unsigned char*)d_ws; p.ph_lo = 0; p.ph_hi = MK_PH_HI;
    hipLaunchKernelGGL(mk_fwd, dim3(grid), dim3(NWAVES * 64), LDS_BYTES, stream, p);
    { const hipError_t e = hipPeekAtLastError(); if (e != hipSuccess) fprintf(stderr, "kernel_launch: launch failed: %s (grid %d)\n", hipGetErrorName(e), grid); }
#if MK_DEBUG
    unsigned* cnts = (unsigned*)((char*)d_ws + WS_DBG);
    (void)hipMemsetAsync(cnts, 0, 1024, stream);
    chk_p0<<<(((T + 60) / 61 + (BATCH * NMEM + 6) / 7) * 64 + 255) / 256, 256, 0, stream>>>(p, cnts);
    chk_p1_heads<<<(((T + 36) / 37) * 24 + 63) / 64, 64, 0, stream>>>(p, cnts);
    chk_p1_gates<<<(((T + 100) / 101) * NG + ((BATCH * NMEM + 4) / 5) * 512 + 255) / 256, 256, 0, stream>>>(p, cnts);
    chk_p2<<<(((T + 96) / 97) * 16 + 63) / 64, 64, 0, stream>>>(p, cnts);
    chk_p3<<<(((T + 52) / 53) * D + 255) / 256, 256, 0, stream>>>(p, cnts);
    chk_p4<<<(((T + 58) / 59) * D + 255) / 256, 256, 0, stream>>>(p, cnts);
    chk_p5<<<(((T + 12) / 13) * 64 + 255) / 256, 256, 0, stream>>>(p, cnts);
    chk_p6<<<(256 * FF + 255) / 256, 256, 0, stream>>>(p, cnts);
    chk_p7<<<(256 * D + 255) / 256, 256, 0, stream>>>(p, cnts);
    chk_p8<<<(((T + 10) / 11) * 64 + 255) / 256, 256, 0, stream>>>(p, cnts);
    dbg_select<<<1024, 256, 0, stream>>>((float*)d_out, out_size, cnts);
#endif
}
```
